# Optimizing an MI355X kernel written in HIP

```python
import math
import jax, jax.numpy as jnp
from jax import lax
import numpy as np

D_MODEL = 2048
BATCH = 4
SEQ = 2048
DEPTH = 1

HGRN_WIDTH = D_MODEL // 2
HGRN_HEAD_DIM = 128
HGRN_HEADS = HGRN_WIDTH // HGRN_HEAD_DIM
CHUNK = 64
ATTN_WIDTH = D_MODEL - HGRN_WIDTH
ATTN_HEAD_DIM = 128
ATTN_HEADS = ATTN_WIDTH // ATTN_HEAD_DIM
ATTN_KV_HEADS = 2
KV_WIDTH = ATTN_KV_HEADS * ATTN_HEAD_DIM
WINDOW = 128
ATTN_BLOCK = 128
KEY_SPAN = ATTN_BLOCK + 2 * WINDOW
REL_BUCKETS = 32
REL_MAX_DIST = 128
D_FF = 5632
EPS = 1e-6
NEG_INF = -1e30
IN_SPLITS = (HGRN_WIDTH, HGRN_WIDTH, HGRN_WIDTH, HGRN_WIDTH, HGRN_WIDTH, ATTN_WIDTH, KV_WIDTH, KV_WIDTH)
IN_COLS = sum(IN_SPLITS)

kernel_name = "hymba_hgrn2_swa_macaron_sandwich"


def rms_norm(x, gain):
    xf = x.astype(jnp.float32)
    y = xf * lax.rsqrt(jnp.mean(xf * xf, axis=-1, keepdims=True) + EPS)
    return (y * gain.astype(jnp.float32)).astype(x.dtype)


def swiglu(x, w_gate_up, w_down):
    gate, up = jnp.split(x @ w_gate_up, 2, axis=-1)
    return (jax.nn.silu(gate) * up) @ w_down


def hgrn_chunk_scan(q, k, v, log_f):
    b_, h_, l_, dk = q.shape
    dv = v.shape[-1]
    n = l_ // CHUNK
    q = q.reshape(b_, h_, n, CHUNK, dk)
    k = k.reshape(b_, h_, n, CHUNK, dk)
    log_f = log_f.reshape(b_, h_, n, CHUNK, dk)
    v = v.reshape(b_, h_, n, CHUNK, dv)
    cum = jnp.cumsum(log_f, axis=3)
    last = cum[:, :, :, -1:, :]
    q_dec = q * jnp.exp(cum)
    k_dec = k * jnp.exp(-cum)
    k_tail = k * jnp.exp(last - cum)
    lower = jnp.tril(jnp.ones((CHUNK, CHUNK), dtype=bool))
    scores = jnp.einsum('bhnck,bhnsk->bhncs', q_dec, k_dec)
    scores = jnp.where(lower, scores, 0.0)
    o_intra = jnp.einsum('bhncs,bhnsv->bhncv', scores, v)
    kv_chunk = jnp.einsum('bhnsk,bhnsv->bhnkv', k_tail, v)
    chunk_decay = jnp.exp(last[:, :, :, 0, :])

    def step(state, inp):
        kv_n, dec_n = inp
        return dec_n[..., None] * state + kv_n, state

    init = jnp.zeros((b_, h_, dk, dv), kv_chunk.dtype)
    _, prev = lax.scan(step, init, (jnp.moveaxis(kv_chunk, 2, 0), jnp.moveaxis(chunk_decay, 2, 0)))
    prev = jnp.moveaxis(prev, 0, 2)
    o_inter = jnp.einsum('bhnck,bhnkv->bhncv', q_dec, prev)
    return (o_intra + o_inter).reshape(b_, h_, l_, dv)


def hgrn2_mixer(q, i, f_fwd_logit, f_bwd_logit, g, lb_fwd, lb_bwd, out_gain):
    b_, l_, _ = q.shape

    def heads(t):
        return t.astype(jnp.float32).reshape(b_, l_, HGRN_HEADS, HGRN_HEAD_DIM).transpose(0, 2, 1, 3)

    qh, vh = heads(q), heads(i)

    def direction(f_logit, lb, flip):
        lb = lb.astype(jnp.float32).reshape(HGRN_HEADS, 1, HGRN_HEAD_DIM)
        f = lb + (1.0 - lb) * jax.nn.sigmoid(heads(f_logit))
        log_f, k = jnp.log(f), 1.0 - f
        qq, vv = qh, vh
        if flip:
            qq, vv, k, log_f = (jnp.flip(t, axis=2) for t in (qq, vv, k, log_f))
        o = hgrn_chunk_scan(qq, k, vv, log_f)
        return jnp.flip(o, axis=2) if flip else o

    o = direction(f_fwd_logit, lb_fwd, False) + direction(f_bwd_logit, lb_bwd, True)
    o = o.transpose(0, 2, 1, 3)
    o = o * lax.rsqrt(jnp.mean(o * o, axis=-1, keepdims=True) + EPS)
    o = o * out_gain.astype(jnp.float32).reshape(HGRN_HEADS, HGRN_HEAD_DIM)
    o = o.reshape(b_, l_, HGRN_WIDTH) * jax.nn.silu(g.astype(jnp.float32))
    return o.astype(q.dtype)


def t5_buckets(rel):
    nb = REL_BUCKETS // 2
    max_exact = nb // 2
    bucket = (rel > 0).astype(np.int32) * nb
    n = np.abs(rel)
    large = max_exact + (np.log(np.maximum(n, 1) / max_exact) / np.log(REL_MAX_DIST / max_exact)
                         * (nb - max_exact)).astype(np.int32)
    large = np.minimum(large, nb - 1)
    return bucket + np.where(n < max_exact, n, large).astype(np.int32)


def window_attention(q, k, v, sink, rel_table):
    b_, l_, _ = q.shape
    nb = l_ // ATTN_BLOCK
    grp = ATTN_HEADS // ATTN_KV_HEADS
    qb = q.reshape(b_, nb, ATTN_BLOCK, ATTN_KV_HEADS, grp, ATTN_HEAD_DIM)

    def band(t):
        tp = jnp.pad(t, ((0, 0), (WINDOW, WINDOW), (0, 0)))
        tp = tp.reshape(b_, nb + 2, ATTN_BLOCK, ATTN_KV_HEADS, ATTN_HEAD_DIM)
        return jnp.concatenate([tp[:, :-2], tp[:, 1:-1], tp[:, 2:]], axis=2)

    kb, vb = band(k), band(v)
    scores = jnp.einsum('bncxgd,bnsxd->bxgncs', qb, kb).astype(jnp.float32) / math.sqrt(ATTN_HEAD_DIM)
    c = np.arange(ATTN_BLOCK)[:, None]
    s = np.arange(KEY_SPAN)[None, :]
    rel = s - WINDOW - c
    bias = rel_table.astype(jnp.float32)[t5_buckets(rel)]
    bias = jnp.transpose(bias, (2, 0, 1)).reshape(ATTN_KV_HEADS, grp, 1, ATTN_BLOCK, KEY_SPAN)
    key_pos = np.arange(nb)[:, None, None] * ATTN_BLOCK - WINDOW + s[None]
    valid = (np.abs(rel)[None] <= WINDOW) & (key_pos >= 0) & (key_pos < l_)
    scores = jnp.where(valid, scores + bias, NEG_INF)
    sink_col = jnp.broadcast_to(sink.astype(jnp.float32).reshape(1, ATTN_KV_HEADS, grp, 1, 1, 1),
                                scores.shape[:-1] + (1,))
    probs = jax.nn.softmax(jnp.concatenate([scores, sink_col], axis=-1), axis=-1)[..., :KEY_SPAN]
    out = jnp.einsum('bxgncs,bnsxd->bncxgd', probs.astype(v.dtype), vb)
    return out.reshape(b_, l_, ATTN_WIDTH)


def setup_inputs(seed: int = 0) -> dict:
    key = jax.random.key(seed)
    ks = jax.random.split(key, 20)
    f32 = jnp.float32

    def w(k, shape, fan_in):
        return jax.random.normal(k, shape, f32) * fan_in ** -0.5

    def gain(k, shape):
        return 1.0 + 0.02 * jax.random.normal(k, shape, f32)

    return {
        "x": jax.random.normal(ks[0], (BATCH, SEQ, D_MODEL), f32),
        "pre_norm_ffn1": gain(ks[1], (DEPTH, D_MODEL)),
        "post_norm_ffn1": gain(ks[2], (DEPTH, D_MODEL)),
        "w_ffn1_gate_up": w(ks[3], (DEPTH, D_MODEL, 2 * D_FF), D_MODEL),
        "w_ffn1_down": w(ks[4], (DEPTH, D_FF, D_MODEL), D_FF),
        "pre_norm_mix": gain(ks[5], (DEPTH, D_MODEL)),
        "post_norm_mix": gain(ks[6], (DEPTH, D_MODEL)),
        "w_mix_in": w(ks[7], (DEPTH, D_MODEL, IN_COLS), D_MODEL),
        "hgrn_lower_bounds_fwd": 0.1 * jax.random.normal(ks[8], (DEPTH + 1, HGRN_WIDTH), f32),
        "hgrn_lower_bounds_bwd": 0.1 * jax.random.normal(ks[9], (DEPTH + 1, HGRN_WIDTH), f32),
        "hgrn_out_norm": gain(ks[10], (DEPTH, HGRN_WIDTH)),
        "attn_sink": 0.5 * jax.random.normal(ks[11], (DEPTH, ATTN_HEADS), f32),
        "w_mix_out": w(ks[12], (DEPTH, HGRN_WIDTH + ATTN_WIDTH, D_MODEL), HGRN_WIDTH + ATTN_WIDTH),
        "pre_norm_ffn2": gain(ks[13], (DEPTH, D_MODEL)),
        "post_norm_ffn2": gain(ks[14], (DEPTH, D_MODEL)),
        "w_ffn2_gate_up": w(ks[15], (DEPTH, D_MODEL, 2 * D_FF), D_MODEL),
        "w_ffn2_down": w(ks[16], (DEPTH, D_FF, D_MODEL), D_FF),
        "rel_bias_table": 0.5 * jax.random.normal(ks[17], (REL_BUCKETS, ATTN_HEADS), f32),
    }


def reference(x, pre_norm_ffn1, post_norm_ffn1, w_ffn1_gate_up, w_ffn1_down, pre_norm_mix,
              post_norm_mix, w_mix_in, hgrn_lower_bounds_fwd, hgrn_lower_bounds_bwd, hgrn_out_norm,
              attn_sink, w_mix_out, pre_norm_ffn2, post_norm_ffn2, w_ffn2_gate_up, w_ffn2_down,
              rel_bias_table):
    lb_fwd_all = jnp.cumsum(jax.nn.softmax(hgrn_lower_bounds_fwd.astype(jnp.float32), axis=0), axis=0)
    lb_bwd_all = jnp.cumsum(jax.nn.softmax(hgrn_lower_bounds_bwd.astype(jnp.float32), axis=0), axis=0)
    split_at = np.cumsum(IN_SPLITS)[:-1].tolist()
    for layer in range(DEPTH):
        ff = swiglu(rms_norm(x, pre_norm_ffn1[layer]), w_ffn1_gate_up[layer], w_ffn1_down[layer])
        x = x + 0.5 * rms_norm(ff, post_norm_ffn1[layer])
        h = rms_norm(x, pre_norm_mix[layer])
        q_h, i_h, f_fwd, f_bwd, g_h, q_a, k_a, v_a = jnp.split(h @ w_mix_in[layer], split_at, axis=-1)
        y_h = hgrn2_mixer(q_h, i_h, f_fwd, f_bwd, g_h, lb_fwd_all[layer], lb_bwd_all[layer],
                          hgrn_out_norm[layer])
        y_a = window_attention(q_a, k_a, v_a, attn_sink[layer], rel_bias_table)
        mixed = jnp.concatenate([y_h.astype(x.dtype), y_a.astype(x.dtype)], axis=-1) @ w_mix_out[layer]
        x = x + rms_norm(mixed, post_norm_mix[layer])
        ff = swiglu(rms_norm(x, pre_norm_ffn2[layer]), w_ffn2_gate_up[layer], w_ffn2_down[layer])
        x = x + 0.5 * rms_norm(ff, post_norm_ffn2[layer])
    return x
```

```cpp
#include <hip/hip_runtime.h>
#include <cstdio>
#include <cstdint>

#ifndef MK_N_LAUNCHES
#define MK_N_LAUNCHES 1
#endif

namespace pg8 {
#define PG8_LAS __attribute__((address_space(3)))
typedef unsigned short bf16_t;
typedef short bf16x8 __attribute__((ext_vector_type(8)));
typedef float f32x4 __attribute__((ext_vector_type(4)));
typedef unsigned u32x4 __attribute__((ext_vector_type(4)));
constexpr int BM = 256, BK = 64, HALF = 128, HTB = HALF * BK * 2  , STAGE_BYTES = 8 * HTB, NXCD = 8, WGM = 8;

__host__ __device__ __forceinline__ int lds_byte(int r, int c) { const int st = (r >> 4) * 2 + (c >> 5), rr = r & 15, cc = c & 31, ob = rr * 64 + cc * 2; return st * 1024 + (ob ^ (((ob >> 9) & 1) << 5)); }
__host__ __device__ __forceinline__ void stage_rc(int b, int& R, int& C) { const int st = b / 1024, sb = b % 1024, swz = sb ^ (((sb >> 9) & 1) << 5); R = (st >> 1) * 16 + swz / 64; C = (st & 1) * 32 + (swz % 64) / 2; }
__host__ __device__ __forceinline__ int perm32(int rho) { const int n = rho >> 4, i = rho & 15; return 8 * (i >> 2) + 4 * n + (i & 3); }

struct Unit { int pm, pn; };
struct Gemm { const bf16_t* A; const bf16_t* Bt; int M, N, K; };

struct StaticOrder {
    int nM, nN, nwg, G, c;
    __host__ __device__ void init(int M, int N, int G_, int c_) { nM = M / BM; nN = N / BM; nwg = nM * nN; G = G_; c = c_; }
    __host__ __device__ bool next(int i, Unit& u) const {
        const long L = (long)i * G + c; if (L >= nwg) return false;
        int wgid = (int)L; { const int q = nwg / NXCD, r = nwg % NXCD, xcd = wgid % NXCD, off = wgid / NXCD; wgid = (xcd < r ? xcd * (q + 1) : r * (q + 1) + (xcd - r) * q) + off; }
        const int nig = WGM * nN, gid = wgid / nig, fm = gid * WGM, gsz = (nM - fm) < WGM ? (nM - fm) : WGM;
        u.pm = fm + ((wgid % nig) % gsz); u.pn = (wgid % nig) / gsz; return true;
    }
    __device__ __forceinline__ void a_ready(const Unit&) const {}
    __device__ __forceinline__ void done(const Unit&) const {}
};

typedef __bf16 bf16v2_t __attribute__((ext_vector_type(2)));
typedef float f32v2_t __attribute__((ext_vector_type(2)));
__device__ __forceinline__ unsigned cvt_pk_bf16(float lo, float hi) { const f32v2_t v = {lo, hi}; const bf16v2_t b = __builtin_convertvector(v, bf16v2_t); return __builtin_bit_cast(unsigned, b); }

struct EpiBf16 {
    static constexpr bool PERM = true, AFTER_DRAIN = false;
    bf16_t* O; int ldc;
    __device__ __forceinline__ void operator()(const f32x4 (&acc)[2][2][4][2], const Unit& u, int wr, int wc, int fr, int fq) const {
        const int row0 = u.pm * BM + wr * 64 + fr; const int col0 = u.pn * BM + wc * 32 + 8 * fq;
#pragma unroll
        for (int ai = 0; ai < 2; ++ai)
#pragma unroll
            for (int m = 0; m < 4; ++m) { bf16_t* rowp = O + (size_t)(row0 + ai * HALF + m * 16) * ldc + col0;
#pragma unroll
                for (int bj = 0; bj < 2; ++bj) { const f32x4 v0 = acc[ai][bj][m][0], v1 = acc[ai][bj][m][1];
                    u32x4 w; w.x = cvt_pk_bf16(v0[0], v0[1]); w.y = cvt_pk_bf16(v0[2], v0[3]); w.z = cvt_pk_bf16(v1[0], v1[1]); w.w = cvt_pk_bf16(v1[2], v1[3]);
                    *(u32x4*)(rowp + bj * HALF) = w; } }
    }
};
__device__ __forceinline__ float silu_f(float x) { return x * __builtin_amdgcn_rcpf(1.0f + __builtin_amdgcn_exp2f(-1.4426950408889634f * x)); }
struct EpiSwiglu {
    static constexpr bool PERM = true, AFTER_DRAIN = false;
    bf16_t* O; int ldc;
    __device__ __forceinline__ void operator()(const f32x4 (&acc)[2][2][4][2], const Unit& u, int wr, int wc, int fr, int fq) const {
        const int row0 = u.pm * BM + wr * 64 + fr; const int col0 = u.pn * HALF + wc * 32 + 8 * fq;
#pragma unroll
        for (int ai = 0; ai < 2; ++ai)
#pragma unroll
            for (int m = 0; m < 4; ++m) { bf16_t* rowp = O + (size_t)(row0 + ai * HALF + m * 16) * ldc + col0;
                const f32x4 g0 = acc[ai][0][m][0], g1 = acc[ai][0][m][1], u0 = acc[ai][1][m][0], u1 = acc[ai][1][m][1];
                float r[8];
#pragma unroll
                for (int e = 0; e < 4; ++e) { r[e] = silu_f(g0[e]) * u0[e]; r[4 + e] = silu_f(g1[e]) * u1[e]; }
                u32x4 w; w.x = cvt_pk_bf16(r[0], r[1]); w.y = cvt_pk_bf16(r[2], r[3]); w.z = cvt_pk_bf16(r[4], r[5]); w.w = cvt_pk_bf16(r[6], r[7]);
                *(u32x4*)rowp = w; }
    }
};
struct EpiF32Ssq {
    static constexpr bool PERM = false, AFTER_DRAIN = false;
    float* C; int ldc; float* ssq;
    __device__ __forceinline__ void operator()(const f32x4 (&acc)[2][2][4][2], const Unit& u, int wr, int wc, int fr, int fq) const {
        const int row0 = u.pm * BM + wr * 64 + fr, col0 = u.pn * BM + wc * 32 + 4 * fq;
#pragma unroll
        for (int ai = 0; ai < 2; ++ai)
#pragma unroll
            for (int m = 0; m < 4; ++m) { const int row = row0 + ai * HALF + m * 16; float* rowp = C + (size_t)row * ldc + col0; float s = 0.f;
#pragma unroll
                for (int bj = 0; bj < 2; ++bj)
#pragma unroll
                    for (int n = 0; n < 2; ++n) { const f32x4 v = acc[ai][bj][m][n]; *(f32x4*)(rowp + bj * HALF + n * 16) = v; s += (v[0] * v[0] + v[1] * v[1]) + (v[2] * v[2] + v[3] * v[3]); }
                s += __shfl_xor(s, 16); s += __shfl_xor(s, 32);
                if (fq == 0) ssq[row * 32 + u.pn * 4 + wc] = s; }
    }
};

template <class Epi, class Sched, bool ALIGN_EPI = false, bool SP2 = false>
__device__ __forceinline__ void gemm_phase(PG8_LAS unsigned char* lds, const Gemm g, const Sched& S, const Epi& E) {
    const int tid = threadIdx.x, wid = __builtin_amdgcn_readfirstlane(tid >> 6), lane = tid & 63, wr = wid >> 2, wc = wid & 3, fr = lane & 15, fq = lane >> 4;
    const int K = g.K, nt = K / BK;
    unsigned voffA[2], voffB[2];
#pragma unroll
    for (int i = 0; i < 2; ++i) { int R, C; stage_rc(tid * 16 + i * 8192, R, C); const int Rb = Epi::PERM ? ((R & ~31) + perm32(R & 31)) : R;
        voffA[i] = (unsigned)(R * K + C) * 2u; voffB[i] = (unsigned)(Rb * K + C) * 2u; }
    const size_t kstep = (size_t)(BK * 2);
    const size_t hstep = (size_t)HALF * K * 2;
    const size_t tstep = 2 * hstep;
    const unsigned ldsw = (unsigned)wid * 1024u;
    const int aoff = lds_byte(wr * 64 + fr, fq * 8), boff = lds_byte(wc * 32 + fr, fq * 8);
#define PG8_SA(b, h) (((b) * 2 + (h)) * HTB)
#define PG8_SB(b, h) ((4 + (b) * 2 + (h)) * HTB)
#define PG8_STAGE(bufoff, gbase, voff) do { _Pragma("unroll") for (int _i = 0; _i < 2; ++_i) \
        __builtin_amdgcn_global_load_lds((const unsigned*)((const char*)(gbase) + (voff)[_i]), (PG8_LAS unsigned*)(lds + (bufoff) + ldsw + _i * 8192), 16, 0, 0); } while (0)
#define PG8_LDA(dst, b, h) do { _Pragma("unroll") for (int m = 0; m < 4; ++m) _Pragma("unroll") for (int k = 0; k < 2; ++k) dst[m][k] = *(const PG8_LAS bf16x8*)(lds + PG8_SA(b, h) + aoff + m * 2048 + k * 1024); } while (0)
#define PG8_LDB(dst, b, h) do { _Pragma("unroll") for (int n = 0; n < 2; ++n) _Pragma("unroll") for (int k = 0; k < 2; ++k) dst[n][k] = *(const PG8_LAS bf16x8*)(lds + PG8_SB(b, h) + boff + n * 2048 + k * 1024); } while (0)
#define PG8_MMA(ai, bj, At, Bt) do { __builtin_amdgcn_s_setprio(1); _Pragma("unroll") for (int m = 0; m < 4; ++m) _Pragma("unroll") for (int n = 0; n < 2; ++n) _Pragma("unroll") for (int k = 0; k < 2; ++k) \
        acc[ai][bj][m][n] = __builtin_amdgcn_mfma_f32_16x16x32_bf16(Bt[n][k], At[m][k], acc[ai][bj][m][n], 0, 0, 0); __builtin_amdgcn_s_setprio(0); } while (0)
#define PG8_WAIT_V(n) asm volatile("s_waitcnt vmcnt(" #n ")" ::: "memory")
#define PG8_WAIT_L(n) asm volatile("s_waitcnt lgkmcnt(" #n ")" ::: "memory")
#define PG8_BAR __builtin_amdgcn_s_barrier()
#define PG8_SCHED __builtin_amdgcn_sched_barrier(0)
    Unit cur, nxt; int ui = 0;
    if (!S.next(0, cur)) return;
    f32x4 acc[2][2][4][2];
#pragma unroll
    for (int a = 0; a < 2; ++a)
#pragma unroll
        for (int b = 0; b < 2; ++b)
#pragma unroll
            for (int m = 0; m < 4; ++m)
#pragma unroll
                for (int n = 0; n < 2; ++n) acc[a][b][m][n] = (f32x4){0.f, 0.f, 0.f, 0.f};
    bf16x8 At[4][2], B0[2][2], B1[2][2];
    const char* cA = (const char*)g.A + (size_t)cur.pm * tstep; const char* cB = (const char*)g.Bt + (size_t)cur.pn * tstep;
    S.a_ready(cur);
    if constexpr (SP2) {
        PG8_STAGE(PG8_SB(0, 0), cB, voffB); PG8_STAGE(PG8_SB(0, 1), cB + hstep, voffB); PG8_STAGE(PG8_SA(0, 0), cA, voffA); PG8_STAGE(PG8_SA(0, 1), cA + hstep, voffA);
        if (wr == 1) PG8_BAR;
        PG8_WAIT_V(2); PG8_BAR;
        PG8_STAGE(PG8_SB(1, 0), cB + kstep, voffB); PG8_STAGE(PG8_SA(1, 0), cA + kstep, voffA); PG8_STAGE(PG8_SB(1, 1), cB + hstep + kstep, voffB);
        PG8_WAIT_V(6); PG8_BAR;
    } else {
        PG8_STAGE(PG8_SB(0, 0), cB, voffB); PG8_STAGE(PG8_SA(0, 0), cA, voffA); PG8_STAGE(PG8_SB(0, 1), cB + hstep, voffB); PG8_STAGE(PG8_SA(0, 1), cA + hstep, voffA);
        if (wr == 1) PG8_BAR;
        PG8_WAIT_V(4); PG8_BAR;
        PG8_STAGE(PG8_SB(1, 0), cB + kstep, voffB); PG8_STAGE(PG8_SA(1, 0), cA + kstep, voffA); PG8_STAGE(PG8_SB(1, 1), cB + hstep + kstep, voffB);
        PG8_WAIT_V(6); PG8_BAR;
    }
    for (;;) {
        const bool has_next = S.next(ui + 1, nxt);
        const char* nA = has_next ? (const char*)g.A + (size_t)nxt.pm * tstep : cA; const char* nB = has_next ? (const char*)g.Bt + (size_t)nxt.pn * tstep : cB;
        for (int t = 0; t < nt; t += 2) {
            const bool last = (t == nt - 2);
            const char* a1 = cA + (size_t)(t + 1) * kstep;
            const char* a2 = last ? nA : cA + (size_t)(t + 2) * kstep; const char* b2 = last ? nB : cB + (size_t)(t + 2) * kstep;
            const char* a3 = a2 + kstep; const char* b3 = b2 + kstep;
            if (last && has_next) S.a_ready(nxt);
            if constexpr (SP2) {
            PG8_LDB(B0, 0, 0); PG8_LDB(B1, 0, 1); PG8_SCHED; PG8_LDA(At, 0, 0); PG8_STAGE(PG8_SA(1, 1), a1 + hstep, voffA);
            PG8_WAIT_V(8); PG8_WAIT_L(0); PG8_BAR; PG8_MMA(0, 0, At, B0); PG8_MMA(0, 1, At, B1); PG8_BAR; PG8_SCHED;
            PG8_LDA(At, 0, 1); PG8_STAGE(PG8_SB(0, 0), b2, voffB); PG8_STAGE(PG8_SB(0, 1), b2 + hstep, voffB); PG8_STAGE(PG8_SA(0, 0), a2, voffA);
            PG8_WAIT_V(8); PG8_WAIT_L(0); PG8_BAR; PG8_MMA(1, 0, At, B0); PG8_MMA(1, 1, At, B1); PG8_BAR; PG8_SCHED;
            PG8_LDB(B0, 1, 0); PG8_LDB(B1, 1, 1); PG8_SCHED; PG8_LDA(At, 1, 0); PG8_STAGE(PG8_SA(0, 1), a2 + hstep, voffA);
            PG8_WAIT_V(8); PG8_WAIT_L(0); PG8_BAR; PG8_MMA(0, 0, At, B0); PG8_MMA(0, 1, At, B1); PG8_BAR; PG8_SCHED;
            PG8_LDA(At, 1, 1); PG8_STAGE(PG8_SB(1, 0), b3, voffB); PG8_STAGE(PG8_SB(1, 1), b3 + hstep, voffB); PG8_STAGE(PG8_SA(1, 0), a3, voffA);
            PG8_WAIT_V(8); PG8_WAIT_L(0); PG8_BAR; PG8_MMA(1, 0, At, B0); PG8_MMA(1, 1, At, B1); PG8_BAR; PG8_SCHED;
            } else {
            PG8_LDB(B0, 0, 0); PG8_SCHED; PG8_LDA(At, 0, 0); PG8_STAGE(PG8_SA(1, 1), a1 + hstep, voffA);
            PG8_WAIT_L(8); PG8_BAR; PG8_WAIT_L(0); PG8_MMA(0, 0, At, B0); PG8_BAR; PG8_SCHED;
            PG8_LDB(B1, 0, 1); PG8_STAGE(PG8_SB(0, 0), b2, voffB);
            PG8_BAR; PG8_WAIT_L(0); PG8_MMA(0, 1, At, B1); PG8_BAR;
            PG8_LDA(At, 0, 1); PG8_STAGE(PG8_SA(0, 0), a2, voffA);
            PG8_BAR; PG8_WAIT_L(0); PG8_MMA(1, 0, At, B0); PG8_BAR; PG8_SCHED;
            PG8_STAGE(PG8_SB(0, 1), b2 + hstep, voffB);
            PG8_WAIT_V(6); PG8_BAR; PG8_MMA(1, 1, At, B1); PG8_BAR;
            PG8_LDB(B0, 1, 0); PG8_SCHED; PG8_LDA(At, 1, 0); PG8_STAGE(PG8_SA(0, 1), a2 + hstep, voffA);
            PG8_WAIT_L(8); PG8_BAR; PG8_WAIT_L(0); PG8_MMA(0, 0, At, B0); PG8_BAR; PG8_SCHED;
            PG8_LDB(B1, 1, 1); PG8_STAGE(PG8_SB(1, 0), b3, voffB);
            PG8_BAR; PG8_WAIT_L(0); PG8_MMA(0, 1, At, B1); PG8_BAR;
            PG8_LDA(At, 1, 1); PG8_STAGE(PG8_SA(1, 0), a3, voffA);
            PG8_BAR; PG8_WAIT_L(0); PG8_MMA(1, 0, At, B0); PG8_BAR; PG8_SCHED;
            PG8_STAGE(PG8_SB(1, 1), b3 + hstep, voffB);
            PG8_WAIT_V(6); PG8_BAR; PG8_MMA(1, 1, At, B1); PG8_BAR;
            }
        }
        if constexpr (ALIGN_EPI) { if (wr == 0) PG8_BAR; }
        if constexpr (!Epi::AFTER_DRAIN) { E(acc, cur, wr, wc, fr, fq); S.done(cur); }
        if (!has_next) break;
#pragma unroll
        for (int a = 0; a < 2; ++a)
#pragma unroll
            for (int b = 0; b < 2; ++b)
#pragma unroll
                for (int m = 0; m < 4; ++m)
#pragma unroll
                    for (int n = 0; n < 2; ++n) acc[a][b][m][n] = (f32x4){0.f, 0.f, 0.f, 0.f};
        cur = nxt; cA = nA; cB = nB; ++ui;
        if constexpr (ALIGN_EPI) { if (wr == 1) PG8_BAR; }
    }
    PG8_WAIT_V(0);
    if constexpr (!ALIGN_EPI) { if (wr == 0) PG8_BAR; }
    PG8_BAR;
#undef PG8_SA
#undef PG8_SB
#undef PG8_STAGE
#undef PG8_LDA
#undef PG8_LDB
#undef PG8_MMA
#undef PG8_WAIT_V
#undef PG8_WAIT_L
#undef PG8_BAR
#undef PG8_SCHED
}
}

#ifndef DBG_HI
#define DBG_HI 12
#define DBG_MODE 0
#define DBG_COL0 0
#endif
#ifndef PG8_SP2
#define PG8_SP2 true
#endif
#ifndef PG8_ALIGN
#define PG8_ALIGN true
#endif

constexpr int NWAVES = 8;
constexpr int N_LAUNCHES = MK_N_LAUNCHES;
constexpr int PER_PHASE = 12;

constexpr int BATCH = 4, SEQ = 2048, D = 2048, FF = 5632, NGU = 2 * FF, NIN = 6656;
constexpr int M = BATCH * SEQ;
constexpr int HW = 1024, HH = 8, HD = 128;
constexpr int AH = 8, AKV = 2;
constexpr int CQH = 0, CIH = 1024, CFF = 2048, CFB = 3072, CGH = 4096, CQA = 5120, CKA = 6144, CVA = 6400;
constexpr float EPS = 1e-6f;

constexpr size_t MiB = 1u << 20;
constexpr size_t WS_CTL = 0, CTL_ZERO_BYTES = 1 * MiB;
constexpr size_t WS_W1GU = 2 * MiB, WS_W1D = 46 * MiB, WS_WIN = 68 * MiB, WS_WOUT = 94 * MiB, WS_W2GU = 102 * MiB, WS_W2D = 146 * MiB;
constexpr size_t WS_H = 168 * MiB;
constexpr size_t WS_ACT = 200 * MiB;
constexpr size_t WS_FF = 304 * MiB;
constexpr size_t WS_END = 368 * MiB;
constexpr int CW_BAR = 4096;
constexpr size_t WS_SSQ = 1 * MiB;

constexpr int RING_OFF = 0, RING_BYTES = 131072;
constexpr int LDSCTL_OFF = RING_BYTES, MISC_OFF = LDSCTL_OFF + 320;
constexpr int LDS_BYTES = 147456;

#define GAS __attribute__((address_space(1)))
#define LAS __attribute__((address_space(3)))
typedef unsigned short bf16;
typedef unsigned v4u __attribute__((ext_vector_type(4)));
typedef unsigned v2u __attribute__((ext_vector_type(2)));
typedef float f32x4 __attribute__((ext_vector_type(4)));
typedef short bf16x8 __attribute__((ext_vector_type(8)));
typedef short bf16x4 __attribute__((ext_vector_type(4)));
typedef GAS unsigned gu32;
#define RLX_AGENT __ATOMIC_RELAXED, __HIP_MEMORY_SCOPE_AGENT
#define LDS_WAIT() asm volatile("s_waitcnt lgkmcnt(0)" ::: "memory")
#define VM_WAIT() asm volatile("s_waitcnt vmcnt(0)" ::: "memory")
__device__ __forceinline__ unsigned f2bf(float f) { unsigned u = __builtin_bit_cast(unsigned, f); return (u + 0x7fffu + ((u >> 16) & 1u)) >> 16; }
__device__ __forceinline__ unsigned pk2(float lo, float hi) { return pg8::cvt_pk_bf16(lo, hi); }
__device__ __forceinline__ float bf_lo(unsigned u) { return __builtin_bit_cast(float, u << 16); }
__device__ __forceinline__ float bf_hi(unsigned u) { return __builtin_bit_cast(float, u & 0xffff0000u); }

#define XB_TMO      128
#define XB_XCNT(j)  (256  + 64 * (j))
#define XB_XSUB(j)  (1280 + 64 * (j))
#define XB_XGEN(j)  (2304 + 64 * (j))
#define XB_TOP      3328
#define XB_TOPGEN   3392
#define XCD_BAR_WORDS 3456
#define XB_SPIN_CAP (1u << 20)

__device__ __forceinline__ unsigned xb_ld(unsigned* p)              { return __hip_atomic_load(p, __ATOMIC_RELAXED, __HIP_MEMORY_SCOPE_AGENT); }
__device__ __forceinline__ unsigned xb_add(unsigned* p, unsigned v) { return __hip_atomic_fetch_add(p, v, __ATOMIC_RELAXED, __HIP_MEMORY_SCOPE_AGENT); }
__device__ __forceinline__ unsigned xb_xcc_id() { return (unsigned)__builtin_amdgcn_s_getreg((3 << 11) | 20) & 0xFu; }
#define XB_SPIN(cond, bar) do { unsigned _sp = 0; while (cond) { __builtin_amdgcn_s_sleep(1); \
    if ((++_sp & 255u) == 0u) { if (xb_ld(&(bar)[XB_TMO])) break; if (_sp > XB_SPIN_CAP) { atomicAdd(&(bar)[XB_TMO], 1u); break; } } } } while (0)

struct XcdBarrier { unsigned* bar; unsigned x; volatile LAS unsigned* st; };

__device__ __forceinline__ XcdBarrier xcd_barrier_post(unsigned* bar, volatile LAS unsigned* st) {
    XcdBarrier b; b.bar = bar; b.x = xb_xcc_id(); b.st = st;
    if (threadIdx.x == 0) (void)xb_add(&bar[XB_XCNT(b.x)], 1u);
    return b;
}
__device__ __forceinline__ void xcd_barrier_complete(unsigned* bar, unsigned x, unsigned& nloc, unsigned& nx) {
    const unsigned G = gridDim.x * gridDim.y * gridDim.z;
    unsigned sum, cnt, mine, sp = 0u;
    for (;;) {
        sum = 0u; cnt = 0u; mine = 0u;
#pragma unroll
        for (unsigned j = 0; j < 16; ++j) { const unsigned c = xb_ld(&bar[XB_XCNT(j)]); sum += c; cnt += (c > 0u) ? 1u : 0u; mine = (j == x) ? c : mine; }
        if (sum == G) break;
        __builtin_amdgcn_s_sleep(1);
        if ((++sp & 255u) == 0u) { if (xb_ld(&bar[XB_TMO])) break; if (sp > XB_SPIN_CAP) { atomicAdd(&bar[XB_TMO], 1u); break; } }
    }
    nloc = mine > 0u ? mine : 1u; nx = cnt > 0u ? cnt : 1u;
}
__device__ __forceinline__ void xcd_barrier(const XcdBarrier& b) {
    asm volatile("s_waitcnt vmcnt(0)" ::: "memory");
    __syncthreads();
    if (threadIdx.x == 0) {
        unsigned* bar = b.bar;
        __builtin_amdgcn_s_waitcnt(0);
        unsigned nloc = b.st[0], nx = b.st[1];
        if (nloc == 0u) { xcd_barrier_complete(bar, b.x, nloc, nx); b.st[0] = nloc; b.st[1] = nx; }
        const unsigned old = xb_add(&bar[XB_XSUB(b.x)], 1u);
        const unsigned gen = old / nloc;
        if (old + 1u == (gen + 1u) * nloc) {
            __builtin_amdgcn_fence(__ATOMIC_RELEASE, "agent");
            asm volatile("s_waitcnt vmcnt(0)" ::: "memory");
            const unsigned og = xb_add(&bar[XB_TOP], 1u);
            const unsigned tg = og / nx;
            if (og + 1u == (tg + 1u) * nx) xb_add(&bar[XB_TOPGEN], 1u);
            else XB_SPIN(xb_ld(&bar[XB_TOPGEN]) == tg, bar);
            __builtin_amdgcn_fence(__ATOMIC_ACQUIRE, "agent");
            xb_add(&bar[XB_XGEN(b.x)], 1u);
            asm volatile("s_waitcnt vmcnt(0)" ::: "memory");
        } else {
            XB_SPIN(xb_ld(&bar[XB_XGEN(b.x)]) == gen, bar);
            __builtin_amdgcn_fence(__ATOMIC_ACQUIRE, "agent");
            asm volatile("s_waitcnt vmcnt(0)" ::: "memory");
        }
    }
    __syncthreads();
}

struct Frame {
    LAS unsigned char* lds;
    volatile LAS unsigned* MISC;
    gu32* ctl;
    int tid, lane, wave;
    int vcu, G;
    const float* x; float* out;
    const float *pre1, *post1, *w1gu, *w1d, *prem, *postm, *win, *lbf, *lbb, *ognorm, *sink, *wout, *pre2, *post2, *w2gu, *w2d, *relb;
    bf16 *W1GU, *W1D, *WIN, *WOUT, *W2GU, *W2D;
    bf16 *H, *ACT; float* FFB; float* ssq;
};

__device__ __forceinline__ float wave_sum(float v) {
#pragma unroll
    for (int o = 1; o < 64; o <<= 1) v += __shfl_xor(v, o);
    return v;
}
template <bool GU>
__device__ __forceinline__ void p0_transpose_item(const float* W, int K, int N, bf16* WT, LAS float* scr, int item, int lane) {
    const int nblk = N / 32, kb = item / nblk, nb = item % nblk, k0 = 64 * kb, n0 = 32 * nb;
    int r0 = n0;
    if (GU) { const int half = N / 2; const int nn = n0 < half ? n0 : n0 - half; r0 = 256 * (nn / 128) + (nn % 128) + (n0 < half ? 0 : 128); }
#pragma unroll 8
    for (int i = 0; i < 32; ++i) { const int kk = 2 * i + (lane >> 5); scr[kk * 33 + (lane & 31)] = W[(size_t)(k0 + kk) * N + n0 + (lane & 31)]; }
    LDS_WAIT(); asm volatile("" ::: "memory");
    const int c = lane & 7;
#pragma unroll
    for (int j = 0; j < 4; ++j) { const int n = (lane >> 3) + 8 * j; const LAS float* s = scr + (8 * c) * 33 + n;
        v4u o; o.x = pk2(s[0 * 33], s[1 * 33]); o.y = pk2(s[2 * 33], s[3 * 33]); o.z = pk2(s[4 * 33], s[5 * 33]); o.w = pk2(s[6 * 33], s[7 * 33]);
        *(GAS v4u*)(WT + (size_t)(r0 + n) * K + k0 + 8 * c) = o; }
    LDS_WAIT(); asm volatile("" ::: "memory");
}
__device__ __forceinline__ void rms_row_to_bf16(int lane, const float* xrow, const float* gain, bf16* orow) {
    const GAS f32x4* xr = (const GAS f32x4*)xrow + lane; const GAS f32x4* gr = (const GAS f32x4*)gain + lane;
    f32x4 v[8]; float s = 0.f;
#pragma unroll
    for (int j = 0; j < 8; ++j) { v[j] = xr[64 * j]; s += (v[j].x * v[j].x + v[j].y * v[j].y) + (v[j].z * v[j].z + v[j].w * v[j].w); }
    const float rs = 1.0f / sqrtf(wave_sum(s) * (1.f / D) + EPS);
    GAS v2u* o8 = (GAS v2u*)orow + lane;
#pragma unroll
    for (int j = 0; j < 8; ++j) { const f32x4 g = gr[64 * j]; v2u o; o.x = pk2(v[j].x * rs * g.x, v[j].y * rs * g.y); o.y = pk2(v[j].z * rs * g.z, v[j].w * rs * g.w); o8[64 * j] = o; }
}
__device__ __forceinline__ void p0_prologue(Frame& F) {
    LAS float* scr = (LAS float*)(F.lds + RING_OFF + F.wave * 16384);
    const int gw = F.vcu * NWAVES + F.wave, NGW = F.G * NWAVES;
    constexpr int I_GU = (D / 64) * (NGU / 32), I_DN = (FF / 64) * (D / 32), I_IN = (D / 64) * (NIN / 32), I_OUT = (D / 64) * (D / 32);
    constexpr int NITEMS = 2 * I_GU + 2 * I_DN + I_IN + I_OUT;
    for (int it = gw; it < NITEMS; it += NGW) {
        int r = it;
        if (r < I_GU) { p0_transpose_item<true>(F.w1gu, D, NGU, F.W1GU, scr, r, F.lane); continue; } r -= I_GU;
        if (r < I_DN) { p0_transpose_item<false>(F.w1d, FF, D, F.W1D, scr, r, F.lane); continue; } r -= I_DN;
        if (r < I_IN) { p0_transpose_item<false>(F.win, D, NIN, F.WIN, scr, r, F.lane); continue; } r -= I_IN;
        if (r < I_OUT) { p0_transpose_item<false>(F.wout, D, D, F.WOUT, scr, r, F.lane); continue; } r -= I_OUT;
        if (r < I_GU) { p0_transpose_item<true>(F.w2gu, D, NGU, F.W2GU, scr, r, F.lane); continue; } r -= I_GU;
        p0_transpose_item<false>(F.w2d, FF, D, F.W2D, scr, r, F.lane);
    }
    for (int m = gw; m < M; m += NGW) rms_row_to_bf16(F.lane, F.x + (size_t)m * D, F.pre1, F.H + (size_t)m * D);
}
__device__ __forceinline__ void ew_phase(Frame& F, const float* xi, const float* ff, const float* ssq, const float* post, float coef, float* xo, const float* pre, bf16* h) {
    const int gw = F.vcu * NWAVES + F.wave, NGW = F.G * NWAVES;
    for (int m = gw; m < M; m += NGW) {
        const float part = (F.lane < 32) ? ssq[m * 32 + F.lane] : 0.f;
        const float rs = coef / sqrtf(wave_sum(part) * (1.f / D) + EPS);
        const GAS f32x4* xr = (const GAS f32x4*)(xi + (size_t)m * D) + F.lane; const GAS f32x4* fr = (const GAS f32x4*)(ff + (size_t)m * D) + F.lane;
        const GAS f32x4* pr = (const GAS f32x4*)post + F.lane; GAS f32x4* orow = (GAS f32x4*)(xo + (size_t)m * D) + F.lane;
        f32x4 v[8]; float s = 0.f;
#pragma unroll
        for (int j = 0; j < 8; ++j) { const f32x4 a = xr[64 * j], b = fr[64 * j], g = pr[64 * j]; v[j] = a + b * g * rs; s += (v[j].x * v[j].x + v[j].y * v[j].y) + (v[j].z * v[j].z + v[j].w * v[j].w); orow[64 * j] = v[j]; }
        if (h) {
            const float r2 = 1.0f / sqrtf(wave_sum(s) * (1.f / D) + EPS);
            const GAS f32x4* gr = (const GAS f32x4*)pre + F.lane; GAS v2u* o8 = (GAS v2u*)(h + (size_t)m * D) + F.lane;
#pragma unroll
            for (int j = 0; j < 8; ++j) { const f32x4 g = gr[64 * j]; v2u o; o.x = pk2(v[j].x * r2 * g.x, v[j].y * r2 * g.y); o.y = pk2(v[j].z * r2 * g.z, v[j].w * r2 * g.w); o8[64 * j] = o; }
        }
    }
}

constexpr int HG_QD = 0, HG_KD = 17408, HG_KT = 34816, HG_VT0 = 53248, HG_VT1 = 57856, HG_PS = 62464, HG_ST0 = 71680, HG_ST1 = 80384, HG_DEC = 89088, HG_END = 89600;
__device__ __forceinline__ bf16x8 ldsfrag(LAS unsigned char* base, int row, int stride, int kbyte) { return *(const LAS bf16x8*)(base + row * stride + kbyte); }
__device__ __forceinline__ void hgrn_phase(Frame& F, const bf16* P, float* OF) {
    LAS unsigned char* L = F.lds + RING_OFF;
    const int w = F.wave, l = F.lane, g = l >> 4, fr = l & 15;
    for (int item = F.vcu; item < 256; item += F.G) {
        const int seq = item >> 2, vs = item & 3, b = seq >> 4, h = (seq >> 1) & 7, dir = seq & 1;
        const float* lbraw = dir ? F.lbb : F.lbf;
        float lb[16];
#pragma unroll
        for (int i = 0; i < 16; ++i) { const float a0 = lbraw[h * 128 + 16 * w + i], a1 = lbraw[HW + h * 128 + 16 * w + i]; lb[i] = 1.0f / (1.0f + __expf(a1 - a0)); }
        f32x4 S[2] = {(f32x4){0.f, 0.f, 0.f, 0.f}, (f32x4){0.f, 0.f, 0.f, 0.f}};
        for (int u = F.tid; u < 8704 / 4; u += NWAVES * 64) ((LAS unsigned*)(L + HG_ST0))[u] = 0u;
        float* O = OF + (size_t)dir * M * HW;
        const int colq = CQH + h * 128 + 16 * w, colz = (dir ? CFB : CFF) + h * 128 + 16 * w, colv = CIH + h * 128 + 32 * vs + 8 * (w & 3);
        v4u rq0, rq1, rz0, rz1, rv;
        {   const int cn = dir ? 31 : 0; const int tok = cn * 64 + (dir ? 63 - l : l); const bf16* row = P + (size_t)(b * SEQ + tok) * NIN;
            rq0 = *(const GAS v4u*)(row + colq); rq1 = *(const GAS v4u*)(row + colq + 8); rz0 = *(const GAS v4u*)(row + colz); rz1 = *(const GAS v4u*)(row + colz + 8);
            rv = (v4u){0u, 0u, 0u, 0u}; if (w < 4) rv = *(const GAS v4u*)(row + colv); }
        for (int n = 0; n < 32; ++n) {
            const int cur = n & 1;
            const v4u q0 = rq0, q1 = rq1, z0 = rz0, z1 = rz1, vv = rv;
            if (n + 1 < 32) { const int cn = dir ? 31 - (n + 1) : (n + 1); const int tok = cn * 64 + (dir ? 63 - l : l); const bf16* row = P + (size_t)(b * SEQ + tok) * NIN;
                rq0 = *(const GAS v4u*)(row + colq); rq1 = *(const GAS v4u*)(row + colq + 8); rz0 = *(const GAS v4u*)(row + colz); rz1 = *(const GAS v4u*)(row + colz + 8);
                if (w < 4) rv = *(const GAS v4u*)(row + colv); }
            float qf[16], zf[16];
#pragma unroll
            for (int i = 0; i < 4; ++i) { qf[2 * i] = bf_lo(q0[i]); qf[2 * i + 1] = bf_hi(q0[i]); qf[8 + 2 * i] = bf_lo(q1[i]); qf[8 + 2 * i + 1] = bf_hi(q1[i]);
                                          zf[2 * i] = bf_lo(z0[i]); zf[2 * i + 1] = bf_hi(z0[i]); zf[8 + 2 * i] = bf_lo(z1[i]); zf[8 + 2 * i + 1] = bf_hi(z1[i]); }
            float kk[16], cum[16];
#pragma unroll
            for (int i = 0; i < 16; ++i) { const float sig = 1.0f / (1.0f + __expf(-zf[i])); const float f = lb[i] + (1.0f - lb[i]) * sig; kk[i] = 1.0f - f; cum[i] = __logf(f); }
#pragma unroll
            for (int o = 1; o < 64; o <<= 1) {
#pragma unroll
                for (int i = 0; i < 16; ++i) { const float t = __shfl_up(cum[i], o); if (l >= o) cum[i] += t; }
            }
            float qd[16], kd[16], kt[16];
#pragma unroll
            for (int i = 0; i < 16; ++i) { const float last = __shfl(cum[i], 63); qd[i] = qf[i] * __expf(cum[i]); kd[i] = kk[i] * __expf(-cum[i]); kt[i] = kk[i] * __expf(last - cum[i]); }
            {   v4u a, c2;
                a.x = pk2(qd[0], qd[1]); a.y = pk2(qd[2], qd[3]); a.z = pk2(qd[4], qd[5]); a.w = pk2(qd[6], qd[7]);
                c2.x = pk2(qd[8], qd[9]); c2.y = pk2(qd[10], qd[11]); c2.z = pk2(qd[12], qd[13]); c2.w = pk2(qd[14], qd[15]);
                *(LAS v4u*)(L + HG_QD + l * 272 + 32 * w) = a; *(LAS v4u*)(L + HG_QD + l * 272 + 32 * w + 16) = c2;
                a.x = pk2(kd[0], kd[1]); a.y = pk2(kd[2], kd[3]); a.z = pk2(kd[4], kd[5]); a.w = pk2(kd[6], kd[7]);
                c2.x = pk2(kd[8], kd[9]); c2.y = pk2(kd[10], kd[11]); c2.z = pk2(kd[12], kd[13]); c2.w = pk2(kd[14], kd[15]);
                *(LAS v4u*)(L + HG_KD + l * 272 + 32 * w) = a; *(LAS v4u*)(L + HG_KD + l * 272 + 32 * w + 16) = c2; }
#pragma unroll
            for (int i = 0; i < 16; ++i) *(LAS unsigned short*)(L + HG_KT + (16 * w + i) * 144 + 2 * l) = (unsigned short)f2bf(kt[i]);
            if (l == 63) {
#pragma unroll
                for (int i = 0; i < 16; ++i) *(LAS float*)(L + HG_DEC + (16 * w + i) * 4) = __expf(cum[i]);
            }
            if (w < 4) { LAS unsigned char* VT = L + (cur ? HG_VT1 : HG_VT0);
#pragma unroll
                for (int e = 0; e < 4; ++e) { *(LAS unsigned short*)(VT + (8 * w + 2 * e) * 144 + 2 * l) = (unsigned short)(vv[e] & 0xffffu); *(LAS unsigned short*)(VT + (8 * w + 2 * e + 1) * 144 + 2 * l) = (unsigned short)(vv[e] >> 16); } }
            __syncthreads();
            LAS unsigned char* VT = L + (cur ? HG_VT1 : HG_VT0);
            LAS unsigned char* STc = L + (cur ? HG_ST1 : HG_ST0);
            LAS unsigned char* STn = L + (cur ? HG_ST0 : HG_ST1);
            const int ct = w >> 1, sh = w & 1;
            bf16x8 qfr[4];
#pragma unroll
            for (int ks = 0; ks < 4; ++ks) qfr[ks] = ldsfrag(L + HG_QD, 16 * ct + fr, 272, 64 * ks + 16 * g);
#pragma unroll
            for (int t2 = 0; t2 < 2; ++t2) { const int st = 2 * sh + t2; f32x4 sc = (f32x4){0.f, 0.f, 0.f, 0.f};
#pragma unroll
                for (int ks = 0; ks < 4; ++ks) sc = __builtin_amdgcn_mfma_f32_16x16x32_bf16(ldsfrag(L + HG_KD, 16 * st + fr, 272, 64 * ks + 16 * g), qfr[ks], sc, 0, 0, 0);
                const int c = 16 * ct + fr, s0 = 16 * st + 4 * g;
                v2u pw; pw.x = pk2(s0 + 0 <= c ? sc[0] : 0.f, s0 + 1 <= c ? sc[1] : 0.f); pw.y = pk2(s0 + 2 <= c ? sc[2] : 0.f, s0 + 3 <= c ? sc[3] : 0.f);
                *(LAS v2u*)(L + HG_PS + c * 144 + 2 * s0) = pw; }
            f32x4 o = (f32x4){0.f, 0.f, 0.f, 0.f};
#pragma unroll
            for (int ks = 0; ks < 4; ++ks) o = __builtin_amdgcn_mfma_f32_16x16x32_bf16(ldsfrag(STc, 16 * sh + fr, 272, 64 * ks + 16 * g), qfr[ks], o, 0, 0, 0);
            {   const f32x4 d4 = *(const LAS f32x4*)(L + HG_DEC + (16 * w + 4 * g) * 4);
                bf16x8 ka[2];
#pragma unroll
                for (int k2 = 0; k2 < 2; ++k2) ka[k2] = ldsfrag(L + HG_KT, 16 * w + fr, 144, 64 * k2 + 16 * g);
#pragma unroll
                for (int vt = 0; vt < 2; ++vt) { S[vt] = S[vt] * d4;
#pragma unroll
                    for (int k2 = 0; k2 < 2; ++k2) S[vt] = __builtin_amdgcn_mfma_f32_16x16x32_bf16(ka[k2], ldsfrag(VT, 16 * vt + fr, 144, 64 * k2 + 16 * g), S[vt], 0, 0, 0);
                    v2u sw; sw.x = pk2(S[vt][0], S[vt][1]); sw.y = pk2(S[vt][2], S[vt][3]);
                    *(LAS v2u*)(STn + (16 * vt + fr) * 272 + 2 * (16 * w + 4 * g)) = sw; } }
            __syncthreads();
#pragma unroll
            for (int k2 = 0; k2 < 2; ++k2) o = __builtin_amdgcn_mfma_f32_16x16x32_bf16(ldsfrag(VT, 16 * sh + fr, 144, 64 * k2 + 16 * g), ldsfrag(L + HG_PS, 16 * ct + fr, 144, 64 * k2 + 16 * g), o, 0, 0, 0);
            {   const int cn = dir ? 31 - n : n; const int c = 16 * ct + fr; const int tok = cn * 64 + (dir ? 63 - c : c);
                *(GAS f32x4*)(O + (size_t)(b * SEQ + tok) * HW + h * 128 + 32 * vs + 16 * sh + 4 * g) = o; }
        }
        __syncthreads();
    }
}
__device__ __forceinline__ void hgrn_out_phase(Frame& F, const bf16* P, const float* OF, bf16* Y) {
    const int gw = F.vcu * NWAVES + F.wave, NGW = F.G * NWAVES, l = F.lane;
    for (int m = gw; m < M; m += NGW) {
        const GAS f32x4* a = (const GAS f32x4*)(OF + (size_t)m * HW) + l; const GAS f32x4* b2 = (const GAS f32x4*)(OF + (size_t)M * HW + (size_t)m * HW) + l;
        const GAS v2u* gp = (const GAS v2u*)(P + (size_t)m * NIN + CGH) + l; const GAS f32x4* gn = (const GAS f32x4*)F.ognorm + l;
        GAS v2u* yo = (GAS v2u*)(Y + (size_t)m * D) + l;
#pragma unroll
        for (int j = 0; j < 4; ++j) { f32x4 v = a[64 * j] + b2[64 * j]; float s = (v.x * v.x + v.y * v.y) + (v.z * v.z + v.w * v.w);
#pragma unroll
            for (int o = 1; o < 32; o <<= 1) s += __shfl_xor(s, o);
            const float rs = 1.0f / sqrtf(s * (1.f / 128.f) + EPS); const f32x4 gg = gn[64 * j]; const v2u gr = gp[64 * j];
            const float g0 = bf_lo(gr.x), g1 = bf_hi(gr.x), g2 = bf_lo(gr.y), g3 = bf_hi(gr.y);
            v2u o2; o2.x = pk2(v.x * rs * gg.x * pg8::silu_f(g0), v.y * rs * gg.y * pg8::silu_f(g1)); o2.y = pk2(v.z * rs * gg.z * pg8::silu_f(g2), v.w * rs * gg.w * pg8::silu_f(g3));
            yo[64 * j] = o2; }
    }
}

constexpr int AT_K = 0, AT_V = 34816, AT_TB = 69632, AT_END = 69632 + 1040;
__device__ __forceinline__ int t5_bucket(int rel) {
    const int n = rel < 0 ? -rel : rel; int bkt;
    if (n < 8) bkt = n; else { int j = 0; while (j < 7 && 64 * (2 << j) <= n * n) ++j; bkt = 8 + j; }
    return bkt + (rel > 0 ? 16 : 0);
}
__device__ __forceinline__ void attn_phase(Frame& F, const bf16* P, bf16* Y) {
    LAS unsigned char* L = F.lds + RING_OFF;
    const int w = F.wave, l = F.lane, g = l >> 4, fr = l & 15, tid = F.tid;
    const float scale = 0.08838834764831845f;
    for (int item = F.vcu; item < 512; item += F.G) {
        const int hq = item & 3, blk = (item >> 2) & 15, kvh = (item >> 6) & 1, b = item >> 7, h = kvh * 4 + hq;
        LAS float* TB = (LAS float*)(L + AT_TB);
        if (tid < 257) TB[tid] = F.relb[t5_bucket(tid - 128) * AH + h];
        const int qrow = b * SEQ + blk * 128 + 16 * w + fr;
        bf16x8 bq[4];
#pragma unroll
        for (int ks = 0; ks < 4; ++ks) bq[ks] = *(const GAS bf16x8*)(P + (size_t)qrow * NIN + CQA + h * 128 + 32 * ks + 8 * g);
        float mrun = F.sink[h], lrun = 1.0f;
        f32x4 ot[8];
#pragma unroll
        for (int dt = 0; dt < 8; ++dt) ot[dt] = (f32x4){0.f, 0.f, 0.f, 0.f};
        for (int jt = 0; jt < 3; ++jt) {
            const int kb = blk - 1 + jt; if (kb < 0 || kb >= 16) continue;
            const bf16* kvbase = P + (size_t)(b * SEQ + kb * 128) * NIN;
#pragma unroll
            for (int i = 0; i < 4; ++i) { const int id = tid + 512 * i; const int key = id >> 4, ch = id & 15;
                *(LAS v4u*)(L + AT_K + key * 272 + 16 * ch) = *(const GAS v4u*)(kvbase + (size_t)key * NIN + CKA + kvh * 128 + 8 * ch); }
#pragma unroll
            for (int i = 0; i < 4; ++i) { const int id = tid + 512 * i; const int key = id & 127, ch = id >> 7;
                const v4u vv = *(const GAS v4u*)(kvbase + (size_t)key * NIN + CVA + kvh * 128 + 8 * ch);
#pragma unroll
                for (int e = 0; e < 4; ++e) { *(LAS unsigned short*)(L + AT_V + (8 * ch + 2 * e) * 272 + 2 * key) = (unsigned short)(vv[e] & 0xffffu); *(LAS unsigned short*)(L + AT_V + (8 * ch + 2 * e + 1) * 272 + 2 * key) = (unsigned short)(vv[e] >> 16); } }
            __syncthreads();
            f32x4 st[8];
#pragma unroll
            for (int mt = 0; mt < 8; ++mt) { st[mt] = (f32x4){0.f, 0.f, 0.f, 0.f};
#pragma unroll
                for (int ks = 0; ks < 4; ++ks) st[mt] = __builtin_amdgcn_mfma_f32_16x16x32_bf16(ldsfrag(L + AT_K, 16 * mt + fr, 272, 64 * ks + 16 * g), bq[ks], st[mt], 0, 0, 0); }
            const int qpos = blk * 128 + 16 * w + fr; float mx = -3.0e38f;
#pragma unroll
            for (int mt = 0; mt < 8; ++mt)
#pragma unroll
                for (int r = 0; r < 4; ++r) { const int rel = kb * 128 + 16 * mt + 4 * g + r - qpos; const bool ok = rel >= -128 && rel <= 128; const int ri = ok ? rel + 128 : 128;
                    const float s = ok ? st[mt][r] * scale + TB[ri] : -1.0e30f; st[mt][r] = s; mx = fmaxf(mx, s); }
            mx = fmaxf(mx, __shfl_xor(mx, 16)); mx = fmaxf(mx, __shfl_xor(mx, 32));
            const float mnew = fmaxf(mrun, mx), alpha = __expf(mrun - mnew); mrun = mnew;
            float ls = 0.f;
#pragma unroll
            for (int mt = 0; mt < 8; ++mt)
#pragma unroll
                for (int r = 0; r < 4; ++r) { const float p = __expf(st[mt][r] - mnew); st[mt][r] = p; ls += p; }
            ls += __shfl_xor(ls, 16); ls += __shfl_xor(ls, 32);
            lrun = lrun * alpha + ls;
#pragma unroll
            for (int dt = 0; dt < 8; ++dt) ot[dt] = ot[dt] * alpha;
#pragma unroll
            for (int k2 = 0; k2 < 4; ++k2) {
                v4u pb; pb.x = pk2(st[2 * k2][0], st[2 * k2][1]); pb.y = pk2(st[2 * k2][2], st[2 * k2][3]); pb.z = pk2(st[2 * k2 + 1][0], st[2 * k2 + 1][1]); pb.w = pk2(st[2 * k2 + 1][2], st[2 * k2 + 1][3]);
                const bf16x8 pfrag = __builtin_bit_cast(bf16x8, pb);
#pragma unroll
                for (int dt = 0; dt < 8; ++dt) { const LAS unsigned char* vrow = L + AT_V + (16 * dt + fr) * 272;
                    const v2u a0 = *(const LAS v2u*)(vrow + 2 * (32 * k2 + 4 * g)), a1 = *(const LAS v2u*)(vrow + 2 * (32 * k2 + 16 + 4 * g));
                    const v4u av = (v4u){a0.x, a0.y, a1.x, a1.y};
                    ot[dt] = __builtin_amdgcn_mfma_f32_16x16x32_bf16(__builtin_bit_cast(bf16x8, av), pfrag, ot[dt], 0, 0, 0); } }
            __syncthreads();
        }
        const float inv = 1.0f / lrun;
#pragma unroll
        for (int dt = 0; dt < 8; ++dt) { v2u o2; o2.x = pk2(ot[dt][0] * inv, ot[dt][1] * inv); o2.y = pk2(ot[dt][2] * inv, ot[dt][3] * inv);
            *(GAS v2u*)(Y + (size_t)qrow * D + HW + h * 128 + 16 * dt + 4 * g) = o2; }
        __syncthreads();
    }
}

struct Args { const float* in[18]; float* out; unsigned char* ws; int ph_lo, ph_hi, li, pad; };
__global__ void __launch_bounds__(NWAVES * 64, 2) hymba_fwd(Args args) {
    extern __shared__ __attribute__((aligned(16))) unsigned char lds[];
    Frame F;
    F.lds = (LAS unsigned char*)lds;
    F.MISC = (volatile LAS unsigned*)(F.lds + MISC_OFF);
    F.tid = threadIdx.x; F.lane = F.tid & 63; F.wave = __builtin_amdgcn_readfirstlane(F.tid >> 6);
    F.G = gridDim.x; { const int bx = blockIdx.x; F.vcu = (F.G % 8 == 0) ? (bx % 8) * (F.G / 8) + bx / 8 : bx; }
    unsigned char* ws = args.ws;
    F.ctl = (gu32*)(ws + WS_CTL);
    F.x = args.in[0]; F.pre1 = args.in[1]; F.post1 = args.in[2]; F.w1gu = args.in[3]; F.w1d = args.in[4]; F.prem = args.in[5]; F.postm = args.in[6]; F.win = args.in[7];
    F.lbf = args.in[8]; F.lbb = args.in[9]; F.ognorm = args.in[10]; F.sink = args.in[11]; F.wout = args.in[12]; F.pre2 = args.in[13]; F.post2 = args.in[14];
    F.w2gu = args.in[15]; F.w2d = args.in[16]; F.relb = args.in[17]; F.out = args.out;
    F.W1GU = (bf16*)(ws + WS_W1GU); F.W1D = (bf16*)(ws + WS_W1D); F.WIN = (bf16*)(ws + WS_WIN); F.WOUT = (bf16*)(ws + WS_WOUT); F.W2GU = (bf16*)(ws + WS_W2GU); F.W2D = (bf16*)(ws + WS_W2D);
    F.H = (bf16*)(ws + WS_H); F.ACT = (bf16*)(ws + WS_ACT); F.FFB = (float*)(ws + WS_FF); F.ssq = (float*)(ws + WS_SSQ);
    for (int u = F.tid; u < (LDS_BYTES - LDSCTL_OFF) / 4; u += NWAVES * 64) ((LAS unsigned*)(F.lds + LDSCTL_OFF))[u] = 0u;
    __syncthreads();
    XcdBarrier bar; bar.bar = (unsigned*)(F.ctl + CW_BAR); bar.x = 0; bar.st = nullptr;
    if (N_LAUNCHES != PER_PHASE) bar = xcd_barrier_post((unsigned*)(F.ctl + CW_BAR), F.MISC + 8);
#define GRID_BAR() do { if (N_LAUNCHES != PER_PHASE) xcd_barrier(bar); } while (0)
    const int lo = args.ph_lo, hi = args.ph_hi;
#define IN(k) (lo <= (k) && (k) < hi)
#define BOTH(k) (IN(k) && IN((k) + 1))
    typedef pg8::StaticOrder SO;
    if (IN(0)) { p0_prologue(F); if (BOTH(0)) GRID_BAR(); }
    if (IN(1)) { pg8::Gemm gm{F.H, F.W1GU, M, NGU, D}; SO S; S.init(M, NGU, F.G, (int)blockIdx.x); pg8::EpiSwiglu E{F.ACT, FF};
        pg8::gemm_phase<pg8::EpiSwiglu, SO, PG8_ALIGN, PG8_SP2>(F.lds + RING_OFF, gm, S, E); if (BOTH(1)) GRID_BAR(); }
    if (IN(2)) { pg8::Gemm gm{F.ACT, F.W1D, M, D, FF}; SO S; S.init(M, D, F.G, (int)blockIdx.x); pg8::EpiF32Ssq E{F.FFB, D, F.ssq};
        pg8::gemm_phase<pg8::EpiF32Ssq, SO, PG8_ALIGN, PG8_SP2>(F.lds + RING_OFF, gm, S, E); if (BOTH(2)) GRID_BAR(); }
    if (IN(3)) { ew_phase(F, F.x, F.FFB, F.ssq, F.post1, 0.5f, F.out, F.prem, F.H); if (BOTH(3)) GRID_BAR(); }
    if (IN(4)) { pg8::Gemm gm{F.H, F.WIN, M, NIN, D}; SO S; S.init(M, NIN, F.G, (int)blockIdx.x); pg8::EpiBf16 E{F.ACT, NIN};
        pg8::gemm_phase<pg8::EpiBf16, SO, PG8_ALIGN, PG8_SP2>(F.lds + RING_OFF, gm, S, E); if (BOTH(4)) GRID_BAR(); }
    if (IN(5)) { hgrn_phase(F, F.ACT, F.FFB); attn_phase(F, F.ACT, F.H); if (BOTH(5)) GRID_BAR(); }
    if (IN(6)) { hgrn_out_phase(F, F.ACT, F.FFB, F.H); if (BOTH(6)) GRID_BAR(); }
    if (IN(7)) { pg8::Gemm gm{F.H, F.WOUT, M, D, D}; SO S; S.init(M, D, F.G, (int)blockIdx.x); pg8::EpiF32Ssq E{F.FFB, D, F.ssq};
        pg8::gemm_phase<pg8::EpiF32Ssq, SO, PG8_ALIGN, PG8_SP2>(F.lds + RING_OFF, gm, S, E); if (BOTH(7)) GRID_BAR(); }
    if (IN(8)) { ew_phase(F, F.out, F.FFB, F.ssq, F.postm, 1.0f, F.out, F.pre2, F.H); if (BOTH(8)) GRID_BAR(); }
    if (IN(9)) { pg8::Gemm gm{F.H, F.W2GU, M, NGU, D}; SO S; S.init(M, NGU, F.G, (int)blockIdx.x); pg8::EpiSwiglu E{F.ACT, FF};
        pg8::gemm_phase<pg8::EpiSwiglu, SO, PG8_ALIGN, PG8_SP2>(F.lds + RING_OFF, gm, S, E); if (BOTH(9)) GRID_BAR(); }
    if (IN(10)) { pg8::Gemm gm{F.ACT, F.W2D, M, D, FF}; SO S; S.init(M, D, F.G, (int)blockIdx.x); pg8::EpiF32Ssq E{F.FFB, D, F.ssq};
        pg8::gemm_phase<pg8::EpiF32Ssq, SO, PG8_ALIGN, PG8_SP2>(F.lds + RING_OFF, gm, S, E); if (BOTH(10)) GRID_BAR(); }
    if (IN(11)) { ew_phase(F, F.out, F.FFB, F.ssq, F.post2, 0.5f, F.out, nullptr, nullptr); }
    if (lo == 100) {
        const int gw = F.vcu * NWAVES + F.wave, NGW = F.G * NWAVES;
        for (int m = gw; m < M; m += NGW) for (int c = F.lane; c < 1024; c += 64) {
            F.out[(size_t)m * D + c] = F.FFB[(size_t)m * HW + c] + F.FFB[(size_t)M * HW + (size_t)m * HW + c];
            F.out[(size_t)m * D + 1024 + c] = bf_lo((unsigned)F.H[(size_t)m * D + 1024 + c]); }
    }
    if (lo == 102 || lo == 103) {
        const int gw = F.vcu * NWAVES + F.wave, NGW = F.G * NWAVES;
        for (int m = gw; m < M; m += NGW) for (int c = F.lane; c < 1024; c += 64) {
            F.out[(size_t)m * D + c] = lo == 102 ? F.FFB[(size_t)m * HW + c] : 0.f;
            F.out[(size_t)m * D + 1024 + c] = lo == 102 ? F.FFB[(size_t)M * HW + (size_t)m * HW + c] : bf_lo((unsigned)F.H[(size_t)m * D + 1024 + c]); }
    }
    if (lo == 101) {
        const int gw = F.vcu * NWAVES + F.wave, NGW = F.G * NWAVES;
        for (int m = gw; m < M; m += NGW) for (int c = F.lane; c < 2048; c += 64) F.out[(size_t)m * D + c] = bf_lo((unsigned)F.ACT[(size_t)m * NIN + DBG_COL0 + c]);
    }
#undef IN
#undef BOTH
}

extern "C" void kernel_launch(void* const* d_in, const int* in_sizes, int n_in, void* d_out, int out_size, void* d_ws, size_t ws_size, hipStream_t stream) {
    static int grid = 0;
    if (grid == 0) {
        if (n_in != 18 || in_sizes[0] != M * D || out_size != M * D || ws_size < WS_END) { fprintf(stderr, "kernel_launch: unexpected shapes/workspace (n_in %d, ws %zu)\n", n_in, ws_size); grid = -1; return; }
        int dev = 0, cus = 0;
        if (hipGetDevice(&dev) != hipSuccess || hipDeviceGetAttribute(&cus, hipDeviceAttributeMultiprocessorCount, dev) != hipSuccess) { grid = -1; return; }
        if (hipFuncSetAttribute((const void*)hymba_fwd, hipFuncAttributeMaxDynamicSharedMemorySize, LDS_BYTES) != hipSuccess) { fprintf(stderr, "kernel_launch: hipFuncSetAttribute failed\n"); grid = -1; return; }
        (void)hipGetLastError();
        grid = cus;
    }
    if (grid < 0) return;
    if (hipMemsetAsync((char*)d_ws + WS_CTL, 0, CTL_ZERO_BYTES, stream) != hipSuccess) return;
    Args a{};
    for (int i = 0; i < 18; ++i) a.in[i] = (const float*)d_in[i];
    a.out = (float*)d_out; a.ws = (unsigned char*)d_ws;
    if (N_LAUNCHES == 1) { a.ph_lo = 0; a.ph_hi = PER_PHASE; a.li = 0; hipLaunchKernelGGL(hymba_fwd, dim3(grid), dim3(NWAVES * 64), LDS_BYTES, stream, a); }
    else { for (int li = 0; li < DBG_HI + 1; ++li) { if (li == DBG_HI && DBG_MODE == 0) break; a.ph_lo = li; a.ph_hi = li + 1; a.li = li; if (li == DBG_HI) { a.ph_lo = DBG_MODE; a.ph_hi = DBG_MODE + 1; } hipLaunchKernelGGL(hymba_fwd, dim3(grid), dim3(NWAVES * 64), LDS_BYTES, stream, a); } }
}
```

```cpp
#include <hip/hip_runtime.h>
#include <cstdio>
#include <cstdint>

#ifndef MK_N_LAUNCHES
#define MK_N_LAUNCHES 1
#endif

namespace pg8 {
#define PG8_LAS __attribute__((address_space(3)))
typedef unsigned short bf16_t;
typedef short bf16x8 __attribute__((ext_vector_type(8)));
typedef float f32x4 __attribute__((ext_vector_type(4)));
typedef unsigned u32x4 __attribute__((ext_vector_type(4)));
constexpr int BM = 256, BK = 64, HALF = 128, HTB = HALF * BK * 2  , STAGE_BYTES = 8 * HTB, NXCD = 8, WGM = 8;

__host__ __device__ __forceinline__ int lds_byte(int r, int c) { const int st = (r >> 4) * 2 + (c >> 5), rr = r & 15, cc = c & 31, ob = rr * 64 + cc * 2; return st * 1024 + (ob ^ (((ob >> 9) & 1) << 5)); }
__host__ __device__ __forceinline__ void stage_rc(int b, int& R, int& C) { const int st = b / 1024, sb = b % 1024, swz = sb ^ (((sb >> 9) & 1) << 5); R = (st >> 1) * 16 + swz / 64; C = (st & 1) * 32 + (swz % 64) / 2; }
__host__ __device__ __forceinline__ int perm32(int rho) { const int n = rho >> 4, i = rho & 15; return 8 * (i >> 2) + 4 * n + (i & 3); }

struct Unit { int pm, pn; };
struct Gemm { const bf16_t* A; const bf16_t* Bt; int M, N, K; };

struct StaticOrder {
    int nM, nN, nwg, G, c;
    __host__ __device__ void init(int M, int N, int G_, int c_) { nM = M / BM; nN = N / BM; nwg = nM * nN; G = G_; c = c_; }
    __host__ __device__ bool next(int i, Unit& u) const {
        const long L = (long)i * G + c; if (L >= nwg) return false;
        int wgid = (int)L; { const int q = nwg / NXCD, r = nwg % NXCD, xcd = wgid % NXCD, off = wgid / NXCD; wgid = (xcd < r ? xcd * (q + 1) : r * (q + 1) + (xcd - r) * q) + off; }
        const int nig = WGM * nN, gid = wgid / nig, fm = gid * WGM, gsz = (nM - fm) < WGM ? (nM - fm) : WGM;
        u.pm = fm + ((wgid % nig) % gsz); u.pn = (wgid % nig) / gsz; return true;
    }
    __device__ __forceinline__ void a_ready(const Unit&) const {}
    __device__ __forceinline__ void done(const Unit&) const {}
};

typedef __bf16 bf16v2_t __attribute__((ext_vector_type(2)));
typedef float f32v2_t __attribute__((ext_vector_type(2)));
__device__ __forceinline__ unsigned cvt_pk_bf16(float lo, float hi) { const f32v2_t v = {lo, hi}; const bf16v2_t b = __builtin_convertvector(v, bf16v2_t); return __builtin_bit_cast(unsigned, b); }

struct EpiBf16 {
    static constexpr bool PERM = true, AFTER_DRAIN = false;
    bf16_t* O; int ldc;
    __device__ __forceinline__ void operator()(const f32x4 (&acc)[2][2][4][2], const Unit& u, int wr, int wc, int fr, int fq) const {
        const int row0 = u.pm * BM + wr * 64 + fr; const int col0 = u.pn * BM + wc * 32 + 8 * fq;
#pragma unroll
        for (int ai = 0; ai < 2; ++ai)
#pragma unroll
            for (int m = 0; m < 4; ++m) { bf16_t* rowp = O + (size_t)(row0 + ai * HALF + m * 16) * ldc + col0;
#pragma unroll
                for (int bj = 0; bj < 2; ++bj) { const f32x4 v0 = acc[ai][bj][m][0], v1 = acc[ai][bj][m][1];
                    u32x4 w; w.x = cvt_pk_bf16(v0[0], v0[1]); w.y = cvt_pk_bf16(v0[2], v0[3]); w.z = cvt_pk_bf16(v1[0], v1[1]); w.w = cvt_pk_bf16(v1[2], v1[3]);
                    *(u32x4*)(rowp + bj * HALF) = w; } }
    }
};
__device__ __forceinline__ float silu_f(float x) { return x * __builtin_amdgcn_rcpf(1.0f + __builtin_amdgcn_exp2f(-1.4426950408889634f * x)); }
struct EpiSwiglu {
    static constexpr bool PERM = true, AFTER_DRAIN = false;
    bf16_t* O; int ldc;
    __device__ __forceinline__ void operator()(const f32x4 (&acc)[2][2][4][2], const Unit& u, int wr, int wc, int fr, int fq) const {
        const int row0 = u.pm * BM + wr * 64 + fr; const int col0 = u.pn * HALF + wc * 32 + 8 * fq;
#pragma unroll
        for (int ai = 0; ai < 2; ++ai)
#pragma unroll
            for (int m = 0; m < 4; ++m) { bf16_t* rowp = O + (size_t)(row0 + ai * HALF + m * 16) * ldc + col0;
                const f32x4 g0 = acc[ai][0][m][0], g1 = acc[ai][0][m][1], u0 = acc[ai][1][m][0], u1 = acc[ai][1][m][1];
                float r[8];
#pragma unroll
                for (int e = 0; e < 4; ++e) { r[e] = silu_f(g0[e]) * u0[e]; r[4 + e] = silu_f(g1[e]) * u1[e]; }
                u32x4 w; w.x = cvt_pk_bf16(r[0], r[1]); w.y = cvt_pk_bf16(r[2], r[3]); w.z = cvt_pk_bf16(r[4], r[5]); w.w = cvt_pk_bf16(r[6], r[7]);
                *(u32x4*)rowp = w; }
    }
};
struct EpiF32Ssq {
    static constexpr bool PERM = false, AFTER_DRAIN = false;
    float* C; int ldc; float* ssq;
    __device__ __forceinline__ void operator()(const f32x4 (&acc)[2][2][4][2], const Unit& u, int wr, int wc, int fr, int fq) const {
        const int row0 = u.pm * BM + wr * 64 + fr, col0 = u.pn * BM + wc * 32 + 4 * fq;
#pragma unroll
        for (int ai = 0; ai < 2; ++ai)
#pragma unroll
            for (int m = 0; m < 4; ++m) { const int row = row0 + ai * HALF + m * 16; float* rowp = C + (size_t)row * ldc + col0; float s = 0.f;
#pragma unroll
                for (int bj = 0; bj < 2; ++bj)
#pragma unroll
                    for (int n = 0; n < 2; ++n) { const f32x4 v = acc[ai][bj][m][n]; *(f32x4*)(rowp + bj * HALF + n * 16) = v; s += (v[0] * v[0] + v[1] * v[1]) + (v[2] * v[2] + v[3] * v[3]); }
                s += __shfl_xor(s, 16); s += __shfl_xor(s, 32);
                if (fq == 0) ssq[row * 32 + u.pn * 4 + wc] = s; }
    }
};

template <class Epi, class Sched, bool ALIGN_EPI = false, bool SP2 = false>
__device__ __forceinline__ void gemm_phase(PG8_LAS unsigned char* lds, const Gemm g, const Sched& S, const Epi& E) {
    const int tid = threadIdx.x, wid = __builtin_amdgcn_readfirstlane(tid >> 6), lane = tid & 63, wr = wid >> 2, wc = wid & 3, fr = lane & 15, fq = lane >> 4;
    const int K = g.K, nt = K / BK;
    unsigned voffA[2], voffB[2];
#pragma unroll
    for (int i = 0; i < 2; ++i) { int R, C; stage_rc(tid * 16 + i * 8192, R, C); const int Rb = Epi::PERM ? ((R & ~31) + perm32(R & 31)) : R;
        voffA[i] = (unsigned)(R * K + C) * 2u; voffB[i] = (unsigned)(Rb * K + C) * 2u; }
    const size_t kstep = (size_t)(BK * 2);
    const size_t hstep = (size_t)HALF * K * 2;
    const size_t tstep = 2 * hstep;
    const unsigned ldsw = (unsigned)wid * 1024u;
    const int aoff = lds_byte(wr * 64 + fr, fq * 8), boff = lds_byte(wc * 32 + fr, fq * 8);
#define PG8_SA(b, h) (((b) * 2 + (h)) * HTB)
#define PG8_SB(b, h) ((4 + (b) * 2 + (h)) * HTB)
#define PG8_STAGE(bufoff, gbase, voff) do { _Pragma("unroll") for (int _i = 0; _i < 2; ++_i) \
        __builtin_amdgcn_global_load_lds((const unsigned*)((const char*)(gbase) + (voff)[_i]), (PG8_LAS unsigned*)(lds + (bufoff) + ldsw + _i * 8192), 16, 0, 0); } while (0)
#define PG8_LDA(dst, b, h) do { _Pragma("unroll") for (int m = 0; m < 4; ++m) _Pragma("unroll") for (int k = 0; k < 2; ++k) dst[m][k] = *(const PG8_LAS bf16x8*)(lds + PG8_SA(b, h) + aoff + m * 2048 + k * 1024); } while (0)
#define PG8_LDB(dst, b, h) do { _Pragma("unroll") for (int n = 0; n < 2; ++n) _Pragma("unroll") for (int k = 0; k < 2; ++k) dst[n][k] = *(const PG8_LAS bf16x8*)(lds + PG8_SB(b, h) + boff + n * 2048 + k * 1024); } while (0)
#define PG8_MMA(ai, bj, At, Bt) do { __builtin_amdgcn_s_setprio(1); _Pragma("unroll") for (int m = 0; m < 4; ++m) _Pragma("unroll") for (int n = 0; n < 2; ++n) _Pragma("unroll") for (int k = 0; k < 2; ++k) \
        acc[ai][bj][m][n] = __builtin_amdgcn_mfma_f32_16x16x32_bf16(Bt[n][k], At[m][k], acc[ai][bj][m][n], 0, 0, 0); __builtin_amdgcn_s_setprio(0); } while (0)
#define PG8_WAIT_V(n) asm volatile("s_waitcnt vmcnt(" #n ")" ::: "memory")
#define PG8_WAIT_L(n) asm volatile("s_waitcnt lgkmcnt(" #n ")" ::: "memory")
#define PG8_BAR __builtin_amdgcn_s_barrier()
#define PG8_SCHED __builtin_amdgcn_sched_barrier(0)
    Unit cur, nxt; int ui = 0;
    if (!S.next(0, cur)) return;
    f32x4 acc[2][2][4][2];
#pragma unroll
    for (int a = 0; a < 2; ++a)
#pragma unroll
        for (int b = 0; b < 2; ++b)
#pragma unroll
            for (int m = 0; m < 4; ++m)
#pragma unroll
                for (int n = 0; n < 2; ++n) acc[a][b][m][n] = (f32x4){0.f, 0.f, 0.f, 0.f};
    bf16x8 At[4][2], B0[2][2], B1[2][2];
    const char* cA = (const char*)g.A + (size_t)cur.pm * tstep; const char* cB = (const char*)g.Bt + (size_t)cur.pn * tstep;
    S.a_ready(cur);
    if constexpr (SP2) {
        PG8_STAGE(PG8_SB(0, 0), cB, voffB); PG8_STAGE(PG8_SB(0, 1), cB + hstep, voffB); PG8_STAGE(PG8_SA(0, 0), cA, voffA); PG8_STAGE(PG8_SA(0, 1), cA + hstep, voffA);
        if (wr == 1) PG8_BAR;
        PG8_WAIT_V(2); PG8_BAR;
        PG8_STAGE(PG8_SB(1, 0), cB + kstep, voffB); PG8_STAGE(PG8_SA(1, 0), cA + kstep, voffA); PG8_STAGE(PG8_SB(1, 1), cB + hstep + kstep, voffB);
        PG8_WAIT_V(6); PG8_BAR;
    } else {
        PG8_STAGE(PG8_SB(0, 0), cB, voffB); PG8_STAGE(PG8_SA(0, 0), cA, voffA); PG8_STAGE(PG8_SB(0, 1), cB + hstep, voffB); PG8_STAGE(PG8_SA(0, 1), cA + hstep, voffA);
        if (wr == 1) PG8_BAR;
        PG8_WAIT_V(4); PG8_BAR;
        PG8_STAGE(PG8_SB(1, 0), cB + kstep, voffB); PG8_STAGE(PG8_SA(1, 0), cA + kstep, voffA); PG8_STAGE(PG8_SB(1, 1), cB + hstep + kstep, voffB);
        PG8_WAIT_V(6); PG8_BAR;
    }
    for (;;) {
        const bool has_next = S.next(ui + 1, nxt);
        const char* nA = has_next ? (const char*)g.A + (size_t)nxt.pm * tstep : cA; const char* nB = has_next ? (const char*)g.Bt + (size_t)nxt.pn * tstep : cB;
        for (int t = 0; t < nt; t += 2) {
            const bool last = (t == nt - 2);
            const char* a1 = cA + (size_t)(t + 1) * kstep;
            const char* a2 = last ? nA : cA + (size_t)(t + 2) * kstep; const char* b2 = last ? nB : cB + (size_t)(t + 2) * kstep;
            const char* a3 = a2 + kstep; const char* b3 = b2 + kstep;
            if (last && has_next) S.a_ready(nxt);
            if constexpr (SP2) {
            PG8_LDB(B0, 0, 0); PG8_LDB(B1, 0, 1); PG8_SCHED; PG8_LDA(At, 0, 0); PG8_STAGE(PG8_SA(1, 1), a1 + hstep, voffA);
            PG8_WAIT_V(8); PG8_WAIT_L(0); PG8_BAR; PG8_MMA(0, 0, At, B0); PG8_MMA(0, 1, At, B1); PG8_BAR; PG8_SCHED;
            PG8_LDA(At, 0, 1); PG8_STAGE(PG8_SB(0, 0), b2, voffB); PG8_STAGE(PG8_SB(0, 1), b2 + hstep, voffB); PG8_STAGE(PG8_SA(0, 0), a2, voffA);
            PG8_WAIT_V(8); PG8_WAIT_L(0); PG8_BAR; PG8_MMA(1, 0, At, B0); PG8_MMA(1, 1, At, B1); PG8_BAR; PG8_SCHED;
            PG8_LDB(B0, 1, 0); PG8_LDB(B1, 1, 1); PG8_SCHED; PG8_LDA(At, 1, 0); PG8_STAGE(PG8_SA(0, 1), a2 + hstep, voffA);
            PG8_WAIT_V(8); PG8_WAIT_L(0); PG8_BAR; PG8_MMA(0, 0, At, B0); PG8_MMA(0, 1, At, B1); PG8_BAR; PG8_SCHED;
            PG8_LDA(At, 1, 1); PG8_STAGE(PG8_SB(1, 0), b3, voffB); PG8_STAGE(PG8_SB(1, 1), b3 + hstep, voffB); PG8_STAGE(PG8_SA(1, 0), a3, voffA);
            PG8_WAIT_V(8); PG8_WAIT_L(0); PG8_BAR; PG8_MMA(1, 0, At, B0); PG8_MMA(1, 1, At, B1); PG8_BAR; PG8_SCHED;
            } else {
            PG8_LDB(B0, 0, 0); PG8_SCHED; PG8_LDA(At, 0, 0); PG8_STAGE(PG8_SA(1, 1), a1 + hstep, voffA);
            PG8_WAIT_L(8); PG8_BAR; PG8_WAIT_L(0); PG8_MMA(0, 0, At, B0); PG8_BAR; PG8_SCHED;
            PG8_LDB(B1, 0, 1); PG8_STAGE(PG8_SB(0, 0), b2, voffB);
            PG8_BAR; PG8_WAIT_L(0); PG8_MMA(0, 1, At, B1); PG8_BAR;
            PG8_LDA(At, 0, 1); PG8_STAGE(PG8_SA(0, 0), a2, voffA);
            PG8_BAR; PG8_WAIT_L(0); PG8_MMA(1, 0, At, B0); PG8_BAR; PG8_SCHED;
            PG8_STAGE(PG8_SB(0, 1), b2 + hstep, voffB);
            PG8_WAIT_V(6); PG8_BAR; PG8_MMA(1, 1, At, B1); PG8_BAR;
            PG8_LDB(B0, 1, 0); PG8_SCHED; PG8_LDA(At, 1, 0); PG8_STAGE(PG8_SA(0, 1), a2 + hstep, voffA);
            PG8_WAIT_L(8); PG8_BAR; PG8_WAIT_L(0); PG8_MMA(0, 0, At, B0); PG8_BAR; PG8_SCHED;
            PG8_LDB(B1, 1, 1); PG8_STAGE(PG8_SB(1, 0), b3, voffB);
            PG8_BAR; PG8_WAIT_L(0); PG8_MMA(0, 1, At, B1); PG8_BAR;
            PG8_LDA(At, 1, 1); PG8_STAGE(PG8_SA(1, 0), a3, voffA);
            PG8_BAR; PG8_WAIT_L(0); PG8_MMA(1, 0, At, B0); PG8_BAR; PG8_SCHED;
            PG8_STAGE(PG8_SB(1, 1), b3 + hstep, voffB);
            PG8_WAIT_V(6); PG8_BAR; PG8_MMA(1, 1, At, B1); PG8_BAR;
            }
        }
        if constexpr (ALIGN_EPI) { if (wr == 0) PG8_BAR; }
        if constexpr (!Epi::AFTER_DRAIN) { E(acc, cur, wr, wc, fr, fq); S.done(cur); }
        if (!has_next) break;
#pragma unroll
        for (int a = 0; a < 2; ++a)
#pragma unroll
            for (int b = 0; b < 2; ++b)
#pragma unroll
                for (int m = 0; m < 4; ++m)
#pragma unroll
                    for (int n = 0; n < 2; ++n) acc[a][b][m][n] = (f32x4){0.f, 0.f, 0.f, 0.f};
        cur = nxt; cA = nA; cB = nB; ++ui;
        if constexpr (ALIGN_EPI) { if (wr == 1) PG8_BAR; }
    }
    PG8_WAIT_V(0);
    if constexpr (!ALIGN_EPI) { if (wr == 0) PG8_BAR; }
    PG8_BAR;
#undef PG8_SA
#undef PG8_SB
#undef PG8_STAGE
#undef PG8_LDA
#undef PG8_LDB
#undef PG8_MMA
#undef PG8_WAIT_V
#undef PG8_WAIT_L
#undef PG8_BAR
#undef PG8_SCHED
}
}

#ifndef REP_P0
#define REP_P0 1
#endif
#ifndef REP_P1
#define REP_P1 1
#endif
#ifndef REP_P2
#define REP_P2 1
#endif
#ifndef REP_P3
#define REP_P3 1
#endif
#ifndef REP_P4
#define REP_P4 1
#endif
#ifndef REP_HG
#define REP_HG 1
#endif
#ifndef REP_AT
#define REP_AT 1
#endif
#ifndef REP_P6
#define REP_P6 1
#endif
#ifndef REP_P7
#define REP_P7 1
#endif
#ifndef DBG_HI
#define DBG_HI 12
#define DBG_MODE 0
#define DBG_COL0 0
#endif
#ifndef PG8_SP2
#define PG8_SP2 true
#endif
#ifndef PG8_ALIGN
#define PG8_ALIGN true
#endif

constexpr int NWAVES = 8;
constexpr int N_LAUNCHES = MK_N_LAUNCHES;
constexpr int PER_PHASE = 12;

constexpr int BATCH = 4, SEQ = 2048, D = 2048, FF = 5632, NGU = 2 * FF, NIN = 6656;
constexpr int M = BATCH * SEQ;
constexpr int HW = 1024, HH = 8, HD = 128;
constexpr int AH = 8, AKV = 2;
constexpr int CQH = 0, CIH = 1024, CFF = 2048, CFB = 3072, CGH = 4096, CQA = 5120, CKA = 6144, CVA = 6400;
constexpr float EPS = 1e-6f;

constexpr size_t MiB = 1u << 20;
constexpr size_t WS_CTL = 0, CTL_ZERO_BYTES = 1 * MiB;
constexpr size_t WS_W1GU = 2 * MiB, WS_W1D = 46 * MiB, WS_WIN = 68 * MiB, WS_WOUT = 94 * MiB, WS_W2GU = 102 * MiB, WS_W2D = 146 * MiB;
constexpr size_t WS_H = 168 * MiB;
constexpr size_t WS_ACT = 200 * MiB;
constexpr size_t WS_FF = 304 * MiB;
constexpr size_t WS_END = 368 * MiB;
constexpr int CW_BAR = 4096;
constexpr size_t WS_SSQ = 1 * MiB;

constexpr int RING_OFF = 0, RING_BYTES = 131072;
constexpr int LDSCTL_OFF = RING_BYTES, MISC_OFF = LDSCTL_OFF + 320;
constexpr int LDS_BYTES = 147456;

#define GAS __attribute__((address_space(1)))
#define LAS __attribute__((address_space(3)))
typedef unsigned short bf16;
typedef unsigned v4u __attribute__((ext_vector_type(4)));
typedef unsigned v2u __attribute__((ext_vector_type(2)));
typedef float f32x4 __attribute__((ext_vector_type(4)));
typedef short bf16x8 __attribute__((ext_vector_type(8)));
typedef short bf16x4 __attribute__((ext_vector_type(4)));
typedef GAS unsigned gu32;
#define RLX_AGENT __ATOMIC_RELAXED, __HIP_MEMORY_SCOPE_AGENT
#define LDS_WAIT() asm volatile("s_waitcnt lgkmcnt(0)" ::: "memory")
#define VM_WAIT() asm volatile("s_waitcnt vmcnt(0)" ::: "memory")
__device__ __forceinline__ unsigned f2bf(float f) { unsigned u = __builtin_bit_cast(unsigned, f); return (u + 0x7fffu + ((u >> 16) & 1u)) >> 16; }
__device__ __forceinline__ unsigned pk2(float lo, float hi) { return pg8::cvt_pk_bf16(lo, hi); }
__device__ __forceinline__ float bf_lo(unsigned u) { return __builtin_bit_cast(float, u << 16); }
__device__ __forceinline__ float bf_hi(unsigned u) { return __builtin_bit_cast(float, u & 0xffff0000u); }

#define XB_TMO      128
#define XB_XCNT(j)  (256  + 64 * (j))
#define XB_XSUB(j)  (1280 + 64 * (j))
#define XB_XGEN(j)  (2304 + 64 * (j))
#define XB_TOP      3328
#define XB_TOPGEN   3392
#define XCD_BAR_WORDS 3456
#define XB_SPIN_CAP (1u << 20)

__device__ __forceinline__ unsigned xb_ld(unsigned* p)              { return __hip_atomic_load(p, __ATOMIC_RELAXED, __HIP_MEMORY_SCOPE_AGENT); }
__device__ __forceinline__ unsigned xb_add(unsigned* p, unsigned v) { return __hip_atomic_fetch_add(p, v, __ATOMIC_RELAXED, __HIP_MEMORY_SCOPE_AGENT); }
__device__ __forceinline__ unsigned xb_xcc_id() { return (unsigned)__builtin_amdgcn_s_getreg((3 << 11) | 20) & 0xFu; }
#define XB_SPIN(cond, bar) do { unsigned _sp = 0; while (cond) { __builtin_amdgcn_s_sleep(1); \
    if ((++_sp & 255u) == 0u) { if (xb_ld(&(bar)[XB_TMO])) break; if (_sp > XB_SPIN_CAP) { atomicAdd(&(bar)[XB_TMO], 1u); break; } } } } while (0)

struct XcdBarrier { unsigned* bar; unsigned x; volatile LAS unsigned* st; };

__device__ __forceinline__ XcdBarrier xcd_barrier_post(unsigned* bar, volatile LAS unsigned* st) {
    XcdBarrier b; b.bar = bar; b.x = xb_xcc_id(); b.st = st;
    if (threadIdx.x == 0) (void)xb_add(&bar[XB_XCNT(b.x)], 1u);
    return b;
}
__device__ __forceinline__ void xcd_barrier_complete(unsigned* bar, unsigned x, unsigned& nloc, unsigned& nx) {
    const unsigned G = gridDim.x * gridDim.y * gridDim.z;
    unsigned sum, cnt, mine, sp = 0u;
    for (;;) {
        sum = 0u; cnt = 0u; mine = 0u;
#pragma unroll
        for (unsigned j = 0; j < 16; ++j) { const unsigned c = xb_ld(&bar[XB_XCNT(j)]); sum += c; cnt += (c > 0u) ? 1u : 0u; mine = (j == x) ? c : mine; }
        if (sum == G) break;
        __builtin_amdgcn_s_sleep(1);
        if ((++sp & 255u) == 0u) { if (xb_ld(&bar[XB_TMO])) break; if (sp > XB_SPIN_CAP) { atomicAdd(&bar[XB_TMO], 1u); break; } }
    }
    nloc = mine > 0u ? mine : 1u; nx = cnt > 0u ? cnt : 1u;
}
__device__ __forceinline__ void xcd_barrier(const XcdBarrier& b) {
    asm volatile("s_waitcnt vmcnt(0)" ::: "memory");
    __syncthreads();
    if (threadIdx.x == 0) {
        unsigned* bar = b.bar;
        __builtin_amdgcn_s_waitcnt(0);
        unsigned nloc = b.st[0], nx = b.st[1];
        if (nloc == 0u) { xcd_barrier_complete(bar, b.x, nloc, nx); b.st[0] = nloc; b.st[1] = nx; }
        const unsigned old = xb_add(&bar[XB_XSUB(b.x)], 1u);
        const unsigned gen = old / nloc;
        if (old + 1u == (gen + 1u) * nloc) {
            __builtin_amdgcn_fence(__ATOMIC_RELEASE, "agent");
            asm volatile("s_waitcnt vmcnt(0)" ::: "memory");
            const unsigned og = xb_add(&bar[XB_TOP], 1u);
            const unsigned tg = og / nx;
            if (og + 1u == (tg + 1u) * nx) xb_add(&bar[XB_TOPGEN], 1u);
            else XB_SPIN(xb_ld(&bar[XB_TOPGEN]) == tg, bar);
            __builtin_amdgcn_fence(__ATOMIC_ACQUIRE, "agent");
            xb_add(&bar[XB_XGEN(b.x)], 1u);
            asm volatile("s_waitcnt vmcnt(0)" ::: "memory");
        } else {
            XB_SPIN(xb_ld(&bar[XB_XGEN(b.x)]) == gen, bar);
            __builtin_amdgcn_fence(__ATOMIC_ACQUIRE, "agent");
            asm volatile("s_waitcnt vmcnt(0)" ::: "memory");
        }
    }
    __syncthreads();
}

struct Frame {
    LAS unsigned char* lds;
    volatile LAS unsigned* MISC;
    gu32* ctl;
    int tid, lane, wave;
    int vcu, G;
    const float* x; float* out;
    const float *pre1, *post1, *w1gu, *w1d, *prem, *postm, *win, *lbf, *lbb, *ognorm, *sink, *wout, *pre2, *post2, *w2gu, *w2d, *relb;
    bf16 *W1GU, *W1D, *WIN, *WOUT, *W2GU, *W2D;
    bf16 *H, *ACT; float* FFB; float* ssq;
};

__device__ __forceinline__ float wave_sum(float v) {
#pragma unroll
    for (int o = 1; o < 64; o <<= 1) v += __shfl_xor(v, o);
    return v;
}
template <bool GU>
__device__ __forceinline__ void p0_transpose_item(const float* W, int K, int N, bf16* WT, LAS float* scr, int item, int lane) {
    const int nblk = N / 32, kb = item / nblk, nb = item % nblk, k0 = 64 * kb, n0 = 32 * nb;
    int r0 = n0;
    if (GU) { const int half = N / 2; const int nn = n0 < half ? n0 : n0 - half; r0 = 256 * (nn / 128) + (nn % 128) + (n0 < half ? 0 : 128); }
#pragma unroll 8
    for (int i = 0; i < 32; ++i) { const int kk = 2 * i + (lane >> 5); scr[kk * 33 + (lane & 31)] = W[(size_t)(k0 + kk) * N + n0 + (lane & 31)]; }
    LDS_WAIT(); asm volatile("" ::: "memory");
    const int c = lane & 7;
#pragma unroll
    for (int j = 0; j < 4; ++j) { const int n = (lane >> 3) + 8 * j; const LAS float* s = scr + (8 * c) * 33 + n;
        v4u o; o.x = pk2(s[0 * 33], s[1 * 33]); o.y = pk2(s[2 * 33], s[3 * 33]); o.z = pk2(s[4 * 33], s[5 * 33]); o.w = pk2(s[6 * 33], s[7 * 33]);
        *(GAS v4u*)(WT + (size_t)(r0 + n) * K + k0 + 8 * c) = o; }
    LDS_WAIT(); asm volatile("" ::: "memory");
}
__device__ __forceinline__ void rms_row_to_bf16(int lane, const float* xrow, const float* gain, bf16* orow) {
    const GAS f32x4* xr = (const GAS f32x4*)xrow + lane; const GAS f32x4* gr = (const GAS f32x4*)gain + lane;
    f32x4 v[8]; float s = 0.f;
#pragma unroll
    for (int j = 0; j < 8; ++j) { v[j] = xr[64 * j]; s += (v[j].x * v[j].x + v[j].y * v[j].y) + (v[j].z * v[j].z + v[j].w * v[j].w); }
    const float rs = 1.0f / sqrtf(wave_sum(s) * (1.f / D) + EPS);
    GAS v2u* o8 = (GAS v2u*)orow + lane;
#pragma unroll
    for (int j = 0; j < 8; ++j) { const f32x4 g = gr[64 * j]; v2u o; o.x = pk2(v[j].x * rs * g.x, v[j].y * rs * g.y); o.y = pk2(v[j].z * rs * g.z, v[j].w * rs * g.w); o8[64 * j] = o; }
}
__device__ __forceinline__ void p0_prologue(Frame& F) {
    LAS float* scr = (LAS float*)(F.lds + RING_OFF + F.wave * 16384);
    const int gw = F.vcu * NWAVES + F.wave, NGW = F.G * NWAVES;
    constexpr int I_GU = (D / 64) * (NGU / 32), I_DN = (FF / 64) * (D / 32), I_IN = (D / 64) * (NIN / 32), I_OUT = (D / 64) * (D / 32);
    constexpr int NITEMS = 2 * I_GU + 2 * I_DN + I_IN + I_OUT;
    for (int it = gw; it < NITEMS; it += NGW) {
        int r = it;
        if (r < I_GU) { p0_transpose_item<true>(F.w1gu, D, NGU, F.W1GU, scr, r, F.lane); continue; } r -= I_GU;
        if (r < I_DN) { p0_transpose_item<false>(F.w1d, FF, D, F.W1D, scr, r, F.lane); continue; } r -= I_DN;
        if (r < I_IN) { p0_transpose_item<false>(F.win, D, NIN, F.WIN, scr, r, F.lane); continue; } r -= I_IN;
        if (r < I_OUT) { p0_transpose_item<false>(F.wout, D, D, F.WOUT, scr, r, F.lane); continue; } r -= I_OUT;
        if (r < I_GU) { p0_transpose_item<true>(F.w2gu, D, NGU, F.W2GU, scr, r, F.lane); continue; } r -= I_GU;
        p0_transpose_item<false>(F.w2d, FF, D, F.W2D, scr, r, F.lane);
    }
    for (int m = gw; m < M; m += NGW) rms_row_to_bf16(F.lane, F.x + (size_t)m * D, F.pre1, F.H + (size_t)m * D);
}
__device__ __forceinline__ void ew_phase(Frame& F, const float* xi, const float* ff, const float* ssq, const float* post, float coef, float* xo, const float* pre, bf16* h) {
    const int gw = F.vcu * NWAVES + F.wave, NGW = F.G * NWAVES;
    for (int m = gw; m < M; m += NGW) {
        const float part = (F.lane < 32) ? ssq[m * 32 + F.lane] : 0.f;
        const float rs = coef / sqrtf(wave_sum(part) * (1.f / D) + EPS);
        const GAS f32x4* xr = (const GAS f32x4*)(xi + (size_t)m * D) + F.lane; const GAS f32x4* fr = (const GAS f32x4*)(ff + (size_t)m * D) + F.lane;
        const GAS f32x4* pr = (const GAS f32x4*)post + F.lane; GAS f32x4* orow = (GAS f32x4*)(xo + (size_t)m * D) + F.lane;
        f32x4 v[8]; float s = 0.f;
#pragma unroll
        for (int j = 0; j < 8; ++j) { const f32x4 a = xr[64 * j], b = fr[64 * j], g = pr[64 * j]; v[j] = a + b * g * rs; s += (v[j].x * v[j].x + v[j].y * v[j].y) + (v[j].z * v[j].z + v[j].w * v[j].w); orow[64 * j] = v[j]; }
        if (h) {
            const float r2 = 1.0f / sqrtf(wave_sum(s) * (1.f / D) + EPS);
            const GAS f32x4* gr = (const GAS f32x4*)pre + F.lane; GAS v2u* o8 = (GAS v2u*)(h + (size_t)m * D) + F.lane;
#pragma unroll
            for (int j = 0; j < 8; ++j) { const f32x4 g = gr[64 * j]; v2u o; o.x = pk2(v[j].x * r2 * g.x, v[j].y * r2 * g.y); o.y = pk2(v[j].z * r2 * g.z, v[j].w * r2 * g.w); o8[64 * j] = o; }
        }
    }
}

template <int CTRL, int ROWMASK> __device__ __forceinline__ float dpp_f(float v) { return __builtin_bit_cast(float, __builtin_amdgcn_update_dpp(0, __builtin_bit_cast(int, v), CTRL, ROWMASK, 0xf, false)); }
__device__ __forceinline__ float wave_scan_incl(float v) {
    v += dpp_f<0x111, 0xf>(v); v += dpp_f<0x112, 0xf>(v); v += dpp_f<0x114, 0xf>(v); v += dpp_f<0x118, 0xf>(v);
    v += dpp_f<0x142, 0xa>(v); v += dpp_f<0x143, 0xc>(v);
    return v;
}
constexpr int HG_QD = 0, HG_KD = 17408, HG_KT = 34816, HG_VT0 = 53248, HG_VT1 = 57856, HG_PS = 62464, HG_ST0 = 71680, HG_ST1 = 80384, HG_DEC = 89088, HG_END = 89600;
__device__ __forceinline__ bf16x8 ldsfrag(LAS unsigned char* base, int row, int stride, int kbyte) { return *(const LAS bf16x8*)(base + row * stride + kbyte); }
__device__ __forceinline__ void hgrn_phase(Frame& F, const bf16* P, float* OF) {
    LAS unsigned char* L = F.lds + RING_OFF;
    const int w = F.wave, l = F.lane, g = l >> 4, fr = l & 15;
    for (int item = F.vcu; item < 256; item += F.G) {
        const int seq = item >> 2, vs = item & 3, b = seq >> 4, h = (seq >> 1) & 7, dir = seq & 1;
        const float* lbraw = dir ? F.lbb : F.lbf;
        float lb[16], oml[16];
#pragma unroll
        for (int i = 0; i < 16; ++i) { const float a0 = lbraw[h * 128 + 16 * w + i], a1 = lbraw[HW + h * 128 + 16 * w + i]; lb[i] = 1.0f / (1.0f + __expf(a1 - a0)); oml[i] = 1.0f - lb[i]; }
        f32x4 S[2] = {(f32x4){0.f, 0.f, 0.f, 0.f}, (f32x4){0.f, 0.f, 0.f, 0.f}};
        for (int u = F.tid; u < 8704 / 4; u += NWAVES * 64) ((LAS unsigned*)(L + HG_ST0))[u] = 0u;
        float* O = OF + (size_t)dir * M * HW;
        const int colq = CQH + h * 128 + 16 * w, colz = (dir ? CFB : CFF) + h * 128 + 16 * w, colv = CIH + h * 128 + 32 * vs + 8 * (w & 3);
        v4u rq0, rq1, rz0, rz1, rv;
        {   const int cn = dir ? 31 : 0; const int tok = cn * 64 + (dir ? 63 - l : l); const bf16* row = P + (size_t)(b * SEQ + tok) * NIN;
            rq0 = *(const GAS v4u*)(row + colq); rq1 = *(const GAS v4u*)(row + colq + 8); rz0 = *(const GAS v4u*)(row + colz); rz1 = *(const GAS v4u*)(row + colz + 8);
            rv = (v4u){0u, 0u, 0u, 0u}; if (w < 4) rv = *(const GAS v4u*)(row + colv); }
        for (int n = 0; n < 32; ++n) {
            const int cur = n & 1;
            const v4u q0 = rq0, q1 = rq1, z0 = rz0, z1 = rz1, vv = rv;
            if (n + 1 < 32) { const int cn = dir ? 31 - (n + 1) : (n + 1); const int tok = cn * 64 + (dir ? 63 - l : l); const bf16* row = P + (size_t)(b * SEQ + tok) * NIN;
                rq0 = *(const GAS v4u*)(row + colq); rq1 = *(const GAS v4u*)(row + colq + 8); rz0 = *(const GAS v4u*)(row + colz); rz1 = *(const GAS v4u*)(row + colz + 8);
                if (w < 4) rv = *(const GAS v4u*)(row + colv); }
            float qf[16], zf[16];
#pragma unroll
            for (int i = 0; i < 4; ++i) { qf[2 * i] = bf_lo(q0[i]); qf[2 * i + 1] = bf_hi(q0[i]); qf[8 + 2 * i] = bf_lo(q1[i]); qf[8 + 2 * i + 1] = bf_hi(q1[i]);
                                          zf[2 * i] = bf_lo(z0[i]); zf[2 * i + 1] = bf_hi(z0[i]); zf[8 + 2 * i] = bf_lo(z1[i]); zf[8 + 2 * i + 1] = bf_hi(z1[i]); }
            float kk[16], cum[16];
#pragma unroll
            for (int i = 0; i < 16; ++i) { const float sig = __builtin_amdgcn_rcpf(1.0f + __builtin_amdgcn_exp2f(-1.4426950408889634f * zf[i])); const float f = lb[i] + oml[i] * sig; kk[i] = 1.0f - f; cum[i] = __builtin_amdgcn_logf(f); }
#pragma unroll
            for (int i = 0; i < 16; ++i) cum[i] = wave_scan_incl(cum[i]);
            float qd[16], kd[16], kt[16];
#pragma unroll
            for (int i = 0; i < 16; ++i) { const float last = __builtin_bit_cast(float, __builtin_amdgcn_readlane(__builtin_bit_cast(int, cum[i]), 63)); const float e = __builtin_amdgcn_exp2f(-cum[i]);
                qd[i] = qf[i] * __builtin_amdgcn_exp2f(cum[i]); kd[i] = kk[i] * e; kt[i] = kk[i] * __builtin_amdgcn_exp2f(last - cum[i]); }
            {   v4u a, c2;
                a.x = pk2(qd[0], qd[1]); a.y = pk2(qd[2], qd[3]); a.z = pk2(qd[4], qd[5]); a.w = pk2(qd[6], qd[7]);
                c2.x = pk2(qd[8], qd[9]); c2.y = pk2(qd[10], qd[11]); c2.z = pk2(qd[12], qd[13]); c2.w = pk2(qd[14], qd[15]);
                *(LAS v4u*)(L + HG_QD + l * 272 + 32 * w) = a; *(LAS v4u*)(L + HG_QD + l * 272 + 32 * w + 16) = c2;
                a.x = pk2(kd[0], kd[1]); a.y = pk2(kd[2], kd[3]); a.z = pk2(kd[4], kd[5]); a.w = pk2(kd[6], kd[7]);
                c2.x = pk2(kd[8], kd[9]); c2.y = pk2(kd[10], kd[11]); c2.z = pk2(kd[12], kd[13]); c2.w = pk2(kd[14], kd[15]);
                *(LAS v4u*)(L + HG_KD + l * 272 + 32 * w) = a; *(LAS v4u*)(L + HG_KD + l * 272 + 32 * w + 16) = c2; }
#pragma unroll
            for (int i = 0; i < 16; ++i) *(LAS unsigned short*)(L + HG_KT + (16 * w + i) * 144 + 2 * l) = (unsigned short)f2bf(kt[i]);
            if (l == 63) {
#pragma unroll
                for (int i = 0; i < 16; ++i) *(LAS float*)(L + HG_DEC + (16 * w + i) * 4) = __builtin_amdgcn_exp2f(cum[i]);
            }
            if (w < 4) { LAS unsigned char* VT = L + (cur ? HG_VT1 : HG_VT0);
#pragma unroll
                for (int e = 0; e < 4; ++e) { *(LAS unsigned short*)(VT + (8 * w + 2 * e) * 144 + 2 * l) = (unsigned short)(vv[e] & 0xffffu); *(LAS unsigned short*)(VT + (8 * w + 2 * e + 1) * 144 + 2 * l) = (unsigned short)(vv[e] >> 16); } }
            __syncthreads();
            LAS unsigned char* VT = L + (cur ? HG_VT1 : HG_VT0);
            LAS unsigned char* STc = L + (cur ? HG_ST1 : HG_ST0);
            LAS unsigned char* STn = L + (cur ? HG_ST0 : HG_ST1);
            const int ct = w >> 1, sh = w & 1;
            bf16x8 qfr[4];
#pragma unroll
            for (int ks = 0; ks < 4; ++ks) qfr[ks] = ldsfrag(L + HG_QD, 16 * ct + fr, 272, 64 * ks + 16 * g);
#pragma unroll
            for (int t2 = 0; t2 < 2; ++t2) { const int st = 2 * sh + t2; f32x4 sc = (f32x4){0.f, 0.f, 0.f, 0.f};
#pragma unroll
                for (int ks = 0; ks < 4; ++ks) sc = __builtin_amdgcn_mfma_f32_16x16x32_bf16(ldsfrag(L + HG_KD, 16 * st + fr, 272, 64 * ks + 16 * g), qfr[ks], sc, 0, 0, 0);
                const int c = 16 * ct + fr, s0 = 16 * st + 4 * g;
                v2u pw; pw.x = pk2(s0 + 0 <= c ? sc[0] : 0.f, s0 + 1 <= c ? sc[1] : 0.f); pw.y = pk2(s0 + 2 <= c ? sc[2] : 0.f, s0 + 3 <= c ? sc[3] : 0.f);
                *(LAS v2u*)(L + HG_PS + c * 144 + 2 * s0) = pw; }
            f32x4 o = (f32x4){0.f, 0.f, 0.f, 0.f};
#pragma unroll
            for (int ks = 0; ks < 4; ++ks) o = __builtin_amdgcn_mfma_f32_16x16x32_bf16(ldsfrag(STc, 16 * sh + fr, 272, 64 * ks + 16 * g), qfr[ks], o, 0, 0, 0);
            {   const f32x4 d4 = *(const LAS f32x4*)(L + HG_DEC + (16 * w + 4 * g) * 4);
                bf16x8 ka[2];
#pragma unroll
                for (int k2 = 0; k2 < 2; ++k2) ka[k2] = ldsfrag(L + HG_KT, 16 * w + fr, 144, 64 * k2 + 16 * g);
#pragma unroll
                for (int vt = 0; vt < 2; ++vt) { S[vt] = S[vt] * d4;
#pragma unroll
                    for (int k2 = 0; k2 < 2; ++k2) S[vt] = __builtin_amdgcn_mfma_f32_16x16x32_bf16(ka[k2], ldsfrag(VT, 16 * vt + fr, 144, 64 * k2 + 16 * g), S[vt], 0, 0, 0);
                    v2u sw; sw.x = pk2(S[vt][0], S[vt][1]); sw.y = pk2(S[vt][2], S[vt][3]);
                    *(LAS v2u*)(STn + (16 * vt + fr) * 272 + 2 * (16 * w + 4 * g)) = sw; } }
            __syncthreads();
#pragma unroll
            for (int k2 = 0; k2 < 2; ++k2) o = __builtin_amdgcn_mfma_f32_16x16x32_bf16(ldsfrag(VT, 16 * sh + fr, 144, 64 * k2 + 16 * g), ldsfrag(L + HG_PS, 16 * ct + fr, 144, 64 * k2 + 16 * g), o, 0, 0, 0);
            {   const int cn = dir ? 31 - n : n; const int c = 16 * ct + fr; const int tok = cn * 64 + (dir ? 63 - c : c);
                *(GAS f32x4*)(O + (size_t)(b * SEQ + tok) * HW + h * 128 + 32 * vs + 16 * sh + 4 * g) = o; }
        }
        __syncthreads();
    }
}
__device__ __forceinline__ void hgrn_out_phase(Frame& F, const bf16* P, const float* OF, bf16* Y) {
    const int gw = F.vcu * NWAVES + F.wave, NGW = F.G * NWAVES, l = F.lane;
    for (int m = gw; m < M; m += NGW) {
        const GAS f32x4* a = (const GAS f32x4*)(OF + (size_t)m * HW) + l; const GAS f32x4* b2 = (const GAS f32x4*)(OF + (size_t)M * HW + (size_t)m * HW) + l;
        const GAS v2u* gp = (const GAS v2u*)(P + (size_t)m * NIN + CGH) + l; const GAS f32x4* gn = (const GAS f32x4*)F.ognorm + l;
        GAS v2u* yo = (GAS v2u*)(Y + (size_t)m * D) + l;
#pragma unroll
        for (int j = 0; j < 4; ++j) { f32x4 v = a[64 * j] + b2[64 * j]; float s = (v.x * v.x + v.y * v.y) + (v.z * v.z + v.w * v.w);
#pragma unroll
            for (int o = 1; o < 32; o <<= 1) s += __shfl_xor(s, o);
            const float rs = 1.0f / sqrtf(s * (1.f / 128.f) + EPS); const f32x4 gg = gn[64 * j]; const v2u gr = gp[64 * j];
            const float g0 = bf_lo(gr.x), g1 = bf_hi(gr.x), g2 = bf_lo(gr.y), g3 = bf_hi(gr.y);
            v2u o2; o2.x = pk2(v.x * rs * gg.x * pg8::silu_f(g0), v.y * rs * gg.y * pg8::silu_f(g1)); o2.y = pk2(v.z * rs * gg.z * pg8::silu_f(g2), v.w * rs * gg.w * pg8::silu_f(g3));
            yo[64 * j] = o2; }
    }
}

constexpr int AT_K = 0, AT_V = 34816, AT_TB = 69632, AT_END = 69632 + 1040;
__device__ __forceinline__ int t5_bucket(int rel) {
    const int n = rel < 0 ? -rel : rel; int bkt;
    if (n < 8) bkt = n; else { int j = 0; while (j < 7 && 64 * (2 << j) <= n * n) ++j; bkt = 8 + j; }
    return bkt + (rel > 0 ? 16 : 0);
}
__device__ __forceinline__ void attn_phase(Frame& F, const bf16* P, bf16* Y) {
    LAS unsigned char* L = F.lds + RING_OFF;
    const int w = F.wave, l = F.lane, g = l >> 4, fr = l & 15, tid = F.tid;
    const float scale = 0.08838834764831845f;
    for (int item = F.vcu; item < 512; item += F.G) {
        const int hq = item & 3, blk = (item >> 2) & 15, kvh = (item >> 6) & 1, b = item >> 7, h = kvh * 4 + hq;
        LAS float* TB = (LAS float*)(L + AT_TB);
        if (tid < 257) TB[tid] = F.relb[t5_bucket(tid - 128) * AH + h];
        const int qrow = b * SEQ + blk * 128 + 16 * w + fr;
        bf16x8 bq[4];
#pragma unroll
        for (int ks = 0; ks < 4; ++ks) bq[ks] = *(const GAS bf16x8*)(P + (size_t)qrow * NIN + CQA + h * 128 + 32 * ks + 8 * g);
        float mrun = F.sink[h], lrun = 1.0f;
        f32x4 ot[8];
#pragma unroll
        for (int dt = 0; dt < 8; ++dt) ot[dt] = (f32x4){0.f, 0.f, 0.f, 0.f};
        for (int jt = 0; jt < 3; ++jt) {
            const int kb = blk - 1 + jt; if (kb < 0 || kb >= 16) continue;
            const bf16* kvbase = P + (size_t)(b * SEQ + kb * 128) * NIN;
#pragma unroll
            for (int i = 0; i < 4; ++i) { const int id = tid + 512 * i; const int key = id >> 4, ch = id & 15;
                *(LAS v4u*)(L + AT_K + key * 272 + 16 * ch) = *(const GAS v4u*)(kvbase + (size_t)key * NIN + CKA + kvh * 128 + 8 * ch); }
#pragma unroll
            for (int i = 0; i < 4; ++i) { const int id = tid + 512 * i; const int key = id & 127, ch = id >> 7;
                const v4u vv = *(const GAS v4u*)(kvbase + (size_t)key * NIN + CVA + kvh * 128 + 8 * ch);
#pragma unroll
                for (int e = 0; e < 4; ++e) { *(LAS unsigned short*)(L + AT_V + (8 * ch + 2 * e) * 272 + 2 * key) = (unsigned short)(vv[e] & 0xffffu); *(LAS unsigned short*)(L + AT_V + (8 * ch + 2 * e + 1) * 272 + 2 * key) = (unsigned short)(vv[e] >> 16); } }
            __syncthreads();
            f32x4 st[8];
#pragma unroll
            for (int mt = 0; mt < 8; ++mt) { st[mt] = (f32x4){0.f, 0.f, 0.f, 0.f};
#pragma unroll
                for (int ks = 0; ks < 4; ++ks) st[mt] = __builtin_amdgcn_mfma_f32_16x16x32_bf16(ldsfrag(L + AT_K, 16 * mt + fr, 272, 64 * ks + 16 * g), bq[ks], st[mt], 0, 0, 0); }
            const int qpos = blk * 128 + 16 * w + fr; float mx = -3.0e38f;
#pragma unroll
            for (int mt = 0; mt < 8; ++mt)
#pragma unroll
                for (int r = 0; r < 4; ++r) { const int rel = kb * 128 + 16 * mt + 4 * g + r - qpos; const bool ok = rel >= -128 && rel <= 128; const int ri = ok ? rel + 128 : 128;
                    const float s = ok ? st[mt][r] * scale + TB[ri] : -1.0e30f; st[mt][r] = s; mx = fmaxf(mx, s); }
            mx = fmaxf(mx, __shfl_xor(mx, 16)); mx = fmaxf(mx, __shfl_xor(mx, 32));
            const float mnew = fmaxf(mrun, mx), alpha = __expf(mrun - mnew); mrun = mnew;
            float ls = 0.f;
#pragma unroll
            for (int mt = 0; mt < 8; ++mt)
#pragma unroll
                for (int r = 0; r < 4; ++r) { const float p = __expf(st[mt][r] - mnew); st[mt][r] = p; ls += p; }
            ls += __shfl_xor(ls, 16); ls += __shfl_xor(ls, 32);
            lrun = lrun * alpha + ls;
#pragma unroll
            for (int dt = 0; dt < 8; ++dt) ot[dt] = ot[dt] * alpha;
#pragma unroll
            for (int k2 = 0; k2 < 4; ++k2) {
                v4u pb; pb.x = pk2(st[2 * k2][0], st[2 * k2][1]); pb.y = pk2(st[2 * k2][2], st[2 * k2][3]); pb.z = pk2(st[2 * k2 + 1][0], st[2 * k2 + 1][1]); pb.w = pk2(st[2 * k2 + 1][2], st[2 * k2 + 1][3]);
                const bf16x8 pfrag = __builtin_bit_cast(bf16x8, pb);
#pragma unroll
                for (int dt = 0; dt < 8; ++dt) { const LAS unsigned char* vrow = L + AT_V + (16 * dt + fr) * 272;
                    const v2u a0 = *(const LAS v2u*)(vrow + 2 * (32 * k2 + 4 * g)), a1 = *(const LAS v2u*)(vrow + 2 * (32 * k2 + 16 + 4 * g));
                    const v4u av = (v4u){a0.x, a0.y, a1.x, a1.y};
                    ot[dt] = __builtin_amdgcn_mfma_f32_16x16x32_bf16(__builtin_bit_cast(bf16x8, av), pfrag, ot[dt], 0, 0, 0); } }
            __syncthreads();
        }
        const float inv = 1.0f / lrun;
#pragma unroll
        for (int dt = 0; dt < 8; ++dt) { v2u o2; o2.x = pk2(ot[dt][0] * inv, ot[dt][1] * inv); o2.y = pk2(ot[dt][2] * inv, ot[dt][3] * inv);
            *(GAS v2u*)(Y + (size_t)qrow * D + HW + h * 128 + 16 * dt + 4 * g) = o2; }
        __syncthreads();
    }
}

struct Args { const float* in[18]; float* out; unsigned char* ws; int ph_lo, ph_hi, li, pad; };
__global__ void __launch_bounds__(NWAVES * 64, 2) hymba_fwd(Args args) {
    extern __shared__ __attribute__((aligned(16))) unsigned char lds[];
    Frame F;
    F.lds = (LAS unsigned char*)lds;
    F.MISC = (volatile LAS unsigned*)(F.lds + MISC_OFF);
    F.tid = threadIdx.x; F.lane = F.tid & 63; F.wave = __builtin_amdgcn_readfirstlane(F.tid >> 6);
    F.G = gridDim.x; { const int bx = blockIdx.x; F.vcu = (F.G % 8 == 0) ? (bx % 8) * (F.G / 8) + bx / 8 : bx; }
    unsigned char* ws = args.ws;
    F.ctl = (gu32*)(ws + WS_CTL);
    F.x = args.in[0]; F.pre1 = args.in[1]; F.post1 = args.in[2]; F.w1gu = args.in[3]; F.w1d = args.in[4]; F.prem = args.in[5]; F.postm = args.in[6]; F.win = args.in[7];
    F.lbf = args.in[8]; F.lbb = args.in[9]; F.ognorm = args.in[10]; F.sink = args.in[11]; F.wout = args.in[12]; F.pre2 = args.in[13]; F.post2 = args.in[14];
    F.w2gu = args.in[15]; F.w2d = args.in[16]; F.relb = args.in[17]; F.out = args.out;
    F.W1GU = (bf16*)(ws + WS_W1GU); F.W1D = (bf16*)(ws + WS_W1D); F.WIN = (bf16*)(ws + WS_WIN); F.WOUT = (bf16*)(ws + WS_WOUT); F.W2GU = (bf16*)(ws + WS_W2GU); F.W2D = (bf16*)(ws + WS_W2D);
    F.H = (bf16*)(ws + WS_H); F.ACT = (bf16*)(ws + WS_ACT); F.FFB = (float*)(ws + WS_FF); F.ssq = (float*)(ws + WS_SSQ);
    for (int u = F.tid; u < (LDS_BYTES - LDSCTL_OFF) / 4; u += NWAVES * 64) ((LAS unsigned*)(F.lds + LDSCTL_OFF))[u] = 0u;
    __syncthreads();
    XcdBarrier bar; bar.bar = (unsigned*)(F.ctl + CW_BAR); bar.x = 0; bar.st = nullptr;
    if (N_LAUNCHES != PER_PHASE) bar = xcd_barrier_post((unsigned*)(F.ctl + CW_BAR), F.MISC + 8);
#define GRID_BAR() do { if (N_LAUNCHES != PER_PHASE) xcd_barrier(bar); } while (0)
    const int lo = args.ph_lo, hi = args.ph_hi;
#define IN(k) (lo <= (k) && (k) < hi)
#define BOTH(k) (IN(k) && IN((k) + 1))
    typedef pg8::StaticOrder SO;
    if (IN(0)) for (int r_ = 0; r_ < REP_P0; ++r_) { p0_prologue(F); if (BOTH(0)) GRID_BAR(); }
    if (IN(1)) for (int r_ = 0; r_ < REP_P1; ++r_) { pg8::Gemm gm{F.H, F.W1GU, M, NGU, D}; SO S; S.init(M, NGU, F.G, (int)blockIdx.x); pg8::EpiSwiglu E{F.ACT, FF};
        pg8::gemm_phase<pg8::EpiSwiglu, SO, PG8_ALIGN, PG8_SP2>(F.lds + RING_OFF, gm, S, E); if (BOTH(1)) GRID_BAR(); }
    if (IN(2)) for (int r_ = 0; r_ < REP_P2; ++r_) { pg8::Gemm gm{F.ACT, F.W1D, M, D, FF}; SO S; S.init(M, D, F.G, (int)blockIdx.x); pg8::EpiF32Ssq E{F.FFB, D, F.ssq};
        pg8::gemm_phase<pg8::EpiF32Ssq, SO, PG8_ALIGN, PG8_SP2>(F.lds + RING_OFF, gm, S, E); if (BOTH(2)) GRID_BAR(); }
    if (IN(3)) for (int r_ = 0; r_ < REP_P3; ++r_) { ew_phase(F, F.x, F.FFB, F.ssq, F.post1, 0.5f, F.out, F.prem, F.H); if (BOTH(3)) GRID_BAR(); }
    if (IN(4)) for (int r_ = 0; r_ < REP_P4; ++r_) { pg8::Gemm gm{F.H, F.WIN, M, NIN, D}; SO S; S.init(M, NIN, F.G, (int)blockIdx.x); pg8::EpiBf16 E{F.ACT, NIN};
        pg8::gemm_phase<pg8::EpiBf16, SO, PG8_ALIGN, PG8_SP2>(F.lds + RING_OFF, gm, S, E); if (BOTH(4)) GRID_BAR(); }
    if (IN(5)) { for (int r_ = 0; r_ < REP_HG; ++r_) hgrn_phase(F, F.ACT, F.FFB); for (int r_ = 0; r_ < REP_AT; ++r_) attn_phase(F, F.ACT, F.H); if (BOTH(5)) GRID_BAR(); }
    if (IN(6)) for (int r_ = 0; r_ < REP_P6; ++r_) { hgrn_out_phase(F, F.ACT, F.FFB, F.H); if (BOTH(6)) GRID_BAR(); }
    if (IN(7)) for (int r_ = 0; r_ < REP_P7; ++r_) { pg8::Gemm gm{F.H, F.WOUT, M, D, D}; SO S; S.init(M, D, F.G, (int)blockIdx.x); pg8::EpiF32Ssq E{F.FFB, D, F.ssq};
        pg8::gemm_phase<pg8::EpiF32Ssq, SO, PG8_ALIGN, PG8_SP2>(F.lds + RING_OFF, gm, S, E); if (BOTH(7)) GRID_BAR(); }
    if (IN(8)) { ew_phase(F, F.out, F.FFB, F.ssq, F.postm, 1.0f, F.out, F.pre2, F.H); if (BOTH(8)) GRID_BAR(); }
    if (IN(9)) { pg8::Gemm gm{F.H, F.W2GU, M, NGU, D}; SO S; S.init(M, NGU, F.G, (int)blockIdx.x); pg8::EpiSwiglu E{F.ACT, FF};
        pg8::gemm_phase<pg8::EpiSwiglu, SO, PG8_ALIGN, PG8_SP2>(F.lds + RING_OFF, gm, S, E); if (BOTH(9)) GRID_BAR(); }
    if (IN(10)) { pg8::Gemm gm{F.ACT, F.W2D, M, D, FF}; SO S; S.init(M, D, F.G, (int)blockIdx.x); pg8::EpiF32Ssq E{F.FFB, D, F.ssq};
        pg8::gemm_phase<pg8::EpiF32Ssq, SO, PG8_ALIGN, PG8_SP2>(F.lds + RING_OFF, gm, S, E); if (BOTH(10)) GRID_BAR(); }
    if (IN(11)) { ew_phase(F, F.out, F.FFB, F.ssq, F.post2, 0.5f, F.out, nullptr, nullptr); }
    if (lo == 100) {
        const int gw = F.vcu * NWAVES + F.wave, NGW = F.G * NWAVES;
        for (int m = gw; m < M; m += NGW) for (int c = F.lane; c < 1024; c += 64) {
            F.out[(size_t)m * D + c] = F.FFB[(size_t)m * HW + c] + F.FFB[(size_t)M * HW + (size_t)m * HW + c];
            F.out[(size_t)m * D + 1024 + c] = bf_lo((unsigned)F.H[(size_t)m * D + 1024 + c]); }
    }
    if (lo == 102 || lo == 103) {
        const int gw = F.vcu * NWAVES + F.wave, NGW = F.G * NWAVES;
        for (int m = gw; m < M; m += NGW) for (int c = F.lane; c < 1024; c += 64) {
            F.out[(size_t)m * D + c] = lo == 102 ? F.FFB[(size_t)m * HW + c] : 0.f;
            F.out[(size_t)m * D + 1024 + c] = lo == 102 ? F.FFB[(size_t)M * HW + (size_t)m * HW + c] : bf_lo((unsigned)F.H[(size_t)m * D + 1024 + c]); }
    }
    if (lo == 101) {
        const int gw = F.vcu * NWAVES + F.wave, NGW = F.G * NWAVES;
        for (int m = gw; m < M; m += NGW) for (int c = F.lane; c < 2048; c += 64) F.out[(size_t)m * D + c] = bf_lo((unsigned)F.ACT[(size_t)m * NIN + DBG_COL0 + c]);
    }
#undef IN
#undef BOTH
}

extern "C" void kernel_launch(void* const* d_in, const int* in_sizes, int n_in, void* d_out, int out_size, void* d_ws, size_t ws_size, hipStream_t stream) {
    static int grid = 0;
    if (grid == 0) {
        if (n_in != 18 || in_sizes[0] != M * D || out_size != M * D || ws_size < WS_END) { fprintf(stderr, "kernel_launch: unexpected shapes/workspace (n_in %d, ws %zu)\n", n_in, ws_size); grid = -1; return; }
        int dev = 0, cus = 0;
        if (hipGetDevice(&dev) != hipSuccess || hipDeviceGetAttribute(&cus, hipDeviceAttributeMultiprocessorCount, dev) != hipSuccess) { grid = -1; return; }
        if (hipFuncSetAttribute((const void*)hymba_fwd, hipFuncAttributeMaxDynamicSharedMemorySize, LDS_BYTES) != hipSuccess) { fprintf(stderr, "kernel_launch: hipFuncSetAttribute failed\n"); grid = -1; return; }
        (void)hipGetLastError();
        grid = cus;
    }
    if (grid < 0) return;
    if (hipMemsetAsync((char*)d_ws + WS_CTL, 0, CTL_ZERO_BYTES, stream) != hipSuccess) return;
    Args a{};
    for (int i = 0; i < 18; ++i) a.in[i] = (const float*)d_in[i];
    a.out = (float*)d_out; a.ws = (unsigned char*)d_ws;
    if (N_LAUNCHES == 1) { a.ph_lo = 0; a.ph_hi = PER_PHASE; a.li = 0; hipLaunchKernelGGL(hymba_fwd, dim3(grid), dim3(NWAVES * 64), LDS_BYTES, stream, a); }
    else { for (int li = 0; li < DBG_HI + 1; ++li) { if (li == DBG_HI && DBG_MODE == 0) break; a.ph_lo = li; a.ph_hi = li + 1; a.li = li; if (li == DBG_HI) { a.ph_lo = DBG_MODE; a.ph_hi = DBG_MODE + 1; } hipLaunchKernelGGL(hymba_fwd, dim3(grid), dim3(NWAVES * 64), LDS_BYTES, stream, a); } }
}
```

```cpp
#include <hip/hip_runtime.h>
#include <cstdio>
#include <cstdint>

#ifndef MK_N_LAUNCHES
#define MK_N_LAUNCHES 1
#endif

namespace pg8 {
#define PG8_LAS __attribute__((address_space(3)))
typedef unsigned short bf16_t;
typedef short bf16x8 __attribute__((ext_vector_type(8)));
typedef float f32x4 __attribute__((ext_vector_type(4)));
typedef unsigned u32x4 __attribute__((ext_vector_type(4)));
#ifndef PG8_WGM
#define PG8_WGM 8
#endif
constexpr int BM = 256, BK = 64, HALF = 128, HTB = HALF * BK * 2  , STAGE_BYTES = 8 * HTB, NXCD = 8, WGM = PG8_WGM;

__host__ __device__ __forceinline__ int lds_byte(int r, int c) { const int st = (r >> 4) * 2 + (c >> 5), rr = r & 15, cc = c & 31, ob = rr * 64 + cc * 2; return st * 1024 + (ob ^ (((ob >> 9) & 1) << 5)); }
__host__ __device__ __forceinline__ void stage_rc(int b, int& R, int& C) { const int st = b / 1024, sb = b % 1024, swz = sb ^ (((sb >> 9) & 1) << 5); R = (st >> 1) * 16 + swz / 64; C = (st & 1) * 32 + (swz % 64) / 2; }
__host__ __device__ __forceinline__ int perm32(int rho) { const int n = rho >> 4, i = rho & 15; return 8 * (i >> 2) + 4 * n + (i & 3); }

struct Unit { int pm, pn; };
struct Gemm { const bf16_t* A; const bf16_t* Bt; int M, N, K; };

struct StaticOrder {
    int nM, nN, nwg, G, c;
    __host__ __device__ void init(int M, int N, int G_, int c_) { nM = M / BM; nN = N / BM; nwg = nM * nN; G = G_; c = c_; }
    __host__ __device__ bool next(int i, Unit& u) const {
        const long L = (long)i * G + c; if (L >= nwg) return false;
        int wgid = (int)L; { const int q = nwg / NXCD, r = nwg % NXCD, xcd = wgid % NXCD, off = wgid / NXCD; wgid = (xcd < r ? xcd * (q + 1) : r * (q + 1) + (xcd - r) * q) + off; }
        const int nig = WGM * nN, gid = wgid / nig, fm = gid * WGM, gsz = (nM - fm) < WGM ? (nM - fm) : WGM;
        u.pm = fm + ((wgid % nig) % gsz); u.pn = (wgid % nig) / gsz; return true;
    }
    __device__ __forceinline__ void a_ready(const Unit&) const {}
    __device__ __forceinline__ void done(const Unit&) const {}
};

typedef __bf16 bf16v2_t __attribute__((ext_vector_type(2)));
typedef float f32v2_t __attribute__((ext_vector_type(2)));
__device__ __forceinline__ unsigned cvt_pk_bf16(float lo, float hi) { const f32v2_t v = {lo, hi}; const bf16v2_t b = __builtin_convertvector(v, bf16v2_t); return __builtin_bit_cast(unsigned, b); }

struct EpiBf16 {
    static constexpr bool PERM = true, AFTER_DRAIN = false;
    bf16_t* O; int ldc;
    __device__ __forceinline__ void operator()(const f32x4 (&acc)[2][2][4][2], const Unit& u, int wr, int wc, int fr, int fq) const {
        const int row0 = u.pm * BM + wr * 64 + fr; const int col0 = u.pn * BM + wc * 32 + 8 * fq;
#pragma unroll
        for (int ai = 0; ai < 2; ++ai)
#pragma unroll
            for (int m = 0; m < 4; ++m) { bf16_t* rowp = O + (size_t)(row0 + ai * HALF + m * 16) * ldc + col0;
#pragma unroll
                for (int bj = 0; bj < 2; ++bj) { const f32x4 v0 = acc[ai][bj][m][0], v1 = acc[ai][bj][m][1];
                    u32x4 w; w.x = cvt_pk_bf16(v0[0], v0[1]); w.y = cvt_pk_bf16(v0[2], v0[3]); w.z = cvt_pk_bf16(v1[0], v1[1]); w.w = cvt_pk_bf16(v1[2], v1[3]);
                    *(u32x4*)(rowp + bj * HALF) = w; } }
    }
};
__device__ __forceinline__ float silu_f(float x) { return x * __builtin_amdgcn_rcpf(1.0f + __builtin_amdgcn_exp2f(-1.4426950408889634f * x)); }
struct EpiSwiglu {
    static constexpr bool PERM = true, AFTER_DRAIN = false;
    bf16_t* O; int ldc;
    __device__ __forceinline__ void operator()(const f32x4 (&acc)[2][2][4][2], const Unit& u, int wr, int wc, int fr, int fq) const {
        const int row0 = u.pm * BM + wr * 64 + fr; const int col0 = u.pn * HALF + wc * 32 + 8 * fq;
#pragma unroll
        for (int ai = 0; ai < 2; ++ai)
#pragma unroll
            for (int m = 0; m < 4; ++m) { bf16_t* rowp = O + (size_t)(row0 + ai * HALF + m * 16) * ldc + col0;
                const f32x4 g0 = acc[ai][0][m][0], g1 = acc[ai][0][m][1], u0 = acc[ai][1][m][0], u1 = acc[ai][1][m][1];
                float r[8];
#pragma unroll
                for (int e = 0; e < 4; ++e) { r[e] = silu_f(g0[e]) * u0[e]; r[4 + e] = silu_f(g1[e]) * u1[e]; }
                u32x4 w; w.x = cvt_pk_bf16(r[0], r[1]); w.y = cvt_pk_bf16(r[2], r[3]); w.z = cvt_pk_bf16(r[4], r[5]); w.w = cvt_pk_bf16(r[6], r[7]);
                *(u32x4*)rowp = w; }
    }
};
struct EpiBf16Ssq {
    static constexpr bool PERM = true, AFTER_DRAIN = false;
    bf16_t* C; int ldc; float* ssq;
    __device__ __forceinline__ void operator()(const f32x4 (&acc)[2][2][4][2], const Unit& u, int wr, int wc, int fr, int fq) const {
        const int row0 = u.pm * BM + wr * 64 + fr, col0 = u.pn * BM + wc * 32 + 8 * fq;
#pragma unroll
        for (int ai = 0; ai < 2; ++ai)
#pragma unroll
            for (int m = 0; m < 4; ++m) { const int row = row0 + ai * HALF + m * 16; bf16_t* rowp = C + (size_t)row * ldc + col0; float s = 0.f;
#pragma unroll
                for (int bj = 0; bj < 2; ++bj) { const f32x4 v0 = acc[ai][bj][m][0], v1 = acc[ai][bj][m][1];
                    s += ((v0[0] * v0[0] + v0[1] * v0[1]) + (v0[2] * v0[2] + v0[3] * v0[3])) + ((v1[0] * v1[0] + v1[1] * v1[1]) + (v1[2] * v1[2] + v1[3] * v1[3]));
                    u32x4 w; w.x = cvt_pk_bf16(v0[0], v0[1]); w.y = cvt_pk_bf16(v0[2], v0[3]); w.z = cvt_pk_bf16(v1[0], v1[1]); w.w = cvt_pk_bf16(v1[2], v1[3]);
                    *(u32x4*)(rowp + bj * HALF) = w; }
                s += __shfl_xor(s, 16); s += __shfl_xor(s, 32);
                if (fq == 0) ssq[row * 32 + u.pn * 4 + wc] = s; }
    }
};

template <class Epi, class Sched, bool ALIGN_EPI = false, bool SP2 = false>
__device__ __forceinline__ void gemm_phase(PG8_LAS unsigned char* lds, const Gemm g, const Sched& S, const Epi& E) {
    const int tid = threadIdx.x, wid = __builtin_amdgcn_readfirstlane(tid >> 6), lane = tid & 63, wr = wid >> 2, wc = wid & 3, fr = lane & 15, fq = lane >> 4;
    const int K = g.K, nt = K / BK;
    unsigned voffA[2], voffB[2];
#pragma unroll
    for (int i = 0; i < 2; ++i) { int R, C; stage_rc(tid * 16 + i * 8192, R, C); const int Rb = Epi::PERM ? ((R & ~31) + perm32(R & 31)) : R;
        voffA[i] = (unsigned)(R * K + C) * 2u; voffB[i] = (unsigned)(Rb * K + C) * 2u; }
    const size_t kstep = (size_t)(BK * 2);
    const size_t hstep = (size_t)HALF * K * 2;
    const size_t tstep = 2 * hstep;
    const unsigned ldsw = (unsigned)wid * 1024u;
    const int aoff = lds_byte(wr * 64 + fr, fq * 8), boff = lds_byte(wc * 32 + fr, fq * 8);
#define PG8_SA(b, h) (((b) * 2 + (h)) * HTB)
#define PG8_SB(b, h) ((4 + (b) * 2 + (h)) * HTB)
#define PG8_STAGE(bufoff, gbase, voff) do { _Pragma("unroll") for (int _i = 0; _i < 2; ++_i) \
        __builtin_amdgcn_global_load_lds((const unsigned*)((const char*)(gbase) + (voff)[_i]), (PG8_LAS unsigned*)(lds + (bufoff) + ldsw + _i * 8192), 16, 0, 0); } while (0)
#define PG8_LDA(dst, b, h) do { _Pragma("unroll") for (int m = 0; m < 4; ++m) _Pragma("unroll") for (int k = 0; k < 2; ++k) dst[m][k] = *(const PG8_LAS bf16x8*)(lds + PG8_SA(b, h) + aoff + m * 2048 + k * 1024); } while (0)
#define PG8_LDB(dst, b, h) do { _Pragma("unroll") for (int n = 0; n < 2; ++n) _Pragma("unroll") for (int k = 0; k < 2; ++k) dst[n][k] = *(const PG8_LAS bf16x8*)(lds + PG8_SB(b, h) + boff + n * 2048 + k * 1024); } while (0)
#define PG8_MMA(ai, bj, At, Bt) do { __builtin_amdgcn_s_setprio(1); _Pragma("unroll") for (int m = 0; m < 4; ++m) _Pragma("unroll") for (int n = 0; n < 2; ++n) _Pragma("unroll") for (int k = 0; k < 2; ++k) \
        acc[ai][bj][m][n] = __builtin_amdgcn_mfma_f32_16x16x32_bf16(Bt[n][k], At[m][k], acc[ai][bj][m][n], 0, 0, 0); __builtin_amdgcn_s_setprio(0); } while (0)
#define PG8_WAIT_V(n) asm volatile("s_waitcnt vmcnt(" #n ")" ::: "memory")
#define PG8_WAIT_L(n) asm volatile("s_waitcnt lgkmcnt(" #n ")" ::: "memory")
#define PG8_BAR __builtin_amdgcn_s_barrier()
#define PG8_SCHED __builtin_amdgcn_sched_barrier(0)
    Unit cur, nxt; int ui = 0;
    if (!S.next(0, cur)) return;
    f32x4 acc[2][2][4][2];
#pragma unroll
    for (int a = 0; a < 2; ++a)
#pragma unroll
        for (int b = 0; b < 2; ++b)
#pragma unroll
            for (int m = 0; m < 4; ++m)
#pragma unroll
                for (int n = 0; n < 2; ++n) acc[a][b][m][n] = (f32x4){0.f, 0.f, 0.f, 0.f};
    bf16x8 At[4][2], B0[2][2], B1[2][2];
    const char* cA = (const char*)g.A + (size_t)cur.pm * tstep; const char* cB = (const char*)g.Bt + (size_t)cur.pn * tstep;
    S.a_ready(cur);
    if constexpr (SP2) {
        PG8_STAGE(PG8_SB(0, 0), cB, voffB); PG8_STAGE(PG8_SB(0, 1), cB + hstep, voffB); PG8_STAGE(PG8_SA(0, 0), cA, voffA); PG8_STAGE(PG8_SA(0, 1), cA + hstep, voffA);
        if (wr == 1) PG8_BAR;
        PG8_WAIT_V(2); PG8_BAR;
        PG8_STAGE(PG8_SB(1, 0), cB + kstep, voffB); PG8_STAGE(PG8_SA(1, 0), cA + kstep, voffA); PG8_STAGE(PG8_SB(1, 1), cB + hstep + kstep, voffB);
        PG8_WAIT_V(6); PG8_BAR;
    } else {
        PG8_STAGE(PG8_SB(0, 0), cB, voffB); PG8_STAGE(PG8_SA(0, 0), cA, voffA); PG8_STAGE(PG8_SB(0, 1), cB + hstep, voffB); PG8_STAGE(PG8_SA(0, 1), cA + hstep, voffA);
        if (wr == 1) PG8_BAR;
        PG8_WAIT_V(4); PG8_BAR;
        PG8_STAGE(PG8_SB(1, 0), cB + kstep, voffB); PG8_STAGE(PG8_SA(1, 0), cA + kstep, voffA); PG8_STAGE(PG8_SB(1, 1), cB + hstep + kstep, voffB);
        PG8_WAIT_V(6); PG8_BAR;
    }
    for (;;) {
        const bool has_next = S.next(ui + 1, nxt);
        const char* nA = has_next ? (const char*)g.A + (size_t)nxt.pm * tstep : cA; const char* nB = has_next ? (const char*)g.Bt + (size_t)nxt.pn * tstep : cB;
        for (int t = 0; t < nt; t += 2) {
            const bool last = (t == nt - 2);
            const char* a1 = cA + (size_t)(t + 1) * kstep;
            const char* a2 = last ? nA : cA + (size_t)(t + 2) * kstep; const char* b2 = last ? nB : cB + (size_t)(t + 2) * kstep;
            const char* a3 = a2 + kstep; const char* b3 = b2 + kstep;
            if (last && has_next) S.a_ready(nxt);
            if constexpr (SP2) {
            PG8_LDB(B0, 0, 0); PG8_LDB(B1, 0, 1); PG8_SCHED; PG8_LDA(At, 0, 0); PG8_STAGE(PG8_SA(1, 1), a1 + hstep, voffA);
            PG8_WAIT_V(8); PG8_WAIT_L(0); PG8_BAR; PG8_MMA(0, 0, At, B0); PG8_MMA(0, 1, At, B1); PG8_BAR; PG8_SCHED;
            PG8_LDA(At, 0, 1); PG8_STAGE(PG8_SB(0, 0), b2, voffB); PG8_STAGE(PG8_SB(0, 1), b2 + hstep, voffB); PG8_STAGE(PG8_SA(0, 0), a2, voffA);
            PG8_WAIT_V(8); PG8_WAIT_L(0); PG8_BAR; PG8_MMA(1, 0, At, B0); PG8_MMA(1, 1, At, B1); PG8_BAR; PG8_SCHED;
            PG8_LDB(B0, 1, 0); PG8_LDB(B1, 1, 1); PG8_SCHED; PG8_LDA(At, 1, 0); PG8_STAGE(PG8_SA(0, 1), a2 + hstep, voffA);
            PG8_WAIT_V(8); PG8_WAIT_L(0); PG8_BAR; PG8_MMA(0, 0, At, B0); PG8_MMA(0, 1, At, B1); PG8_BAR; PG8_SCHED;
            PG8_LDA(At, 1, 1); PG8_STAGE(PG8_SB(1, 0), b3, voffB); PG8_STAGE(PG8_SB(1, 1), b3 + hstep, voffB); PG8_STAGE(PG8_SA(1, 0), a3, voffA);
            PG8_WAIT_V(8); PG8_WAIT_L(0); PG8_BAR; PG8_MMA(1, 0, At, B0); PG8_MMA(1, 1, At, B1); PG8_BAR; PG8_SCHED;
            } else {
            PG8_LDB(B0, 0, 0); PG8_SCHED; PG8_LDA(At, 0, 0); PG8_STAGE(PG8_SA(1, 1), a1 + hstep, voffA);
            PG8_WAIT_L(8); PG8_BAR; PG8_WAIT_L(0); PG8_MMA(0, 0, At, B0); PG8_BAR; PG8_SCHED;
            PG8_LDB(B1, 0, 1); PG8_STAGE(PG8_SB(0, 0), b2, voffB);
            PG8_BAR; PG8_WAIT_L(0); PG8_MMA(0, 1, At, B1); PG8_BAR;
            PG8_LDA(At, 0, 1); PG8_STAGE(PG8_SA(0, 0), a2, voffA);
            PG8_BAR; PG8_WAIT_L(0); PG8_MMA(1, 0, At, B0); PG8_BAR; PG8_SCHED;
            PG8_STAGE(PG8_SB(0, 1), b2 + hstep, voffB);
            PG8_WAIT_V(6); PG8_BAR; PG8_MMA(1, 1, At, B1); PG8_BAR;
            PG8_LDB(B0, 1, 0); PG8_SCHED; PG8_LDA(At, 1, 0); PG8_STAGE(PG8_SA(0, 1), a2 + hstep, voffA);
            PG8_WAIT_L(8); PG8_BAR; PG8_WAIT_L(0); PG8_MMA(0, 0, At, B0); PG8_BAR; PG8_SCHED;
            PG8_LDB(B1, 1, 1); PG8_STAGE(PG8_SB(1, 0), b3, voffB);
            PG8_BAR; PG8_WAIT_L(0); PG8_MMA(0, 1, At, B1); PG8_BAR;
            PG8_LDA(At, 1, 1); PG8_STAGE(PG8_SA(1, 0), a3, voffA);
            PG8_BAR; PG8_WAIT_L(0); PG8_MMA(1, 0, At, B0); PG8_BAR; PG8_SCHED;
            PG8_STAGE(PG8_SB(1, 1), b3 + hstep, voffB);
            PG8_WAIT_V(6); PG8_BAR; PG8_MMA(1, 1, At, B1); PG8_BAR;
            }
        }
        if constexpr (ALIGN_EPI) { if (wr == 0) PG8_BAR; }
        if constexpr (!Epi::AFTER_DRAIN) { E(acc, cur, wr, wc, fr, fq); S.done(cur); }
        if (!has_next) break;
#pragma unroll
        for (int a = 0; a < 2; ++a)
#pragma unroll
            for (int b = 0; b < 2; ++b)
#pragma unroll
                for (int m = 0; m < 4; ++m)
#pragma unroll
                    for (int n = 0; n < 2; ++n) acc[a][b][m][n] = (f32x4){0.f, 0.f, 0.f, 0.f};
        cur = nxt; cA = nA; cB = nB; ++ui;
        if constexpr (ALIGN_EPI) { if (wr == 1) PG8_BAR; }
    }
    PG8_WAIT_V(0);
    if constexpr (!ALIGN_EPI) { if (wr == 0) PG8_BAR; }
    PG8_BAR;
#undef PG8_SA
#undef PG8_SB
#undef PG8_STAGE
#undef PG8_LDA
#undef PG8_LDB
#undef PG8_MMA
#undef PG8_WAIT_V
#undef PG8_WAIT_L
#undef PG8_BAR
#undef PG8_SCHED
}
}

#ifndef REP_P0
#define REP_P0 1
#endif
#ifndef REP_P1
#define REP_P1 1
#endif
#ifndef REP_P2
#define REP_P2 1
#endif
#ifndef REP_P3
#define REP_P3 1
#endif
#ifndef REP_P4
#define REP_P4 1
#endif
#ifndef REP_HG
#define REP_HG 1
#endif
#ifndef REP_AT
#define REP_AT 1
#endif
#ifndef REP_P6
#define REP_P6 1
#endif
#ifndef REP_P7
#define REP_P7 1
#endif
#ifndef PROBE_MULT
#define PROBE_MULT 8
#endif
#ifndef PG8_SP2
#define PG8_SP2 true
#endif
#ifndef PG8_ALIGN
#define PG8_ALIGN true
#endif

constexpr int NWAVES = 8;
constexpr int N_LAUNCHES = MK_N_LAUNCHES;
constexpr int PER_PHASE = 12;

constexpr int BATCH = 4, SEQ = 2048, D = 2048, FF = 5632, NGU = 2 * FF, NIN = 6656;
constexpr int M = BATCH * SEQ;
constexpr int HW = 1024, HH = 8, HD = 128;
constexpr int AH = 8, AKV = 2;
constexpr int CQH = 0, CIH = 1024, CFF = 2048, CFB = 3072, CGH = 4096, CQA = 5120, CKA = 6144, CVA = 6400;
constexpr float EPS = 1e-6f;

constexpr size_t MiB = 1u << 20;
constexpr size_t WS_CTL = 0, CTL_ZERO_BYTES = 32768;
constexpr size_t WS_W1GU = 2 * MiB, WS_W1D = 46 * MiB, WS_WIN = 68 * MiB, WS_WOUT = 94 * MiB, WS_W2GU = 102 * MiB, WS_W2D = 146 * MiB;
constexpr size_t WS_H = 168 * MiB;
constexpr size_t WS_ACT = 200 * MiB;
constexpr size_t WS_FF = 304 * MiB;
constexpr size_t WS_END = 368 * MiB;
constexpr int CW_BAR = 4096;
constexpr size_t WS_SSQ = 1 * MiB;

constexpr int RING_OFF = 0, RING_BYTES = 131072;
constexpr int LDSCTL_OFF = RING_BYTES, MISC_OFF = LDSCTL_OFF + 320;
constexpr int LDS_BYTES = 147456;

#define GAS __attribute__((address_space(1)))
#define LAS __attribute__((address_space(3)))
typedef unsigned short bf16;
typedef unsigned v4u __attribute__((ext_vector_type(4)));
typedef unsigned v2u __attribute__((ext_vector_type(2)));
typedef float f32x4 __attribute__((ext_vector_type(4)));
typedef short bf16x8 __attribute__((ext_vector_type(8)));
typedef short bf16x4 __attribute__((ext_vector_type(4)));
typedef GAS unsigned gu32;
#define RLX_AGENT __ATOMIC_RELAXED, __HIP_MEMORY_SCOPE_AGENT
#define LDS_WAIT() asm volatile("s_waitcnt lgkmcnt(0)" ::: "memory")
#define VM_WAIT() asm volatile("s_waitcnt vmcnt(0)" ::: "memory")
__device__ __forceinline__ unsigned f2bf(float f) { unsigned u = __builtin_bit_cast(unsigned, f); return (u + 0x7fffu + ((u >> 16) & 1u)) >> 16; }
__device__ __forceinline__ unsigned pk2(float lo, float hi) { return pg8::cvt_pk_bf16(lo, hi); }
__device__ __forceinline__ float bf_lo(unsigned u) { return __builtin_bit_cast(float, u << 16); }
__device__ __forceinline__ float bf_hi(unsigned u) { return __builtin_bit_cast(float, u & 0xffff0000u); }

#define XB_TMO      128
#define XB_XCNT(j)  (256  + 64 * (j))
#define XB_XSUB(j)  (1280 + 64 * (j))
#define XB_XGEN(j)  (2304 + 64 * (j))
#define XB_TOP      3328
#define XB_TOPGEN   3392
#define XCD_BAR_WORDS 3456
#define XB_SPIN_CAP (1u << 20)

__device__ __forceinline__ unsigned xb_ld(unsigned* p)              { return __hip_atomic_load(p, __ATOMIC_RELAXED, __HIP_MEMORY_SCOPE_AGENT); }
__device__ __forceinline__ unsigned xb_add(unsigned* p, unsigned v) { return __hip_atomic_fetch_add(p, v, __ATOMIC_RELAXED, __HIP_MEMORY_SCOPE_AGENT); }
__device__ __forceinline__ unsigned xb_xcc_id() { return (unsigned)__builtin_amdgcn_s_getreg((3 << 11) | 20) & 0xFu; }
#define XB_SPIN(cond, bar) do { unsigned _sp = 0; while (cond) { __builtin_amdgcn_s_sleep(1); \
    if ((++_sp & 255u) == 0u) { if (xb_ld(&(bar)[XB_TMO])) break; if (_sp > XB_SPIN_CAP) { atomicAdd(&(bar)[XB_TMO], 1u); break; } } } } while (0)

struct XcdBarrier { unsigned* bar; unsigned x; volatile LAS unsigned* st; };

__device__ __forceinline__ XcdBarrier xcd_barrier_post(unsigned* bar, volatile LAS unsigned* st) {
    XcdBarrier b; b.bar = bar; b.x = xb_xcc_id(); b.st = st;
    if (threadIdx.x == 0) (void)xb_add(&bar[XB_XCNT(b.x)], 1u);
    return b;
}
__device__ __forceinline__ void xcd_barrier_complete(unsigned* bar, unsigned x, unsigned& nloc, unsigned& nx) {
    const unsigned G = gridDim.x * gridDim.y * gridDim.z;
    unsigned sum, cnt, mine, sp = 0u;
    for (;;) {
        sum = 0u; cnt = 0u; mine = 0u;
#pragma unroll
        for (unsigned j = 0; j < 16; ++j) { const unsigned c = xb_ld(&bar[XB_XCNT(j)]); sum += c; cnt += (c > 0u) ? 1u : 0u; mine = (j == x) ? c : mine; }
        if (sum == G) break;
        __builtin_amdgcn_s_sleep(1);
        if ((++sp & 255u) == 0u) { if (xb_ld(&bar[XB_TMO])) break; if (sp > XB_SPIN_CAP) { atomicAdd(&bar[XB_TMO], 1u); break; } }
    }
    nloc = mine > 0u ? mine : 1u; nx = cnt > 0u ? cnt : 1u;
}
__device__ __forceinline__ void xcd_barrier(const XcdBarrier& b) {
    asm volatile("s_waitcnt vmcnt(0)" ::: "memory");
    __syncthreads();
    if (threadIdx.x == 0) {
        unsigned* bar = b.bar;
        __builtin_amdgcn_s_waitcnt(0);
        unsigned nloc = b.st[0], nx = b.st[1];
        if (nloc == 0u) { xcd_barrier_complete(bar, b.x, nloc, nx); b.st[0] = nloc; b.st[1] = nx; }
        const unsigned old = xb_add(&bar[XB_XSUB(b.x)], 1u);
        const unsigned gen = old / nloc;
        if (old + 1u == (gen + 1u) * nloc) {
            __builtin_amdgcn_fence(__ATOMIC_RELEASE, "agent");
            asm volatile("s_waitcnt vmcnt(0)" ::: "memory");
            const unsigned og = xb_add(&bar[XB_TOP], 1u);
            const unsigned tg = og / nx;
            if (og + 1u == (tg + 1u) * nx) xb_add(&bar[XB_TOPGEN], 1u);
            else XB_SPIN(xb_ld(&bar[XB_TOPGEN]) == tg, bar);
            __builtin_amdgcn_fence(__ATOMIC_ACQUIRE, "agent");
            xb_add(&bar[XB_XGEN(b.x)], 1u);
            asm volatile("s_waitcnt vmcnt(0)" ::: "memory");
        } else {
            XB_SPIN(xb_ld(&bar[XB_XGEN(b.x)]) == gen, bar);
            __builtin_amdgcn_fence(__ATOMIC_ACQUIRE, "agent");
            asm volatile("s_waitcnt vmcnt(0)" ::: "memory");
        }
    }
    __syncthreads();
}

struct Frame {
    LAS unsigned char* lds;
    volatile LAS unsigned* MISC;
    gu32* ctl;
    int tid, lane, wave;
    int vcu, G;
    const float* x; float* out;
    const float *pre1, *post1, *w1gu, *w1d, *prem, *postm, *win, *lbf, *lbb, *ognorm, *sink, *wout, *pre2, *post2, *w2gu, *w2d, *relb;
    bf16 *W1GU, *W1D, *WIN, *WOUT, *W2GU, *W2D;
    bf16 *H, *ACT, *FFB, *XR; float* SLB; float* ssq;
};

__device__ __forceinline__ float wave_sum(float v) {
#pragma unroll
    for (int o = 1; o < 64; o <<= 1) v += __shfl_xor(v, o);
    return v;
}
struct CvItem { const float* src; bf16* dst; int K, N; };
__device__ __forceinline__ CvItem cv_item(const float* W, int K, int N, bf16* WT, bool gu, int item) {
    const int nblk = N / 32, kb = item / nblk, nb = item % nblk, k0 = 64 * kb, n0 = 32 * nb;
    int r0 = n0;
    if (gu) { const int half = N / 2; const int nn = n0 < half ? n0 : n0 - half; r0 = 256 * (nn / 128) + (nn % 128) + (n0 < half ? 0 : 128); }
    CvItem c; c.src = W + (size_t)k0 * N + n0; c.dst = WT + (size_t)r0 * K + k0; c.K = K; c.N = N; return c;
}
constexpr int I_GU = (D / 64) * (NGU / 32), I_DN = (FF / 64) * (D / 32), I_IN = (D / 64) * (NIN / 32), I_OUT = (D / 64) * (D / 32);
template <int LIST>
__device__ __forceinline__ CvItem cv_list_item(Frame& F, int r) {
    if (LIST == 0) return cv_item(F.w1gu, D, NGU, F.W1GU, true, r);
    if (LIST == 1) { if (r < I_DN) return cv_item(F.w1d, FF, D, F.W1D, false, r); r -= I_DN; if (r < I_IN) return cv_item(F.win, D, NIN, F.WIN, false, r); r -= I_IN; return cv_item(F.wout, D, D, F.WOUT, false, r); }
    if (LIST == 2) return cv_item(F.w2gu, D, NGU, F.W2GU, true, r);
    return cv_item(F.w2d, FF, D, F.W2D, false, r);
}
template <int LIST>
__device__ __forceinline__ void convert_list(Frame& F, int worker, int nworkers) {
    LAS float* scr = (LAS float*)(F.lds + RING_OFF + F.wave * 16384);
    constexpr int NITEMS = LIST == 0 ? I_GU : (LIST == 1 ? I_DN + I_IN + I_OUT : (LIST == 2 ? I_GU : I_DN));
    const int lane = F.lane;
    int it = worker; if (it >= NITEMS) return;
    CvItem cur = cv_list_item<LIST>(F, it);
    float r[32];
#pragma unroll
    for (int i = 0; i < 32; ++i) r[i] = cur.src[(size_t)(2 * i + (lane >> 5)) * cur.N + (lane & 31)];
    for (;;) {
#pragma unroll
        for (int i = 0; i < 32; ++i) scr[(2 * i + (lane >> 5)) * 33 + (lane & 31)] = r[i];
        const int nxt = it + nworkers; const bool has = nxt < NITEMS; CvItem nd = cur;
        if (has) { nd = cv_list_item<LIST>(F, nxt);
#pragma unroll
            for (int i = 0; i < 32; ++i) r[i] = nd.src[(size_t)(2 * i + (lane >> 5)) * nd.N + (lane & 31)]; }
        LDS_WAIT(); asm volatile("" ::: "memory");
        const int c = lane & 7;
#pragma unroll
        for (int j = 0; j < 4; ++j) { const int n = (lane >> 3) + 8 * j; const LAS float* sp = scr + (8 * c) * 33 + n;
            v4u o; o.x = pk2(sp[0 * 33], sp[1 * 33]); o.y = pk2(sp[2 * 33], sp[3 * 33]); o.z = pk2(sp[4 * 33], sp[5 * 33]); o.w = pk2(sp[6 * 33], sp[7 * 33]);
            *(GAS v4u*)(cur.dst + (size_t)n * cur.K + 8 * c) = o; }
        LDS_WAIT(); asm volatile("" ::: "memory");
        if (!has) break;
        cur = nd; it = nxt;
    }
}
__device__ __forceinline__ void rms_rows_to_bf16(int lane, const float* x, const float* gain, bf16* out, int first, int stride) {
    if (first >= M) return;
    const GAS f32x4* gr = (const GAS f32x4*)gain + lane;
    f32x4 v[8];
#pragma unroll
    for (int j = 0; j < 8; ++j) v[j] = ((const GAS f32x4*)(x + (size_t)first * D) + lane)[64 * j];
    for (int m = first; m < M; m += stride) {
        f32x4 c[8]; float s = 0.f;
#pragma unroll
        for (int j = 0; j < 8; ++j) { c[j] = v[j]; s += (c[j].x * c[j].x + c[j].y * c[j].y) + (c[j].z * c[j].z + c[j].w * c[j].w); }
        if (m + stride < M) {
#pragma unroll
            for (int j = 0; j < 8; ++j) v[j] = ((const GAS f32x4*)(x + (size_t)(m + stride) * D) + lane)[64 * j]; }
        const float rs = 1.0f / sqrtf(wave_sum(s) * (1.f / D) + EPS);
        GAS v2u* o8 = (GAS v2u*)(out + (size_t)m * D) + lane;
#pragma unroll
        for (int j = 0; j < 8; ++j) { const f32x4 g = gr[64 * j]; v2u o; o.x = pk2(c[j].x * rs * g.x, c[j].y * rs * g.y); o.y = pk2(c[j].z * rs * g.z, c[j].w * rs * g.w); o8[64 * j] = o; }
    }
}
__device__ __forceinline__ void p0_prologue(Frame& F) {
    const int gw = F.vcu * NWAVES + F.wave, NGW = F.G * NWAVES;
    convert_list<0>(F, gw, NGW);
    rms_rows_to_bf16(F.lane, F.x, F.pre1, F.H, gw, NGW);
}
template <bool XIN_F32, bool XOUT_F32>
__device__ __forceinline__ void ew_phase(Frame& F, const void* xi, const bf16* ff, const float* ssq, const float* post, float coef, void* xo, const float* pre, bf16* h) {
    const int gw = F.vcu * NWAVES + F.wave, NGW = F.G * NWAVES;
    for (int m = gw; m < M; m += NGW) {
        const float part = (F.lane < 32) ? ssq[m * 32 + F.lane] : 0.f;
        const float rs = coef / sqrtf(wave_sum(part) * (1.f / D) + EPS);
        const GAS v2u* fr = (const GAS v2u*)(ff + (size_t)m * D) + F.lane; const GAS f32x4* pr = (const GAS f32x4*)post + F.lane;
        f32x4 v[8]; float s = 0.f;
#pragma unroll
        for (int j = 0; j < 8; ++j) { f32x4 a;
            if (XIN_F32) a = ((const GAS f32x4*)((const float*)xi + (size_t)m * D) + F.lane)[64 * j];
            else { const v2u t = ((const GAS v2u*)((const bf16*)xi + (size_t)m * D) + F.lane)[64 * j]; a = (f32x4){bf_lo(t.x), bf_hi(t.x), bf_lo(t.y), bf_hi(t.y)}; }
            const v2u fb = fr[64 * j]; const f32x4 b = (f32x4){bf_lo(fb.x), bf_hi(fb.x), bf_lo(fb.y), bf_hi(fb.y)}; const f32x4 g = pr[64 * j];
            v[j] = a + b * g * rs;
            if (XOUT_F32) ((GAS f32x4*)((float*)xo + (size_t)m * D) + F.lane)[64 * j] = v[j];
            else { v2u o; o.x = pk2(v[j].x, v[j].y); o.y = pk2(v[j].z, v[j].w); ((GAS v2u*)((bf16*)xo + (size_t)m * D) + F.lane)[64 * j] = o;
                   v[j] = (f32x4){bf_lo(o.x), bf_hi(o.x), bf_lo(o.y), bf_hi(o.y)}; }
            s += (v[j].x * v[j].x + v[j].y * v[j].y) + (v[j].z * v[j].z + v[j].w * v[j].w); }
        if (h) {
            const float r2 = 1.0f / sqrtf(wave_sum(s) * (1.f / D) + EPS);
            const GAS f32x4* gr = (const GAS f32x4*)pre + F.lane; GAS v2u* o8 = (GAS v2u*)(h + (size_t)m * D) + F.lane;
#pragma unroll
            for (int j = 0; j < 8; ++j) { const f32x4 g = gr[64 * j]; v2u o; o.x = pk2(v[j].x * r2 * g.x, v[j].y * r2 * g.y); o.y = pk2(v[j].z * r2 * g.z, v[j].w * r2 * g.w); o8[64 * j] = o; }
        }
    }
}

__device__ __forceinline__ bf16x8 ldsfrag(LAS unsigned char* base, int row, int stride, int kbyte) { return *(const LAS bf16x8*)(base + row * stride + kbyte); }
constexpr int H2_QD = 0, H2_KD = 17408, H2_KT0 = 34816, H2_KT1 = 53248, H2_VT0 = 71680, H2_VT1 = 90112, H2_PS = 108544, H2_DEC0 = 117760, H2_DEC1 = 118272, H2_RED = 118784, H2_LB = 126976, H2_END = 127488;
static_assert(H2_END <= RING_BYTES, "HGRN LDS map");
static_assert((CW_BAR + 3456) * 4 <= (int)CTL_ZERO_BYTES, "barrier words inside the memset region");
__device__ __forceinline__ void wave_scan_mul8(float (&v)[8]) {
#define SCAN_ROUND(ctrl) \
    "v_mul_f32_dpp %0, %0, %0 " ctrl "\n\tv_mul_f32_dpp %1, %1, %1 " ctrl "\n\tv_mul_f32_dpp %2, %2, %2 " ctrl "\n\tv_mul_f32_dpp %3, %3, %3 " ctrl "\n\t" \
    "v_mul_f32_dpp %4, %4, %4 " ctrl "\n\tv_mul_f32_dpp %5, %5, %5 " ctrl "\n\tv_mul_f32_dpp %6, %6, %6 " ctrl "\n\tv_mul_f32_dpp %7, %7, %7 " ctrl "\n\t"
    asm volatile("s_nop 1\n\t"
        SCAN_ROUND("row_shr:1 row_mask:0xf bank_mask:0xf") SCAN_ROUND("row_shr:2 row_mask:0xf bank_mask:0xf") SCAN_ROUND("row_shr:4 row_mask:0xf bank_mask:0xf")
        SCAN_ROUND("row_shr:8 row_mask:0xf bank_mask:0xf") SCAN_ROUND("row_bcast:15 row_mask:0xa bank_mask:0xf") SCAN_ROUND("row_bcast:31 row_mask:0xc bank_mask:0xf")
        "s_nop 1"
        : "+v"(v[0]), "+v"(v[1]), "+v"(v[2]), "+v"(v[3]), "+v"(v[4]), "+v"(v[5]), "+v"(v[6]), "+v"(v[7]));
#undef SCAN_ROUND
}
template <bool FULL>
__device__ __forceinline__ void hg_stage(LAS unsigned char* L, int ktoff, int decoff, int w, int l, bool bwd, const v4u (&zr)[2], const v4u (&qr)[2], float (&el)[16]) {
#pragma unroll
    for (int hh = 0; hh < 2; ++hh) {
        float f[8], kk[8], E[8], lbv[8];
        { const f32x4 l0 = *(const LAS f32x4*)(L + H2_LB + (16 * w + 8 * hh) * 4), l1 = *(const LAS f32x4*)(L + H2_LB + (16 * w + 8 * hh + 4) * 4);
          lbv[0] = l0[0]; lbv[1] = l0[1]; lbv[2] = l0[2]; lbv[3] = l0[3]; lbv[4] = l1[0]; lbv[5] = l1[1]; lbv[6] = l1[2]; lbv[7] = l1[3]; }
#pragma unroll
        for (int i = 0; i < 8; ++i) { const unsigned zw = zr[hh][i >> 1]; const float z = (i & 1) ? bf_hi(zw) : bf_lo(zw);
            const float sig = __builtin_amdgcn_rcpf(1.0f + __builtin_amdgcn_exp2f(-1.4426950408889634f * z)); f[i] = lbv[i] + (1.0f - lbv[i]) * sig; kk[i] = 1.0f - f[i]; }
#pragma unroll
        for (int i = 0; i < 8; ++i) E[i] = f[i];
        wave_scan_mul8(E);
        float qd[8], kd[8], kt[8];
#pragma unroll
        for (int i = 0; i < 8; ++i) { const float last = __builtin_bit_cast(float, __builtin_amdgcn_readlane(__builtin_bit_cast(int, E[i]), 63)); el[8 * hh + i] = last;
            const float rE = __builtin_amdgcn_rcpf(E[i]); const float C = bwd ? last * f[i] * rE : E[i]; const float Cinv = bwd ? __builtin_amdgcn_rcpf(C) : rE;
            kd[i] = kk[i] * Cinv; kt[i] = kd[i] * last;
            if (FULL) { const unsigned qw = qr[hh][i >> 1]; const float q = (i & 1) ? bf_hi(qw) : bf_lo(qw); qd[i] = q * C; } }
        if (FULL) { v4u a;
            a.x = pk2(qd[0], qd[1]); a.y = pk2(qd[2], qd[3]); a.z = pk2(qd[4], qd[5]); a.w = pk2(qd[6], qd[7]);
            *(LAS v4u*)(L + H2_QD + l * 272 + 32 * w + 16 * hh) = a;
            a.x = pk2(kd[0], kd[1]); a.y = pk2(kd[2], kd[3]); a.z = pk2(kd[4], kd[5]); a.w = pk2(kd[6], kd[7]);
            *(LAS v4u*)(L + H2_KD + l * 272 + 32 * w + 16 * hh) = a; }
#pragma unroll
        for (int i = 0; i < 8; i += 2) { const unsigned pw = pk2(kt[i], kt[i + 1]);
            *(LAS unsigned short*)(L + ktoff + (16 * w + 8 * hh + i) * 144 + 2 * l) = (unsigned short)(pw & 0xffffu); *(LAS unsigned short*)(L + ktoff + (16 * w + 8 * hh + i + 1) * 144 + 2 * l) = (unsigned short)(pw >> 16); }
        if (l == 0) {
#pragma unroll
            for (int i = 0; i < 8; ++i) *(LAS float*)(L + decoff + (16 * w + 8 * hh + i) * 4) = el[8 * hh + i];
        }
    }
}
__device__ __forceinline__ void hg_write_lb(LAS unsigned char* L, const float* lbf, const float* lbb, bool bwd, int h, int w, int l) {
    if (l < 16) { const int i0 = h * 128 + 16 * w + l; const float f0 = lbf[i0], f1 = lbf[HW + i0], b0 = lbb[i0], b1 = lbb[HW + i0];
        const float a0 = bwd ? b0 : f0, a1 = bwd ? b1 : f1; *(LAS float*)(L + H2_LB + (16 * w + l) * 4) = 1.0f / (1.0f + __expf(a1 - a0)); }
}
__device__ __forceinline__ void hg_stage_v(LAS unsigned char* L, int vtoff, int w, int l, const v4u (&vr)[2]) {
#pragma unroll
    for (int i = 0; i < 8; ++i) { const unsigned vw = vr[i >> 2][i & 3];
        *(LAS unsigned short*)(L + vtoff + (16 * w + 2 * i) * 144 + 2 * l) = (unsigned short)(vw & 0xffffu); *(LAS unsigned short*)(L + vtoff + (16 * w + 2 * i + 1) * 144 + 2 * l) = (unsigned short)(vw >> 16); }
}
__device__ __forceinline__ void hg_state_update(LAS unsigned char* L, int ktoff, int vtoff, int decoff, int w, int g, int fr, f32x4 (&S)[8]) {
    bf16x8 vf[2];
#pragma unroll
    for (int k2 = 0; k2 < 2; ++k2) vf[k2] = ldsfrag(L + vtoff, 16 * w + fr, 144, 64 * k2 + 16 * g);
#pragma unroll
    for (int kt = 0; kt < 8; ++kt) { const f32x4 d4 = *(const LAS f32x4*)(L + decoff + (16 * kt + 4 * g) * 4); S[kt] = S[kt] * d4;
#pragma unroll
        for (int k2 = 0; k2 < 2; ++k2) S[kt] = __builtin_amdgcn_mfma_f32_16x16x32_bf16(ldsfrag(L + ktoff, 16 * kt + fr, 144, 64 * k2 + 16 * g), vf[k2], S[kt], 0, 0, 0); }
}
__device__ __forceinline__ size_t hg_slot(int dir, int b, int h, int sc) { return (size_t)(((dir * BATCH + b) * HH + h) * 8 + sc); }

struct HgIn { v4u z[2], q[2], v[2]; };
template <bool FULL>
__device__ __forceinline__ void hg_load(HgIn& r, const bf16* P, int b, int h, int w, int l, int cn, bool bwd) {
    const bf16* row = P + (size_t)(b * SEQ + cn * 64 + l) * NIN;
    const int colz = (bwd ? CFB : CFF) + h * 128 + 16 * w, colv = CIH + h * 128 + 16 * w, colq = CQH + h * 128 + 16 * w;
    r.z[0] = *(const GAS v4u*)(row + colz); r.z[1] = *(const GAS v4u*)(row + colz + 8); r.v[0] = *(const GAS v4u*)(row + colv); r.v[1] = *(const GAS v4u*)(row + colv + 8);
    if (FULL) { r.q[0] = *(const GAS v4u*)(row + colq); r.q[1] = *(const GAS v4u*)(row + colq + 8); } else { r.q[0] = r.z[0]; r.q[1] = r.z[1]; }
}
__device__ __forceinline__ void hgrn_pass1(Frame& F, const bf16* P, float* SL, float* DL) {
    LAS unsigned char* L = F.lds + RING_OFF;
    const int w = F.wave, l = F.lane, g = l >> 4, fr = l & 15;
    for (int item = F.vcu; item < 256; item += F.G) { const int b = item >> 6, h = (item >> 3) & 7, sc = item & 7;
        HgIn in; hg_load<false>(in, P, b, h, w, l, sc * 4, false);
        f32x4 S[8]; float dtot[16];
        for (int t = 0; t < 8; ++t) { const bool bwd = t >= 4; const int n = t & 3, buf = t & 1;
            if (n == 0) { hg_write_lb(L, F.lbf, F.lbb, bwd, h, w, l);
#pragma unroll
                for (int kt = 0; kt < 8; ++kt) S[kt] = (f32x4){0.f, 0.f, 0.f, 0.f};
#pragma unroll
                for (int i = 0; i < 16; ++i) dtot[i] = 1.0f; }
            float el[16];
            hg_stage_v(L, buf ? H2_VT1 : H2_VT0, w, l, in.v);
            hg_stage<false>(L, buf ? H2_KT1 : H2_KT0, buf ? H2_DEC1 : H2_DEC0, w, l, bwd, in.z, in.q, el);
            if (t + 1 < 8) { const bool nb = (t + 1) >= 4; const int nn = (t + 1) & 3; hg_load<false>(in, P, b, h, w, l, sc * 4 + (nb ? 3 - nn : nn), nb); }
#pragma unroll
            for (int i = 0; i < 16; ++i) dtot[i] *= el[i];
            __syncthreads();
            hg_state_update(L, buf ? H2_KT1 : H2_KT0, buf ? H2_VT1 : H2_VT0, buf ? H2_DEC1 : H2_DEC0, w, g, fr, S);
            if (n == 3) { const size_t slot = hg_slot(bwd ? 1 : 0, b, h, sc); float* so = SL + slot * 16384;
#pragma unroll
                for (int kt = 0; kt < 8; ++kt) *(GAS f32x4*)(so + (size_t)((kt * 8 + w) * 64 + l) * 4) = S[kt];
                if (l == 0) {
#pragma unroll
                    for (int i = 0; i < 16; ++i) DL[slot * 128 + 16 * w + i] = dtot[i];
                } }
        }
        __syncthreads();
    }
}

__device__ __forceinline__ void hgrn_pass2_compute(LAS unsigned char* L, int w, int g, int fr, bool bwd, int vtoff, f32x4 (&S)[8], f32x4 (&o)[4]) {
    {   const int ct = w >> 1, sh = w & 1;
        bf16x8 qfr[4];
#pragma unroll
        for (int ks = 0; ks < 4; ++ks) qfr[ks] = ldsfrag(L + H2_QD, 16 * ct + fr, 272, 64 * ks + 16 * g);
#pragma unroll
        for (int t2 = 0; t2 < 2; ++t2) { const int st = 2 * sh + t2; f32x4 sc4 = (f32x4){0.f, 0.f, 0.f, 0.f};
#pragma unroll
            for (int ks = 0; ks < 4; ++ks) sc4 = __builtin_amdgcn_mfma_f32_16x16x32_bf16(ldsfrag(L + H2_KD, 16 * st + fr, 272, 64 * ks + 16 * g), qfr[ks], sc4, 0, 0, 0);
            const int c = 16 * ct + fr, s0 = 16 * st + 4 * g;
            float m[4];
#pragma unroll
            for (int r = 0; r < 4; ++r) { const bool keep = bwd ? (s0 + r >= c) : (s0 + r <= c); m[r] = keep ? sc4[r] : 0.f; }
            v2u pw; pw.x = pk2(m[0], m[1]); pw.y = pk2(m[2], m[3]);
            *(LAS v2u*)(L + H2_PS + c * 144 + 2 * s0) = pw; } }
    {   bf16x8 sa[4];
#pragma unroll
        for (int k2 = 0; k2 < 4; ++k2) { v4u t; t.x = pk2(S[2 * k2][0], S[2 * k2][1]); t.y = pk2(S[2 * k2][2], S[2 * k2][3]); t.z = pk2(S[2 * k2 + 1][0], S[2 * k2 + 1][1]); t.w = pk2(S[2 * k2 + 1][2], S[2 * k2 + 1][3]); sa[k2] = __builtin_bit_cast(bf16x8, t); }
#pragma unroll
        for (int ct = 0; ct < 4; ++ct) { const LAS unsigned char* qrow = L + H2_QD + (16 * ct + fr) * 272; o[ct] = (f32x4){0.f, 0.f, 0.f, 0.f};
#pragma unroll
            for (int k2 = 0; k2 < 4; ++k2) { const v2u b0 = *(const LAS v2u*)(qrow + 2 * (32 * k2 + 4 * g)), b1 = *(const LAS v2u*)(qrow + 2 * (32 * k2 + 16 + 4 * g));
                const v4u bv = (v4u){b0.x, b0.y, b1.x, b1.y};
                o[ct] = __builtin_amdgcn_mfma_f32_16x16x32_bf16(sa[k2], __builtin_bit_cast(bf16x8, bv), o[ct], 0, 0, 0); } } }
    hg_state_update(L, H2_KT0, vtoff, H2_DEC0, w, g, fr, S);
    __syncthreads();
    {   bf16x8 vf[2];
#pragma unroll
        for (int k2 = 0; k2 < 2; ++k2) vf[k2] = ldsfrag(L + vtoff, 16 * w + fr, 144, 64 * k2 + 16 * g);
#pragma unroll
        for (int ct = 0; ct < 4; ++ct)
#pragma unroll
            for (int k2 = 0; k2 < 2; ++k2) o[ct] = __builtin_amdgcn_mfma_f32_16x16x32_bf16(vf[k2], ldsfrag(L + H2_PS, 16 * ct + fr, 144, 64 * k2 + 16 * g), o[ct], 0, 0, 0); }
}
__device__ __forceinline__ void hgrn_pass2(Frame& F, const bf16* P, const float* SL, const float* DL, float* OFW, bf16* Y) {
    LAS unsigned char* L = F.lds + RING_OFF;
    const int w = F.wave, l = F.lane, g = l >> 4, fr = l & 15;
    LAS float* RED = (LAS float*)(L + H2_RED);
    for (int item = F.vcu; item < 256; item += F.G) { const int b = item >> 6, h = (item >> 3) & 7, sc = item & 7;
        HgIn in; hg_load<true>(in, P, b, h, w, l, sc * 4, false);
        const f32x4 gn = *(const GAS f32x4*)(F.ognorm + h * 128 + 16 * w + 4 * g);
        f32x4 S[8];
        for (int t = 0; t < 8; ++t) { const bool bwd = t >= 4; const int n = t & 3, j = bwd ? 3 - n : n, dir = bwd ? 1 : 0;
            if (n == 0) {
                if (bwd) { asm volatile("s_waitcnt vmcnt(0)" ::: "memory"); }
                hg_write_lb(L, F.lbf, F.lbb, bwd, h, w, l);
#pragma unroll
                for (int kt = 0; kt < 8; ++kt) S[kt] = (f32x4){0.f, 0.f, 0.f, 0.f};
                const int nf = bwd ? 7 - sc : sc;
                LAS float* DLS = (LAS float*)(L + H2_PS);
                for (int u = F.tid; u < nf * 128; u += NWAVES * 64) { const int tt = u >> 7; const int i = bwd ? 7 - tt : tt; DLS[u] = DL[hg_slot(dir, b, h, i) * 128 + (u & 127)]; }
                __syncthreads();
                int tt = 0;
                for (; tt + 1 < nf; tt += 2) {
                    const int i0 = bwd ? 7 - tt : tt, i1 = bwd ? 6 - tt : tt + 1;
                    const float* sl0 = SL + hg_slot(dir, b, h, i0) * 16384 + (size_t)(w * 64 + l) * 4; const float* sl1 = SL + hg_slot(dir, b, h, i1) * 16384 + (size_t)(w * 64 + l) * 4;
                    f32x4 s4a[8], s4b[8];
#pragma unroll
                    for (int kt = 0; kt < 8; ++kt) { s4a[kt] = *(const GAS f32x4*)(sl0 + (size_t)kt * 8 * 256); s4b[kt] = *(const GAS f32x4*)(sl1 + (size_t)kt * 8 * 256); }
                    asm volatile("" ::: "memory");
#pragma unroll
                    for (int kt = 0; kt < 8; ++kt) { const f32x4 d0 = *(const LAS f32x4*)(DLS + tt * 128 + 16 * kt + 4 * g), d1 = *(const LAS f32x4*)(DLS + (tt + 1) * 128 + 16 * kt + 4 * g);
                        S[kt] = (S[kt] * d0 + s4a[kt]) * d1 + s4b[kt]; } }
                if (tt < nf) { const int i = bwd ? 7 - tt : tt; const float* sl = SL + hg_slot(dir, b, h, i) * 16384 + (size_t)(w * 64 + l) * 4;
                    f32x4 s4[8];
#pragma unroll
                    for (int kt = 0; kt < 8; ++kt) s4[kt] = *(const GAS f32x4*)(sl + (size_t)kt * 8 * 256);
                    asm volatile("" ::: "memory");
#pragma unroll
                    for (int kt = 0; kt < 8; ++kt) { const f32x4 d4 = *(const LAS f32x4*)(DLS + tt * 128 + 16 * kt + 4 * g); S[kt] = S[kt] * d4 + s4[kt]; } }
            }
            const int vtoff = (t & 1) ? H2_VT1 : H2_VT0;
            {   float el[16];
                hg_stage_v(L, vtoff, w, l, in.v);
                hg_stage<true>(L, H2_KT0, H2_DEC0, w, l, bwd, in.z, in.q, el); }
            if (t + 1 < 8) { const bool nb = (t + 1) >= 4; const int nn = (t + 1) & 3; hg_load<true>(in, P, b, h, w, l, sc * 4 + (nb ? 3 - nn : nn), nb); }
            float* ofw = OFW + ((size_t)((item * 4 + j) * 4) * 8 + w) * 256 + (size_t)l * 4;
            f32x4 of[4]; v2u gr[4];
            if (bwd) {
#pragma unroll
                for (int ct = 0; ct < 4; ++ct) { of[ct] = *(const GAS f32x4*)(ofw + (size_t)ct * 8 * 256);
                    gr[ct] = *(const GAS v2u*)(P + (size_t)(b * SEQ + (sc * 4 + j) * 64 + ct * 16 + fr) * NIN + CGH + h * 128 + 16 * w + 4 * g); }
            }
            __syncthreads();
            f32x4 o[4];
            hgrn_pass2_compute(L, w, g, fr, bwd, vtoff, S, o);
            if (!bwd) {
#pragma unroll
                for (int ct = 0; ct < 4; ++ct) *(GAS f32x4*)(ofw + (size_t)ct * 8 * 256) = o[ct];
            } else {
                float ps[4];
#pragma unroll
                for (int ct = 0; ct < 4; ++ct) { o[ct] = o[ct] + of[ct]; const f32x4 v = o[ct];
                    float s2 = (v[0] * v[0] + v[1] * v[1]) + (v[2] * v[2] + v[3] * v[3]); s2 += __shfl_xor(s2, 16); s2 += __shfl_xor(s2, 32); ps[ct] = s2; }
                if (g == 0) {
#pragma unroll
                    for (int ct = 0; ct < 4; ++ct) RED[w * 64 + ct * 16 + fr] = ps[ct];
                }
                __syncthreads();
#pragma unroll
                for (int ct = 0; ct < 4; ++ct) { const int ti = ct * 16 + fr; float tot = 0.f;
#pragma unroll
                    for (int ww = 0; ww < 8; ++ww) tot += RED[ww * 64 + ti];
                    const float rs = 1.0f / sqrtf(tot * (1.f / 128.f) + EPS);
                    const size_t row = (size_t)(b * SEQ + (sc * 4 + j) * 64 + ti);
                    const f32x4 v = o[ct];
                    v2u o2; o2.x = pk2(v[0] * rs * gn[0] * pg8::silu_f(bf_lo(gr[ct].x)), v[1] * rs * gn[1] * pg8::silu_f(bf_hi(gr[ct].x)));
                    o2.y = pk2(v[2] * rs * gn[2] * pg8::silu_f(bf_lo(gr[ct].y)), v[3] * rs * gn[3] * pg8::silu_f(bf_hi(gr[ct].y)));
                    *(GAS v2u*)(Y + row * D + h * 128 + 16 * w + 4 * g) = o2; }
            }
        }
        __syncthreads();
    }
}

constexpr int AT_K = 0, AT_V = 34816, AT_TB = 69632, AT_END = 69632 + 2 * 264 * 4;
__device__ __forceinline__ int t5_bucket(int rel) {
    const int n = rel < 0 ? -rel : rel; int bkt;
    if (n < 8) bkt = n; else { int j = 0; while (j < 7 && 64 * (2 << j) <= n * n) ++j; bkt = 8 + j; }
    return bkt + (rel > 0 ? 16 : 0);
}
struct AtRegs { v4u k[4], v[4]; };
__device__ __forceinline__ void at_load(AtRegs& r, const bf16* P, int b, int kb, int kvh, int tid) {
    const bf16* kvbase = P + (size_t)(b * SEQ + kb * 128) * NIN;
#pragma unroll
    for (int i = 0; i < 4; ++i) { const int id = tid + 512 * i; r.k[i] = *(const GAS v4u*)(kvbase + (size_t)(id >> 4) * NIN + CKA + kvh * 128 + 8 * (id & 15)); }
#pragma unroll
    for (int i = 0; i < 4; ++i) { const int id = tid + 512 * i; r.v[i] = *(const GAS v4u*)(kvbase + (size_t)(id & 127) * NIN + CVA + kvh * 128 + 8 * (id >> 7)); }
}
__device__ __forceinline__ void at_stage(LAS unsigned char* L, const AtRegs& r, int tid) {
#pragma unroll
    for (int i = 0; i < 4; ++i) { const int id = tid + 512 * i; *(LAS v4u*)(L + AT_K + (id >> 4) * 272 + 16 * (id & 15)) = r.k[i]; }
#pragma unroll
    for (int i = 0; i < 4; ++i) { const int id = tid + 512 * i; const int key = id & 127, ch = id >> 7;
#pragma unroll
        for (int e = 0; e < 4; ++e) { *(LAS unsigned short*)(L + AT_V + (8 * ch + 2 * e) * 272 + 2 * key) = (unsigned short)(r.v[i][e] & 0xffffu); *(LAS unsigned short*)(L + AT_V + (8 * ch + 2 * e + 1) * 272 + 2 * key) = (unsigned short)(r.v[i][e] >> 16); } }
}
__device__ __forceinline__ void at_head(LAS unsigned char* L, const LAS float* TB, int relbase, int g, int fr, const bf16x8 (&bq)[4], float& mrun, float& lrun, f32x4 (&ot)[8]) {
    const float scale = 0.08838834764831845f;
    f32x4 st[8];
#pragma unroll
    for (int mt = 0; mt < 8; ++mt) { st[mt] = (f32x4){0.f, 0.f, 0.f, 0.f};
#pragma unroll
        for (int ks = 0; ks < 4; ++ks) st[mt] = __builtin_amdgcn_mfma_f32_16x16x32_bf16(ldsfrag(L + AT_K, 16 * mt + fr, 272, 64 * ks + 16 * g), bq[ks], st[mt], 0, 0, 0); }
    float mx = -3.0e38f;
#pragma unroll
    for (int mt = 0; mt < 8; ++mt)
#pragma unroll
        for (int r = 0; r < 4; ++r) { const int rel = relbase + 16 * mt + r; const bool ok = rel >= -128 && rel <= 128; const int ri = min(max(rel + 128, 0), 256);
            const float tb = TB[ri]; const float s = ok ? st[mt][r] * scale + tb : -1.0e30f; st[mt][r] = s; mx = fmaxf(mx, s); }
    mx = fmaxf(mx, __shfl_xor(mx, 16)); mx = fmaxf(mx, __shfl_xor(mx, 32));
    const float mnew = fmaxf(mrun, mx), alpha = __expf(mrun - mnew); mrun = mnew;
    float ls = 0.f;
#pragma unroll
    for (int mt = 0; mt < 8; ++mt)
#pragma unroll
        for (int r = 0; r < 4; ++r) { const float p = __expf(st[mt][r] - mnew); st[mt][r] = p; ls += p; }
    ls += __shfl_xor(ls, 16); ls += __shfl_xor(ls, 32);
    lrun = lrun * alpha + ls;
#pragma unroll
    for (int dt = 0; dt < 8; ++dt) ot[dt] = ot[dt] * alpha;
#pragma unroll
    for (int k2 = 0; k2 < 4; ++k2) {
        v4u pb; pb.x = pk2(st[2 * k2][0], st[2 * k2][1]); pb.y = pk2(st[2 * k2][2], st[2 * k2][3]); pb.z = pk2(st[2 * k2 + 1][0], st[2 * k2 + 1][1]); pb.w = pk2(st[2 * k2 + 1][2], st[2 * k2 + 1][3]);
        const bf16x8 pfrag = __builtin_bit_cast(bf16x8, pb);
#pragma unroll
        for (int dt = 0; dt < 8; ++dt) { const LAS unsigned char* vrow = L + AT_V + (16 * dt + fr) * 272;
            const v2u a0 = *(const LAS v2u*)(vrow + 2 * (32 * k2 + 4 * g)), a1 = *(const LAS v2u*)(vrow + 2 * (32 * k2 + 16 + 4 * g));
            const v4u av = (v4u){a0.x, a0.y, a1.x, a1.y};
            ot[dt] = __builtin_amdgcn_mfma_f32_16x16x32_bf16(__builtin_bit_cast(bf16x8, av), pfrag, ot[dt], 0, 0, 0); } }
}
__device__ __forceinline__ void attn_item(Frame& F, const bf16* P, bf16* Y, int item) {
    LAS unsigned char* L = F.lds + RING_OFF;
    const int w = F.wave, l = F.lane, g = l >> 4, fr = l & 15, tid = F.tid;
    {
        const int hq = item & 3, blk = (item >> 2) & 15, kvh = (item >> 6) & 1, b = item >> 7, h = kvh * 4 + hq;
        LAS float* TB = (LAS float*)(L + AT_TB);
        if (tid < 257) TB[tid] = F.relb[t5_bucket(tid - 128) * AH + h];
        const int jt0 = blk == 0 ? 1 : 0, jt1 = blk == 15 ? 1 : 2;
        AtRegs R; at_load(R, P, b, blk - 1 + jt0, kvh, tid);
        const int qrow = b * SEQ + blk * 128 + 16 * w + fr;
        bf16x8 bq[4];
#pragma unroll
        for (int ks = 0; ks < 4; ++ks) bq[ks] = *(const GAS bf16x8*)(P + (size_t)qrow * NIN + CQA + h * 128 + 32 * ks + 8 * g);
        float mrun = F.sink[h], lrun = 1.0f;
        f32x4 ot[8];
#pragma unroll
        for (int dt = 0; dt < 8; ++dt) ot[dt] = (f32x4){0.f, 0.f, 0.f, 0.f};
        for (int jt = jt0; jt <= jt1; ++jt) {
            at_stage(L, R, tid);
            __syncthreads();
            if (jt < jt1) at_load(R, P, b, blk + jt, kvh, tid);
            const int relbase = (jt - 1) * 128 + 4 * g - (16 * w + fr);
            at_head(L, TB, relbase, g, fr, bq, mrun, lrun, ot);
            __syncthreads();
        }
        const float inv = 1.0f / lrun;
#pragma unroll
        for (int dt = 0; dt < 8; ++dt) { v2u o2; o2.x = pk2(ot[dt][0] * inv, ot[dt][1] * inv); o2.y = pk2(ot[dt][2] * inv, ot[dt][3] * inv);
            *(GAS v2u*)(Y + (size_t)qrow * D + HW + h * 128 + 16 * dt + 4 * g) = o2; }
        __syncthreads();
    }
}
__device__ __forceinline__ void attn_phase(Frame& F, const bf16* P, bf16* Y) { for (int item = F.vcu; item < 512; item += F.G) attn_item(F, P, Y, item); }
constexpr int CW_GRP = 1024;
__device__ __forceinline__ void hg_group_publish(Frame& F, int grp) {
    asm volatile("s_waitcnt vmcnt(0)" ::: "memory");
    __syncthreads();
    if (F.tid == 0) { __builtin_amdgcn_fence(__ATOMIC_RELEASE, "agent"); asm volatile("s_waitcnt vmcnt(0)" ::: "memory");
        __hip_atomic_fetch_add((unsigned*)(F.ctl + CW_GRP + 64 * grp), 1u, __ATOMIC_RELAXED, __HIP_MEMORY_SCOPE_AGENT); }
}
__device__ __forceinline__ void hg_group_wait(Frame& F, int grp) {
    if (F.tid == 0) { unsigned sp = 0;
        while (__hip_atomic_load((unsigned*)(F.ctl + CW_GRP + 64 * grp), __ATOMIC_RELAXED, __HIP_MEMORY_SCOPE_AGENT) < 8u) { __builtin_amdgcn_s_sleep(2); if (++sp > (1u << 20)) break; }
        __builtin_amdgcn_fence(__ATOMIC_ACQUIRE, "agent"); asm volatile("s_waitcnt vmcnt(0)" ::: "memory"); }
    __syncthreads();
}

struct Args { const float* in[18]; float* out; unsigned char* ws; int ph_lo, ph_hi, li, pad; };
__global__ void __launch_bounds__(NWAVES * 64, 2) hymba_fwd(Args args) {
    extern __shared__ __attribute__((aligned(16))) unsigned char lds[];
    Frame F;
    F.lds = (LAS unsigned char*)lds;
    F.MISC = (volatile LAS unsigned*)(F.lds + MISC_OFF);
    F.tid = threadIdx.x; F.lane = F.tid & 63; F.wave = __builtin_amdgcn_readfirstlane(F.tid >> 6);
    F.G = gridDim.x; { const int bx = blockIdx.x; F.vcu = (F.G % 8 == 0) ? (bx % 8) * (F.G / 8) + bx / 8 : bx; }
    unsigned char* ws = args.ws;
    F.ctl = (gu32*)(ws + WS_CTL);
    F.x = args.in[0]; F.pre1 = args.in[1]; F.post1 = args.in[2]; F.w1gu = args.in[3]; F.w1d = args.in[4]; F.prem = args.in[5]; F.postm = args.in[6]; F.win = args.in[7];
    F.lbf = args.in[8]; F.lbb = args.in[9]; F.ognorm = args.in[10]; F.sink = args.in[11]; F.wout = args.in[12]; F.pre2 = args.in[13]; F.post2 = args.in[14];
    F.w2gu = args.in[15]; F.w2d = args.in[16]; F.relb = args.in[17]; F.out = args.out;
    F.W1GU = (bf16*)(ws + WS_W1GU); F.W1D = (bf16*)(ws + WS_W1D); F.WIN = (bf16*)(ws + WS_WIN); F.WOUT = (bf16*)(ws + WS_WOUT); F.W2GU = (bf16*)(ws + WS_W2GU); F.W2D = (bf16*)(ws + WS_W2D);
    F.H = (bf16*)(ws + WS_H); F.ACT = (bf16*)(ws + WS_ACT); F.FFB = (bf16*)(ws + WS_FF); F.SLB = (float*)(ws + WS_FF); F.XR = (bf16*)(ws + WS_FF + 32 * MiB); F.ssq = (float*)(ws + WS_SSQ);
    for (int u = F.tid; u < (LDS_BYTES - LDSCTL_OFF) / 4; u += NWAVES * 64) ((LAS unsigned*)(F.lds + LDSCTL_OFF))[u] = 0u;
    __syncthreads();
    XcdBarrier bar; bar.bar = (unsigned*)(F.ctl + CW_BAR); bar.x = 0; bar.st = nullptr;
    if (N_LAUNCHES != PER_PHASE) bar = xcd_barrier_post((unsigned*)(F.ctl + CW_BAR), F.MISC + 8);
#define GRID_BAR() do { if (N_LAUNCHES != PER_PHASE) xcd_barrier(bar); } while (0)
    const int lo = args.ph_lo, hi = args.ph_hi;
    unsigned long long pr_t0 = 0, pr_dt = 0;
#ifdef PROBE_PHASE
#define TS(k) do { if ((k) == PROBE_PHASE) pr_t0 = __builtin_amdgcn_s_memrealtime(); } while (0)
#define TE(k) do { if ((k) == PROBE_PHASE) pr_dt = __builtin_amdgcn_s_memrealtime() - pr_t0; } while (0)
#else
#define TS(k) do {} while (0)
#define TE(k) do {} while (0)
#endif
#define IN(k) (lo <= (k) && (k) < hi)
#define BOTH(k) (IN(k) && IN((k) + 1))
    typedef pg8::StaticOrder SO;
    TS(0); if (IN(0)) for (int r_ = 0; r_ < REP_P0; ++r_) { p0_prologue(F); if (BOTH(0)) GRID_BAR(); }
    TE(0);
    TS(1); if (IN(1)) for (int r_ = 0; r_ < REP_P1; ++r_) { pg8::Gemm gm{F.H, F.W1GU, M, NGU, D}; SO S; S.init(M, NGU, F.G, (int)blockIdx.x); pg8::EpiSwiglu E{F.ACT, FF};
        pg8::gemm_phase<pg8::EpiSwiglu, SO, PG8_ALIGN, PG8_SP2>(F.lds + RING_OFF, gm, S, E);
        { const int nfull = (M / 256) * (NGU / 256) % F.G;
          if (nfull != 0 && (int)blockIdx.x >= nfull && r_ == 0) convert_list<1>(F, ((int)blockIdx.x - nfull) * NWAVES + F.wave, (F.G - nfull) * NWAVES);
          else if (nfull == 0 && r_ == 0) convert_list<1>(F, F.vcu * NWAVES + F.wave, F.G * NWAVES); }
        if (BOTH(1)) GRID_BAR(); }
    TE(1);
    TS(2); if (IN(2)) for (int r_ = 0; r_ < REP_P2; ++r_) { pg8::Gemm gm{F.ACT, F.W1D, M, D, FF}; SO S; S.init(M, D, F.G, (int)blockIdx.x); pg8::EpiBf16Ssq E{F.FFB, D, F.ssq};
        pg8::gemm_phase<pg8::EpiBf16Ssq, SO, PG8_ALIGN, PG8_SP2>(F.lds + RING_OFF, gm, S, E); if (BOTH(2)) GRID_BAR(); }
    TE(2);
    TS(3); if (IN(3)) for (int r_ = 0; r_ < REP_P3; ++r_) { ew_phase<true, false>(F, F.x, F.FFB, F.ssq, F.post1, 0.5f, F.XR, F.prem, F.H); if (BOTH(3)) GRID_BAR(); }
    TE(3);
    TS(4); if (IN(4)) for (int r_ = 0; r_ < REP_P4; ++r_) { pg8::Gemm gm{F.H, F.WIN, M, NIN, D}; SO S; S.init(M, NIN, F.G, (int)blockIdx.x); pg8::EpiBf16 E{F.ACT, NIN};
        pg8::gemm_phase<pg8::EpiBf16, SO, PG8_ALIGN, PG8_SP2>(F.lds + RING_OFF, gm, S, E);
        { const int nfull = (M / 256) * (NIN / 256) % F.G;
          if (nfull != 0 && (int)blockIdx.x >= nfull && r_ == 0) convert_list<2>(F, ((int)blockIdx.x - nfull) * NWAVES + F.wave, (F.G - nfull) * NWAVES);
          else if (nfull == 0 && r_ == 0) convert_list<2>(F, F.vcu * NWAVES + F.wave, F.G * NWAVES); }
        if (BOTH(4)) GRID_BAR(); }
    TE(4);
    TS(5); if (IN(5)) {
        if (F.G == 256 && REP_HG == 1 && REP_AT == 1) {
            const int grp = F.vcu >> 3;
            hgrn_pass1(F, F.ACT, F.SLB, F.ssq); hg_group_publish(F, grp);
            attn_item(F, F.ACT, F.H, F.vcu);
            hg_group_wait(F, grp); hgrn_pass2(F, F.ACT, F.SLB, F.ssq, F.out, F.H);
            attn_item(F, F.ACT, F.H, F.vcu + 256);
        } else {
            for (int r_ = 0; r_ < REP_HG; ++r_) hgrn_pass1(F, F.ACT, F.SLB, F.ssq); for (int r_ = 0; r_ < REP_AT; ++r_) attn_phase(F, F.ACT, F.H); GRID_BAR();
            hgrn_pass2(F, F.ACT, F.SLB, F.ssq, F.out, F.H);
        }
        if (BOTH(5)) GRID_BAR(); }
    TE(5);
    TS(6);
    TE(6);
    TS(7); if (IN(7)) for (int r_ = 0; r_ < REP_P7; ++r_) { pg8::Gemm gm{F.H, F.WOUT, M, D, D}; SO S; S.init(M, D, F.G, (int)blockIdx.x); pg8::EpiBf16Ssq E{F.FFB, D, F.ssq};
        pg8::gemm_phase<pg8::EpiBf16Ssq, SO, PG8_ALIGN, PG8_SP2>(F.lds + RING_OFF, gm, S, E); if (BOTH(7)) GRID_BAR(); }
    TE(7);
    TS(8); if (IN(8)) { ew_phase<false, false>(F, F.XR, F.FFB, F.ssq, F.postm, 1.0f, F.XR, F.pre2, F.H); if (BOTH(8)) GRID_BAR(); }
    TE(8);
    TS(9); if (IN(9)) { pg8::Gemm gm{F.H, F.W2GU, M, NGU, D}; SO S; S.init(M, NGU, F.G, (int)blockIdx.x); pg8::EpiSwiglu E{F.ACT, FF};
        pg8::gemm_phase<pg8::EpiSwiglu, SO, PG8_ALIGN, PG8_SP2>(F.lds + RING_OFF, gm, S, E);
        { const int nfull = (M / 256) * (NGU / 256) % F.G;
          if (nfull != 0 && (int)blockIdx.x >= nfull) convert_list<3>(F, ((int)blockIdx.x - nfull) * NWAVES + F.wave, (F.G - nfull) * NWAVES);
          else if (nfull == 0) convert_list<3>(F, F.vcu * NWAVES + F.wave, F.G * NWAVES); }
        if (BOTH(9)) GRID_BAR(); }
    TE(9);
    TS(10); if (IN(10)) { pg8::Gemm gm{F.ACT, F.W2D, M, D, FF}; SO S; S.init(M, D, F.G, (int)blockIdx.x); pg8::EpiBf16Ssq E{F.FFB, D, F.ssq};
        pg8::gemm_phase<pg8::EpiBf16Ssq, SO, PG8_ALIGN, PG8_SP2>(F.lds + RING_OFF, gm, S, E); if (BOTH(10)) GRID_BAR(); }
    TE(10);
    TS(11); if (IN(11)) { ew_phase<false, true>(F, F.XR, F.FFB, F.ssq, F.post2, 0.5f, F.out, nullptr, nullptr); }
    TE(11);
#undef IN
#undef BOTH
#ifdef PROBE_PHASE
    if (blockIdx.x == 0 && F.tid == 0) { const unsigned long long te = __builtin_amdgcn_s_memrealtime(); while (__builtin_amdgcn_s_memrealtime() - te < (unsigned long long)PROBE_MULT * pr_dt) __builtin_amdgcn_s_sleep(8); }
#endif
}

extern "C" void kernel_launch(void* const* d_in, const int* in_sizes, int n_in, void* d_out, int out_size, void* d_ws, size_t ws_size, hipStream_t stream) {
    static int grid = 0;
    if (grid == 0) {
        if (n_in != 18 || in_sizes[0] != M * D || out_size != M * D || ws_size < WS_END) { fprintf(stderr, "kernel_launch: unexpected shapes/workspace (n_in %d, ws %zu)\n", n_in, ws_size); grid = -1; return; }
        int dev = 0, cus = 0;
        if (hipGetDevice(&dev) != hipSuccess || hipDeviceGetAttribute(&cus, hipDeviceAttributeMultiprocessorCount, dev) != hipSuccess) { grid = -1; return; }
        if (hipFuncSetAttribute((const void*)hymba_fwd, hipFuncAttributeMaxDynamicSharedMemorySize, LDS_BYTES) != hipSuccess) { fprintf(stderr, "kernel_launch: hipFuncSetAttribute failed\n"); grid = -1; return; }
        (void)hipGetLastError();
        grid = cus;
    }
    if (grid < 0) return;
    if (hipMemsetAsync((char*)d_ws + WS_CTL, 0, CTL_ZERO_BYTES, stream) != hipSuccess) return;
    Args a{};
    for (int i = 0; i < 18; ++i) a.in[i] = (const float*)d_in[i];
    a.out = (float*)d_out; a.ws = (unsigned char*)d_ws;
    if (N_LAUNCHES == 1) { a.ph_lo = 0; a.ph_hi = PER_PHASE; a.li = 0; hipLaunchKernelGGL(hymba_fwd, dim3(grid), dim3(NWAVES * 64), LDS_BYTES, stream, a); }
    else { for (int li = 0; li < PER_PHASE; ++li) { a.ph_lo = li; a.ph_hi = li + 1; a.li = li; hipLaunchKernelGGL(hymba_fwd, dim3(grid), dim3(NWAVES * 64), LDS_BYTES, stream, a); } }
}
```

```cpp
#include <hip/hip_runtime.h>
#include <cstdio>
#include <cstdint>

#ifndef MK_N_LAUNCHES
#define MK_N_LAUNCHES 1
#endif

namespace pg8 {
#define PG8_LAS __attribute__((address_space(3)))
typedef unsigned short bf16_t;
typedef short bf16x8 __attribute__((ext_vector_type(8)));
typedef float f32x4 __attribute__((ext_vector_type(4)));
typedef unsigned u32x4 __attribute__((ext_vector_type(4)));
#ifndef PG8_WGM
#define PG8_WGM 8
#endif
constexpr int BM = 256, BK = 64, HALF = 128, HTB = HALF * BK * 2  , STAGE_BYTES = 8 * HTB, NXCD = 8, WGM = PG8_WGM;

__host__ __device__ __forceinline__ int lds_byte(int r, int c) { const int st = (r >> 4) * 2 + (c >> 5), rr = r & 15, cc = c & 31, ob = rr * 64 + cc * 2; return st * 1024 + (ob ^ (((ob >> 9) & 1) << 5)); }
__host__ __device__ __forceinline__ void stage_rc(int b, int& R, int& C) { const int st = b / 1024, sb = b % 1024, swz = sb ^ (((sb >> 9) & 1) << 5); R = (st >> 1) * 16 + swz / 64; C = (st & 1) * 32 + (swz % 64) / 2; }
__host__ __device__ __forceinline__ int perm32(int rho) { const int n = rho >> 4, i = rho & 15; return 8 * (i >> 2) + 4 * n + (i & 3); }

struct Unit { int pm, pn; };
struct Gemm { const bf16_t* A; const bf16_t* Bt; int M, N, K; };

struct StaticOrder {
    int nM, nN, nwg, G, c;
    __host__ __device__ void init(int M, int N, int G_, int c_) { nM = M / BM; nN = N / BM; nwg = nM * nN; G = G_; c = c_; }
    __host__ __device__ bool next(int i, Unit& u) const {
        const long L = (long)i * G + c; if (L >= nwg) return false;
        int wgid = (int)L; { const int q = nwg / NXCD, r = nwg % NXCD, xcd = wgid % NXCD, off = wgid / NXCD; wgid = (xcd < r ? xcd * (q + 1) : r * (q + 1) + (xcd - r) * q) + off; }
        const int nig = WGM * nN, gid = wgid / nig, fm = gid * WGM, gsz = (nM - fm) < WGM ? (nM - fm) : WGM;
        u.pm = fm + ((wgid % nig) % gsz); u.pn = (wgid % nig) / gsz; return true;
    }
    __device__ __forceinline__ void a_ready(const Unit&) const {}
    __device__ __forceinline__ void done(const Unit&) const {}
};

typedef __bf16 bf16v2_t __attribute__((ext_vector_type(2)));
typedef float f32v2_t __attribute__((ext_vector_type(2)));
__device__ __forceinline__ unsigned cvt_pk_bf16(float lo, float hi) { const f32v2_t v = {lo, hi}; const bf16v2_t b = __builtin_convertvector(v, bf16v2_t); return __builtin_bit_cast(unsigned, b); }

struct EpiBf16 {
    static constexpr bool PERM = true, AFTER_DRAIN = false;
    bf16_t* O; int ldc;
    __device__ __forceinline__ void operator()(const f32x4 (&acc)[2][2][4][2], const Unit& u, int wr, int wc, int fr, int fq) const {
        const int row0 = u.pm * BM + wr * 64 + fr; const int col0 = u.pn * BM + wc * 32 + 8 * fq;
#pragma unroll
        for (int ai = 0; ai < 2; ++ai)
#pragma unroll
            for (int m = 0; m < 4; ++m) { bf16_t* rowp = O + (size_t)(row0 + ai * HALF + m * 16) * ldc + col0;
#pragma unroll
                for (int bj = 0; bj < 2; ++bj) { const f32x4 v0 = acc[ai][bj][m][0], v1 = acc[ai][bj][m][1];
                    u32x4 w; w.x = cvt_pk_bf16(v0[0], v0[1]); w.y = cvt_pk_bf16(v0[2], v0[3]); w.z = cvt_pk_bf16(v1[0], v1[1]); w.w = cvt_pk_bf16(v1[2], v1[3]);
                    *(u32x4*)(rowp + bj * HALF) = w; } }
    }
};
__device__ __forceinline__ float silu_f(float x) { return x * __builtin_amdgcn_rcpf(1.0f + __builtin_amdgcn_exp2f(-1.4426950408889634f * x)); }
struct EpiSwiglu {
    static constexpr bool PERM = true, AFTER_DRAIN = false;
    bf16_t* O; int ldc;
    __device__ __forceinline__ void operator()(const f32x4 (&acc)[2][2][4][2], const Unit& u, int wr, int wc, int fr, int fq) const {
        const int row0 = u.pm * BM + wr * 64 + fr; const int col0 = u.pn * HALF + wc * 32 + 8 * fq;
#pragma unroll
        for (int ai = 0; ai < 2; ++ai)
#pragma unroll
            for (int m = 0; m < 4; ++m) { bf16_t* rowp = O + (size_t)(row0 + ai * HALF + m * 16) * ldc + col0;
                const f32x4 g0 = acc[ai][0][m][0], g1 = acc[ai][0][m][1], u0 = acc[ai][1][m][0], u1 = acc[ai][1][m][1];
                float r[8];
#pragma unroll
                for (int e = 0; e < 4; ++e) { r[e] = silu_f(g0[e]) * u0[e]; r[4 + e] = silu_f(g1[e]) * u1[e]; }
                u32x4 w; w.x = cvt_pk_bf16(r[0], r[1]); w.y = cvt_pk_bf16(r[2], r[3]); w.z = cvt_pk_bf16(r[4], r[5]); w.w = cvt_pk_bf16(r[6], r[7]);
                *(u32x4*)rowp = w; }
    }
};
struct EpiBf16Ssq {
    static constexpr bool PERM = true, AFTER_DRAIN = false;
    bf16_t* C; int ldc; float* ssq;
    __device__ __forceinline__ void operator()(const f32x4 (&acc)[2][2][4][2], const Unit& u, int wr, int wc, int fr, int fq) const {
        const int row0 = u.pm * BM + wr * 64 + fr, col0 = u.pn * BM + wc * 32 + 8 * fq;
#pragma unroll
        for (int ai = 0; ai < 2; ++ai)
#pragma unroll
            for (int m = 0; m < 4; ++m) { const int row = row0 + ai * HALF + m * 16; bf16_t* rowp = C + (size_t)row * ldc + col0; float s = 0.f;
#pragma unroll
                for (int bj = 0; bj < 2; ++bj) { const f32x4 v0 = acc[ai][bj][m][0], v1 = acc[ai][bj][m][1];
                    s += ((v0[0] * v0[0] + v0[1] * v0[1]) + (v0[2] * v0[2] + v0[3] * v0[3])) + ((v1[0] * v1[0] + v1[1] * v1[1]) + (v1[2] * v1[2] + v1[3] * v1[3]));
                    u32x4 w; w.x = cvt_pk_bf16(v0[0], v0[1]); w.y = cvt_pk_bf16(v0[2], v0[3]); w.z = cvt_pk_bf16(v1[0], v1[1]); w.w = cvt_pk_bf16(v1[2], v1[3]);
                    *(u32x4*)(rowp + bj * HALF) = w; }
                s += __shfl_xor(s, 16); s += __shfl_xor(s, 32);
                if (fq == 0) ssq[row * 32 + u.pn * 4 + wc] = s; }
    }
};

template <class Epi, class Sched, bool ALIGN_EPI = false, bool SP2 = false>
__device__ __forceinline__ void gemm_phase(PG8_LAS unsigned char* lds, const Gemm g, const Sched& S, const Epi& E) {
    const int tid = threadIdx.x, wid = __builtin_amdgcn_readfirstlane(tid >> 6), lane = tid & 63, wr = wid >> 2, wc = wid & 3, fr = lane & 15, fq = lane >> 4;
    const int K = g.K, nt = K / BK;
    unsigned voffA[2], voffB[2];
#pragma unroll
    for (int i = 0; i < 2; ++i) { int R, C; stage_rc(tid * 16 + i * 8192, R, C); const int Rb = Epi::PERM ? ((R & ~31) + perm32(R & 31)) : R;
        voffA[i] = (unsigned)(R * K + C) * 2u; voffB[i] = (unsigned)(Rb * K + C) * 2u; }
    const size_t kstep = (size_t)(BK * 2);
    const size_t hstep = (size_t)HALF * K * 2;
    const size_t tstep = 2 * hstep;
    const unsigned ldsw = (unsigned)wid * 1024u;
    const int aoff = lds_byte(wr * 64 + fr, fq * 8), boff = lds_byte(wc * 32 + fr, fq * 8);
#define PG8_SA(b, h) (((b) * 2 + (h)) * HTB)
#define PG8_SB(b, h) ((4 + (b) * 2 + (h)) * HTB)
#define PG8_STAGE(bufoff, gbase, voff) do { _Pragma("unroll") for (int _i = 0; _i < 2; ++_i) \
        __builtin_amdgcn_global_load_lds((const unsigned*)((const char*)(gbase) + (voff)[_i]), (PG8_LAS unsigned*)(lds + (bufoff) + ldsw + _i * 8192), 16, 0, 0); } while (0)
#define PG8_LDA(dst, b, h) do { _Pragma("unroll") for (int m = 0; m < 4; ++m) _Pragma("unroll") for (int k = 0; k < 2; ++k) dst[m][k] = *(const PG8_LAS bf16x8*)(lds + PG8_SA(b, h) + aoff + m * 2048 + k * 1024); } while (0)
#define PG8_LDB(dst, b, h) do { _Pragma("unroll") for (int n = 0; n < 2; ++n) _Pragma("unroll") for (int k = 0; k < 2; ++k) dst[n][k] = *(const PG8_LAS bf16x8*)(lds + PG8_SB(b, h) + boff + n * 2048 + k * 1024); } while (0)
#define PG8_MMA(ai, bj, At, Bt) do { __builtin_amdgcn_s_setprio(1); _Pragma("unroll") for (int m = 0; m < 4; ++m) _Pragma("unroll") for (int n = 0; n < 2; ++n) _Pragma("unroll") for (int k = 0; k < 2; ++k) \
        acc[ai][bj][m][n] = __builtin_amdgcn_mfma_f32_16x16x32_bf16(Bt[n][k], At[m][k], acc[ai][bj][m][n], 0, 0, 0); __builtin_amdgcn_s_setprio(0); } while (0)
#define PG8_WAIT_V(n) asm volatile("s_waitcnt vmcnt(" #n ")" ::: "memory")
#define PG8_WAIT_L(n) asm volatile("s_waitcnt lgkmcnt(" #n ")" ::: "memory")
#define PG8_BAR __builtin_amdgcn_s_barrier()
#define PG8_SCHED __builtin_amdgcn_sched_barrier(0)
    Unit cur, nxt; int ui = 0;
    if (!S.next(0, cur)) return;
    f32x4 acc[2][2][4][2];
#pragma unroll
    for (int a = 0; a < 2; ++a)
#pragma unroll
        for (int b = 0; b < 2; ++b)
#pragma unroll
            for (int m = 0; m < 4; ++m)
#pragma unroll
                for (int n = 0; n < 2; ++n) acc[a][b][m][n] = (f32x4){0.f, 0.f, 0.f, 0.f};
    bf16x8 At[4][2], B0[2][2], B1[2][2];
    const char* cA = (const char*)g.A + (size_t)cur.pm * tstep; const char* cB = (const char*)g.Bt + (size_t)cur.pn * tstep;
    S.a_ready(cur);
    if constexpr (SP2) {
        PG8_STAGE(PG8_SB(0, 0), cB, voffB); PG8_STAGE(PG8_SB(0, 1), cB + hstep, voffB); PG8_STAGE(PG8_SA(0, 0), cA, voffA); PG8_STAGE(PG8_SA(0, 1), cA + hstep, voffA);
        if (wr == 1) PG8_BAR;
        PG8_WAIT_V(2); PG8_BAR;
        PG8_STAGE(PG8_SB(1, 0), cB + kstep, voffB); PG8_STAGE(PG8_SA(1, 0), cA + kstep, voffA); PG8_STAGE(PG8_SB(1, 1), cB + hstep + kstep, voffB);
        PG8_WAIT_V(6); PG8_BAR;
    } else {
        PG8_STAGE(PG8_SB(0, 0), cB, voffB); PG8_STAGE(PG8_SA(0, 0), cA, voffA); PG8_STAGE(PG8_SB(0, 1), cB + hstep, voffB); PG8_STAGE(PG8_SA(0, 1), cA + hstep, voffA);
        if (wr == 1) PG8_BAR;
        PG8_WAIT_V(4); PG8_BAR;
        PG8_STAGE(PG8_SB(1, 0), cB + kstep, voffB); PG8_STAGE(PG8_SA(1, 0), cA + kstep, voffA); PG8_STAGE(PG8_SB(1, 1), cB + hstep + kstep, voffB);
        PG8_WAIT_V(6); PG8_BAR;
    }
    for (;;) {
        const bool has_next = S.next(ui + 1, nxt);
        const char* nA = has_next ? (const char*)g.A + (size_t)nxt.pm * tstep : cA; const char* nB = has_next ? (const char*)g.Bt + (size_t)nxt.pn * tstep : cB;
        for (int t = 0; t < nt; t += 2) {
            const bool last = (t == nt - 2);
            const char* a1 = cA + (size_t)(t + 1) * kstep;
            const char* a2 = last ? nA : cA + (size_t)(t + 2) * kstep; const char* b2 = last ? nB : cB + (size_t)(t + 2) * kstep;
            const char* a3 = a2 + kstep; const char* b3 = b2 + kstep;
            if (last && has_next) S.a_ready(nxt);
            if constexpr (SP2) {
            PG8_LDB(B0, 0, 0); PG8_LDB(B1, 0, 1); PG8_SCHED; PG8_LDA(At, 0, 0); PG8_STAGE(PG8_SA(1, 1), a1 + hstep, voffA);
            PG8_WAIT_V(8); PG8_WAIT_L(0); PG8_BAR; PG8_MMA(0, 0, At, B0); PG8_MMA(0, 1, At, B1); PG8_BAR; PG8_SCHED;
            PG8_LDA(At, 0, 1); PG8_STAGE(PG8_SB(0, 0), b2, voffB); PG8_STAGE(PG8_SB(0, 1), b2 + hstep, voffB); PG8_STAGE(PG8_SA(0, 0), a2, voffA);
            PG8_WAIT_V(8); PG8_WAIT_L(0); PG8_BAR; PG8_MMA(1, 0, At, B0); PG8_MMA(1, 1, At, B1); PG8_BAR; PG8_SCHED;
            PG8_LDB(B0, 1, 0); PG8_LDB(B1, 1, 1); PG8_SCHED; PG8_LDA(At, 1, 0); PG8_STAGE(PG8_SA(0, 1), a2 + hstep, voffA);
            PG8_WAIT_V(8); PG8_WAIT_L(0); PG8_BAR; PG8_MMA(0, 0, At, B0); PG8_MMA(0, 1, At, B1); PG8_BAR; PG8_SCHED;
            PG8_LDA(At, 1, 1); PG8_STAGE(PG8_SB(1, 0), b3, voffB); PG8_STAGE(PG8_SB(1, 1), b3 + hstep, voffB); PG8_STAGE(PG8_SA(1, 0), a3, voffA);
            PG8_WAIT_V(8); PG8_WAIT_L(0); PG8_BAR; PG8_MMA(1, 0, At, B0); PG8_MMA(1, 1, At, B1); PG8_BAR; PG8_SCHED;
            } else {
            PG8_LDB(B0, 0, 0); PG8_SCHED; PG8_LDA(At, 0, 0); PG8_STAGE(PG8_SA(1, 1), a1 + hstep, voffA);
            PG8_WAIT_L(8); PG8_BAR; PG8_WAIT_L(0); PG8_MMA(0, 0, At, B0); PG8_BAR; PG8_SCHED;
            PG8_LDB(B1, 0, 1); PG8_STAGE(PG8_SB(0, 0), b2, voffB);
            PG8_BAR; PG8_WAIT_L(0); PG8_MMA(0, 1, At, B1); PG8_BAR;
            PG8_LDA(At, 0, 1); PG8_STAGE(PG8_SA(0, 0), a2, voffA);
            PG8_BAR; PG8_WAIT_L(0); PG8_MMA(1, 0, At, B0); PG8_BAR; PG8_SCHED;
            PG8_STAGE(PG8_SB(0, 1), b2 + hstep, voffB);
            PG8_WAIT_V(6); PG8_BAR; PG8_MMA(1, 1, At, B1); PG8_BAR;
            PG8_LDB(B0, 1, 0); PG8_SCHED; PG8_LDA(At, 1, 0); PG8_STAGE(PG8_SA(0, 1), a2 + hstep, voffA);
            PG8_WAIT_L(8); PG8_BAR; PG8_WAIT_L(0); PG8_MMA(0, 0, At, B0); PG8_BAR; PG8_SCHED;
            PG8_LDB(B1, 1, 1); PG8_STAGE(PG8_SB(1, 0), b3, voffB);
            PG8_BAR; PG8_WAIT_L(0); PG8_MMA(0, 1, At, B1); PG8_BAR;
            PG8_LDA(At, 1, 1); PG8_STAGE(PG8_SA(1, 0), a3, voffA);
            PG8_BAR; PG8_WAIT_L(0); PG8_MMA(1, 0, At, B0); PG8_BAR; PG8_SCHED;
            PG8_STAGE(PG8_SB(1, 1), b3 + hstep, voffB);
            PG8_WAIT_V(6); PG8_BAR; PG8_MMA(1, 1, At, B1); PG8_BAR;
            }
        }
        if constexpr (ALIGN_EPI) { if (wr == 0) PG8_BAR; }
        if constexpr (!Epi::AFTER_DRAIN) { E(acc, cur, wr, wc, fr, fq); S.done(cur); }
        if (!has_next) break;
#pragma unroll
        for (int a = 0; a < 2; ++a)
#pragma unroll
            for (int b = 0; b < 2; ++b)
#pragma unroll
                for (int m = 0; m < 4; ++m)
#pragma unroll
                    for (int n = 0; n < 2; ++n) acc[a][b][m][n] = (f32x4){0.f, 0.f, 0.f, 0.f};
        cur = nxt; cA = nA; cB = nB; ++ui;
        if constexpr (ALIGN_EPI) { if (wr == 1) PG8_BAR; }
    }
    PG8_WAIT_V(0);
    if constexpr (!ALIGN_EPI) { if (wr == 0) PG8_BAR; }
    PG8_BAR;
#undef PG8_SA
#undef PG8_SB
#undef PG8_STAGE
#undef PG8_LDA
#undef PG8_LDB
#undef PG8_MMA
#undef PG8_WAIT_V
#undef PG8_WAIT_L
#undef PG8_BAR
#undef PG8_SCHED
}
}

#ifndef REP_P0
#define REP_P0 1
#endif
#ifndef REP_P1
#define REP_P1 1
#endif
#ifndef REP_P2
#define REP_P2 1
#endif
#ifndef REP_P3
#define REP_P3 1
#endif
#ifndef REP_P4
#define REP_P4 1
#endif
#ifndef REP_HG
#define REP_HG 1
#endif
#ifndef REP_AT
#define REP_AT 1
#endif
#ifndef REP_P6
#define REP_P6 1
#endif
#ifndef REP_P7
#define REP_P7 1
#endif
#ifndef PROBE_MULT
#define PROBE_MULT 8
#endif
#ifndef PG8_SP2
#define PG8_SP2 true
#endif
#ifndef PG8_ALIGN
#define PG8_ALIGN true
#endif

constexpr int NWAVES = 8;
constexpr int N_LAUNCHES = MK_N_LAUNCHES;
constexpr int PER_PHASE = 12;

constexpr int BATCH = 4, SEQ = 2048, D = 2048, FF = 5632, NGU = 2 * FF, NIN = 6656;
constexpr int M = BATCH * SEQ;
constexpr int HW = 1024, HH = 8, HD = 128;
constexpr int AH = 8, AKV = 2;
constexpr int CQH = 0, CIH = 1024, CFF = 2048, CFB = 3072, CGH = 4096, CQA = 5120, CKA = 6144, CVA = 6400;
constexpr float EPS = 1e-6f;

constexpr size_t MiB = 1u << 20;
constexpr size_t WS_CTL = 0, CTL_ZERO_BYTES = 32768;
constexpr size_t WS_W1GU = 2 * MiB, WS_W1D = 46 * MiB, WS_WIN = 68 * MiB, WS_WOUT = 94 * MiB, WS_W2GU = 102 * MiB, WS_W2D = 146 * MiB;
constexpr size_t WS_H = 168 * MiB;
constexpr size_t WS_ACT = 200 * MiB;
constexpr size_t WS_FF = 304 * MiB;
constexpr size_t WS_END = 368 * MiB;
constexpr int CW_BAR = 4096;
constexpr size_t WS_SSQ = 1 * MiB;

constexpr int RING_OFF = 0, RING_BYTES = 131072;
constexpr int LDSCTL_OFF = RING_BYTES, MISC_OFF = LDSCTL_OFF + 320;
constexpr int LDS_BYTES = 147456;

#define GAS __attribute__((address_space(1)))
#define LAS __attribute__((address_space(3)))
typedef unsigned short bf16;
typedef unsigned v4u __attribute__((ext_vector_type(4)));
typedef unsigned v2u __attribute__((ext_vector_type(2)));
typedef float f32x4 __attribute__((ext_vector_type(4)));
typedef short bf16x8 __attribute__((ext_vector_type(8)));
typedef short bf16x4 __attribute__((ext_vector_type(4)));
typedef GAS unsigned gu32;
#define RLX_AGENT __ATOMIC_RELAXED, __HIP_MEMORY_SCOPE_AGENT
#define LDS_WAIT() asm volatile("s_waitcnt lgkmcnt(0)" ::: "memory")
#define VM_WAIT() asm volatile("s_waitcnt vmcnt(0)" ::: "memory")
__device__ __forceinline__ unsigned f2bf(float f) { unsigned u = __builtin_bit_cast(unsigned, f); return (u + 0x7fffu + ((u >> 16) & 1u)) >> 16; }
__device__ __forceinline__ unsigned pk2(float lo, float hi) { return pg8::cvt_pk_bf16(lo, hi); }
__device__ __forceinline__ float bf_lo(unsigned u) { return __builtin_bit_cast(float, u << 16); }
__device__ __forceinline__ float bf_hi(unsigned u) { return __builtin_bit_cast(float, u & 0xffff0000u); }

#define XB_TMO      128
#define XB_XCNT(j)  (256  + 64 * (j))
#define XB_XSUB(j)  (1280 + 64 * (j))
#define XB_XGEN(j)  (2304 + 64 * (j))
#define XB_TOP      3328
#define XB_TOPGEN   3392
#define XCD_BAR_WORDS 3456
#define XB_SPIN_CAP (1u << 20)

__device__ __forceinline__ unsigned xb_ld(unsigned* p)              { return __hip_atomic_load(p, __ATOMIC_RELAXED, __HIP_MEMORY_SCOPE_AGENT); }
__device__ __forceinline__ unsigned xb_add(unsigned* p, unsigned v) { return __hip_atomic_fetch_add(p, v, __ATOMIC_RELAXED, __HIP_MEMORY_SCOPE_AGENT); }
__device__ __forceinline__ unsigned xb_xcc_id() { return (unsigned)__builtin_amdgcn_s_getreg((3 << 11) | 20) & 0xFu; }
#define XB_SPIN(cond, bar) do { unsigned _sp = 0; while (cond) { __builtin_amdgcn_s_sleep(1); \
    if ((++_sp & 255u) == 0u) { if (xb_ld(&(bar)[XB_TMO])) break; if (_sp > XB_SPIN_CAP) { atomicAdd(&(bar)[XB_TMO], 1u); break; } } } } while (0)

struct XcdBarrier { unsigned* bar; unsigned x; volatile LAS unsigned* st; };

__device__ __forceinline__ XcdBarrier xcd_barrier_post(unsigned* bar, volatile LAS unsigned* st) {
    XcdBarrier b; b.bar = bar; b.x = xb_xcc_id(); b.st = st;
    if (threadIdx.x == 0) (void)xb_add(&bar[XB_XCNT(b.x)], 1u);
    return b;
}
__device__ __forceinline__ void xcd_barrier_complete(unsigned* bar, unsigned x, unsigned& nloc, unsigned& nx) {
    const unsigned G = gridDim.x * gridDim.y * gridDim.z;
    unsigned sum, cnt, mine, sp = 0u;
    for (;;) {
        sum = 0u; cnt = 0u; mine = 0u;
#pragma unroll
        for (unsigned j = 0; j < 16; ++j) { const unsigned c = xb_ld(&bar[XB_XCNT(j)]); sum += c; cnt += (c > 0u) ? 1u : 0u; mine = (j == x) ? c : mine; }
        if (sum == G) break;
        __builtin_amdgcn_s_sleep(1);
        if ((++sp & 255u) == 0u) { if (xb_ld(&bar[XB_TMO])) break; if (sp > XB_SPIN_CAP) { atomicAdd(&bar[XB_TMO], 1u); break; } }
    }
    nloc = mine > 0u ? mine : 1u; nx = cnt > 0u ? cnt : 1u;
}
__device__ __forceinline__ void xcd_barrier(const XcdBarrier& b) {
    asm volatile("s_waitcnt vmcnt(0)" ::: "memory");
    __syncthreads();
    if (threadIdx.x == 0) {
        unsigned* bar = b.bar;
        __builtin_amdgcn_s_waitcnt(0);
        unsigned nloc = b.st[0], nx = b.st[1];
        if (nloc == 0u) { xcd_barrier_complete(bar, b.x, nloc, nx); b.st[0] = nloc; b.st[1] = nx; }
        const unsigned old = xb_add(&bar[XB_XSUB(b.x)], 1u);
        const unsigned gen = old / nloc;
        if (old + 1u == (gen + 1u) * nloc) {
            __builtin_amdgcn_fence(__ATOMIC_RELEASE, "agent");
            asm volatile("s_waitcnt vmcnt(0)" ::: "memory");
            const unsigned og = xb_add(&bar[XB_TOP], 1u);
            const unsigned tg = og / nx;
            if (og + 1u == (tg + 1u) * nx) xb_add(&bar[XB_TOPGEN], 1u);
            else XB_SPIN(xb_ld(&bar[XB_TOPGEN]) == tg, bar);
            __builtin_amdgcn_fence(__ATOMIC_ACQUIRE, "agent");
            xb_add(&bar[XB_XGEN(b.x)], 1u);
            asm volatile("s_waitcnt vmcnt(0)" ::: "memory");
        } else {
            XB_SPIN(xb_ld(&bar[XB_XGEN(b.x)]) == gen, bar);
            __builtin_amdgcn_fence(__ATOMIC_ACQUIRE, "agent");
            asm volatile("s_waitcnt vmcnt(0)" ::: "memory");
        }
    }
    __syncthreads();
}

struct Frame {
    LAS unsigned char* lds;
    volatile LAS unsigned* MISC;
    gu32* ctl;
    int tid, lane, wave;
    int vcu, G;
    const float* x; float* out;
    const float *pre1, *post1, *w1gu, *w1d, *prem, *postm, *win, *lbf, *lbb, *ognorm, *sink, *wout, *pre2, *post2, *w2gu, *w2d, *relb;
    bf16 *W1GU, *W1D, *WIN, *WOUT, *W2GU, *W2D;
    bf16 *H, *ACT, *FFB, *XR; float* SLB; float* ssq;
};

__device__ __forceinline__ float wave_sum(float v) {
#pragma unroll
    for (int o = 1; o < 64; o <<= 1) v += __shfl_xor(v, o);
    return v;
}
struct CvItem { const float* src; bf16* dst; int K, N; };
__device__ __forceinline__ CvItem cv_item(const float* W, int K, int N, bf16* WT, bool gu, int item) {
    const int nblk = N / 32, kb = item / nblk, nb = item % nblk, k0 = 64 * kb, n0 = 32 * nb;
    int r0 = n0;
    if (gu) { const int half = N / 2; const int nn = n0 < half ? n0 : n0 - half; r0 = 256 * (nn / 128) + (nn % 128) + (n0 < half ? 0 : 128); }
    CvItem c; c.src = W + (size_t)k0 * N + n0; c.dst = WT + (size_t)r0 * K + k0; c.K = K; c.N = N; return c;
}
constexpr int I_GU = (D / 64) * (NGU / 32), I_DN = (FF / 64) * (D / 32), I_IN = (D / 64) * (NIN / 32), I_OUT = (D / 64) * (D / 32);
template <int LIST>
__device__ __forceinline__ CvItem cv_list_item(Frame& F, int r) {
    if (LIST == 0) return cv_item(F.w1gu, D, NGU, F.W1GU, true, r);
    if (LIST == 1) { if (r < I_DN) return cv_item(F.w1d, FF, D, F.W1D, false, r); r -= I_DN; if (r < I_IN) return cv_item(F.win, D, NIN, F.WIN, false, r); r -= I_IN; return cv_item(F.wout, D, D, F.WOUT, false, r); }
    if (LIST == 2) return cv_item(F.w2gu, D, NGU, F.W2GU, true, r);
    return cv_item(F.w2d, FF, D, F.W2D, false, r);
}
template <int LIST>
__device__ __forceinline__ void convert_list(Frame& F, int worker, int nworkers) {
    LAS float* scr = (LAS float*)(F.lds + RING_OFF + F.wave * 16384);
    constexpr int NITEMS = LIST == 0 ? I_GU : (LIST == 1 ? I_DN + I_IN + I_OUT : (LIST == 2 ? I_GU : I_DN));
    const int lane = F.lane;
    int it = worker; if (it >= NITEMS) return;
    CvItem cur = cv_list_item<LIST>(F, it);
    float r[32];
#pragma unroll
    for (int i = 0; i < 32; ++i) r[i] = __builtin_nontemporal_load(cur.src + (size_t)(2 * i + (lane >> 5)) * cur.N + (lane & 31));
    for (;;) {
#pragma unroll
        for (int i = 0; i < 32; ++i) scr[(2 * i + (lane >> 5)) * 33 + (lane & 31)] = r[i];
        const int nxt = it + nworkers; const bool has = nxt < NITEMS; CvItem nd = cur;
        if (has) { nd = cv_list_item<LIST>(F, nxt);
#pragma unroll
            for (int i = 0; i < 32; ++i) r[i] = __builtin_nontemporal_load(nd.src + (size_t)(2 * i + (lane >> 5)) * nd.N + (lane & 31)); }
        LDS_WAIT(); asm volatile("" ::: "memory");
        const int c = lane & 7;
#pragma unroll
        for (int j = 0; j < 4; ++j) { const int n = (lane >> 3) + 8 * j; const LAS float* sp = scr + (8 * c) * 33 + n;
            v4u o; o.x = pk2(sp[0 * 33], sp[1 * 33]); o.y = pk2(sp[2 * 33], sp[3 * 33]); o.z = pk2(sp[4 * 33], sp[5 * 33]); o.w = pk2(sp[6 * 33], sp[7 * 33]);
            *(GAS v4u*)(cur.dst + (size_t)n * cur.K + 8 * c) = o; }
        LDS_WAIT(); asm volatile("" ::: "memory");
        if (!has) break;
        cur = nd; it = nxt;
    }
}
__device__ __forceinline__ void rms_rows_to_bf16(int lane, const float* x, const float* gain, bf16* out, int first, int stride) {
    if (first >= M) return;
    const GAS f32x4* gr = (const GAS f32x4*)gain + lane;
    f32x4 v[8];
#pragma unroll
    for (int j = 0; j < 8; ++j) v[j] = __builtin_nontemporal_load((const GAS f32x4*)(x + (size_t)first * D) + lane + 64 * j);
    for (int m = first; m < M; m += stride) {
        f32x4 c[8]; float s = 0.f;
#pragma unroll
        for (int j = 0; j < 8; ++j) { c[j] = v[j]; s += (c[j].x * c[j].x + c[j].y * c[j].y) + (c[j].z * c[j].z + c[j].w * c[j].w); }
        if (m + stride < M) {
#pragma unroll
            for (int j = 0; j < 8; ++j) v[j] = __builtin_nontemporal_load((const GAS f32x4*)(x + (size_t)(m + stride) * D) + lane + 64 * j); }
        const float rs = 1.0f / sqrtf(wave_sum(s) * (1.f / D) + EPS);
        GAS v2u* o8 = (GAS v2u*)(out + (size_t)m * D) + lane;
#pragma unroll
        for (int j = 0; j < 8; ++j) { const f32x4 g = gr[64 * j]; v2u o; o.x = pk2(c[j].x * rs * g.x, c[j].y * rs * g.y); o.y = pk2(c[j].z * rs * g.z, c[j].w * rs * g.w); o8[64 * j] = o; }
    }
}
__device__ __forceinline__ void p0_prologue(Frame& F) {
    const int gw = F.vcu * NWAVES + F.wave, NGW = F.G * NWAVES;
    convert_list<0>(F, gw, NGW);
    rms_rows_to_bf16(F.lane, F.x, F.pre1, F.H, gw, NGW);
}
template <bool XIN_F32, bool XOUT_F32>
__device__ __forceinline__ void ew_phase(Frame& F, const void* xi, const bf16* ff, const float* ssq, const float* post, float coef, void* xo, const float* pre, bf16* h) {
    const int gw = F.vcu * NWAVES + F.wave, NGW = F.G * NWAVES;
    for (int m = gw; m < M; m += NGW) {
        const float part = (F.lane < 32) ? ssq[m * 32 + F.lane] : 0.f;
        const float rs = coef / sqrtf(wave_sum(part) * (1.f / D) + EPS);
        const GAS v2u* fr = (const GAS v2u*)(ff + (size_t)m * D) + F.lane; const GAS f32x4* pr = (const GAS f32x4*)post + F.lane;
        f32x4 v[8]; float s = 0.f;
#pragma unroll
        for (int j = 0; j < 8; ++j) { f32x4 a;
            if (XIN_F32) a = __builtin_nontemporal_load((const GAS f32x4*)((const float*)xi + (size_t)m * D) + F.lane + 64 * j);
            else { const v2u t = __builtin_nontemporal_load((const GAS v2u*)((const bf16*)xi + (size_t)m * D) + F.lane + 64 * j); a = (f32x4){bf_lo(t.x), bf_hi(t.x), bf_lo(t.y), bf_hi(t.y)}; }
            const v2u fb = __builtin_nontemporal_load(fr + 64 * j); const f32x4 b = (f32x4){bf_lo(fb.x), bf_hi(fb.x), bf_lo(fb.y), bf_hi(fb.y)}; const f32x4 g = pr[64 * j];
            v[j] = a + b * g * rs;
            if (XOUT_F32) __builtin_nontemporal_store(v[j], (GAS f32x4*)((float*)xo + (size_t)m * D) + F.lane + 64 * j);
            else { v2u o; o.x = pk2(v[j].x, v[j].y); o.y = pk2(v[j].z, v[j].w); __builtin_nontemporal_store(o, (GAS v2u*)((bf16*)xo + (size_t)m * D) + F.lane + 64 * j);
                   v[j] = (f32x4){bf_lo(o.x), bf_hi(o.x), bf_lo(o.y), bf_hi(o.y)}; }
            s += (v[j].x * v[j].x + v[j].y * v[j].y) + (v[j].z * v[j].z + v[j].w * v[j].w); }
        if (h) {
            const float r2 = 1.0f / sqrtf(wave_sum(s) * (1.f / D) + EPS);
            const GAS f32x4* gr = (const GAS f32x4*)pre + F.lane; GAS v2u* o8 = (GAS v2u*)(h + (size_t)m * D) + F.lane;
#pragma unroll
            for (int j = 0; j < 8; ++j) { const f32x4 g = gr[64 * j]; v2u o; o.x = pk2(v[j].x * r2 * g.x, v[j].y * r2 * g.y); o.y = pk2(v[j].z * r2 * g.z, v[j].w * r2 * g.w); o8[64 * j] = o; }
        }
    }
}

__device__ __forceinline__ bf16x8 ldsfrag(LAS unsigned char* base, int row, int stride, int kbyte) { return *(const LAS bf16x8*)(base + row * stride + kbyte); }
constexpr int H2_QD = 0, H2_KD = 17408, H2_KT0 = 34816, H2_KT1 = 53248, H2_VT0 = 71680, H2_VT1 = 90112, H2_PS = 108544, H2_DEC0 = 117760, H2_DEC1 = 118272, H2_RED = 118784, H2_LB = 126976, H2_END = 127488;
static_assert(H2_END <= RING_BYTES, "HGRN LDS map");
static_assert((CW_BAR + 3456) * 4 <= (int)CTL_ZERO_BYTES, "barrier words inside the memset region");
__device__ __forceinline__ void wave_scan_mul8(float (&v)[8]) {
#define SCAN_ROUND(ctrl) \
    "v_mul_f32_dpp %0, %0, %0 " ctrl "\n\tv_mul_f32_dpp %1, %1, %1 " ctrl "\n\tv_mul_f32_dpp %2, %2, %2 " ctrl "\n\tv_mul_f32_dpp %3, %3, %3 " ctrl "\n\t" \
    "v_mul_f32_dpp %4, %4, %4 " ctrl "\n\tv_mul_f32_dpp %5, %5, %5 " ctrl "\n\tv_mul_f32_dpp %6, %6, %6 " ctrl "\n\tv_mul_f32_dpp %7, %7, %7 " ctrl "\n\t"
    asm volatile("s_nop 1\n\t"
        SCAN_ROUND("row_shr:1 row_mask:0xf bank_mask:0xf") SCAN_ROUND("row_shr:2 row_mask:0xf bank_mask:0xf") SCAN_ROUND("row_shr:4 row_mask:0xf bank_mask:0xf")
        SCAN_ROUND("row_shr:8 row_mask:0xf bank_mask:0xf") SCAN_ROUND("row_bcast:15 row_mask:0xa bank_mask:0xf") SCAN_ROUND("row_bcast:31 row_mask:0xc bank_mask:0xf")
        "s_nop 1"
        : "+v"(v[0]), "+v"(v[1]), "+v"(v[2]), "+v"(v[3]), "+v"(v[4]), "+v"(v[5]), "+v"(v[6]), "+v"(v[7]));
#undef SCAN_ROUND
}
template <bool FULL>
__device__ __forceinline__ void hg_stage(LAS unsigned char* L, int ktoff, int decoff, int w, int l, bool bwd, const v4u (&zr)[2], const v4u (&qr)[2], float (&el)[16]) {
#pragma unroll
    for (int hh = 0; hh < 2; ++hh) {
        float f[8], kk[8], E[8], lbv[8];
        { const f32x4 l0 = *(const LAS f32x4*)(L + H2_LB + (16 * w + 8 * hh) * 4), l1 = *(const LAS f32x4*)(L + H2_LB + (16 * w + 8 * hh + 4) * 4);
          lbv[0] = l0[0]; lbv[1] = l0[1]; lbv[2] = l0[2]; lbv[3] = l0[3]; lbv[4] = l1[0]; lbv[5] = l1[1]; lbv[6] = l1[2]; lbv[7] = l1[3]; }
#pragma unroll
        for (int i = 0; i < 8; ++i) { const unsigned zw = zr[hh][i >> 1]; const float z = (i & 1) ? bf_hi(zw) : bf_lo(zw);
            const float sig = __builtin_amdgcn_rcpf(1.0f + __builtin_amdgcn_exp2f(-1.4426950408889634f * z)); f[i] = lbv[i] + (1.0f - lbv[i]) * sig; kk[i] = 1.0f - f[i]; }
#pragma unroll
        for (int i = 0; i < 8; ++i) E[i] = f[i];
        wave_scan_mul8(E);
        float qd[8], kd[8], kt[8];
#pragma unroll
        for (int i = 0; i < 8; ++i) { const float last = __builtin_bit_cast(float, __builtin_amdgcn_readlane(__builtin_bit_cast(int, E[i]), 63)); el[8 * hh + i] = last;
            const float rE = __builtin_amdgcn_rcpf(E[i]); const float C = bwd ? last * f[i] * rE : E[i]; const float Cinv = bwd ? __builtin_amdgcn_rcpf(C) : rE;
            kd[i] = kk[i] * Cinv; kt[i] = kd[i] * last;
            if (FULL) { const unsigned qw = qr[hh][i >> 1]; const float q = (i & 1) ? bf_hi(qw) : bf_lo(qw); qd[i] = q * C; } }
        if (FULL) { v4u a;
            a.x = pk2(qd[0], qd[1]); a.y = pk2(qd[2], qd[3]); a.z = pk2(qd[4], qd[5]); a.w = pk2(qd[6], qd[7]);
            *(LAS v4u*)(L + H2_QD + l * 272 + 32 * w + 16 * hh) = a;
            a.x = pk2(kd[0], kd[1]); a.y = pk2(kd[2], kd[3]); a.z = pk2(kd[4], kd[5]); a.w = pk2(kd[6], kd[7]);
            *(LAS v4u*)(L + H2_KD + l * 272 + 32 * w + 16 * hh) = a; }
#pragma unroll
        for (int i = 0; i < 8; i += 2) { const unsigned pw = pk2(kt[i], kt[i + 1]);
            *(LAS unsigned short*)(L + ktoff + (16 * w + 8 * hh + i) * 144 + 2 * l) = (unsigned short)(pw & 0xffffu); *(LAS unsigned short*)(L + ktoff + (16 * w + 8 * hh + i + 1) * 144 + 2 * l) = (unsigned short)(pw >> 16); }
        if (l == 0) {
#pragma unroll
            for (int i = 0; i < 8; ++i) *(LAS float*)(L + decoff + (16 * w + 8 * hh + i) * 4) = el[8 * hh + i];
        }
    }
}
__device__ __forceinline__ void hg_write_lb(LAS unsigned char* L, const float* lbf, const float* lbb, bool bwd, int h, int w, int l) {
    if (l < 16) { const int i0 = h * 128 + 16 * w + l; const float f0 = lbf[i0], f1 = lbf[HW + i0], b0 = lbb[i0], b1 = lbb[HW + i0];
        const float a0 = bwd ? b0 : f0, a1 = bwd ? b1 : f1; *(LAS float*)(L + H2_LB + (16 * w + l) * 4) = 1.0f / (1.0f + __expf(a1 - a0)); }
}
__device__ __forceinline__ void hg_stage_v(LAS unsigned char* L, int vtoff, int w, int l, const v4u (&vr)[2]) {
#pragma unroll
    for (int i = 0; i < 8; ++i) { const unsigned vw = vr[i >> 2][i & 3];
        *(LAS unsigned short*)(L + vtoff + (16 * w + 2 * i) * 144 + 2 * l) = (unsigned short)(vw & 0xffffu); *(LAS unsigned short*)(L + vtoff + (16 * w + 2 * i + 1) * 144 + 2 * l) = (unsigned short)(vw >> 16); }
}
__device__ __forceinline__ void hg_state_update(LAS unsigned char* L, int ktoff, int vtoff, int decoff, int w, int g, int fr, f32x4 (&S)[8]) {
    bf16x8 vf[2];
#pragma unroll
    for (int k2 = 0; k2 < 2; ++k2) vf[k2] = ldsfrag(L + vtoff, 16 * w + fr, 144, 64 * k2 + 16 * g);
#pragma unroll
    for (int kt = 0; kt < 8; ++kt) { const f32x4 d4 = *(const LAS f32x4*)(L + decoff + (16 * kt + 4 * g) * 4); S[kt] = S[kt] * d4;
#pragma unroll
        for (int k2 = 0; k2 < 2; ++k2) S[kt] = __builtin_amdgcn_mfma_f32_16x16x32_bf16(ldsfrag(L + ktoff, 16 * kt + fr, 144, 64 * k2 + 16 * g), vf[k2], S[kt], 0, 0, 0); }
}
__device__ __forceinline__ size_t hg_slot(int dir, int b, int h, int sc) { return (size_t)(((dir * BATCH + b) * HH + h) * 8 + sc); }

struct HgIn { v4u z[2], q[2], v[2]; };
template <bool FULL>
__device__ __forceinline__ void hg_load(HgIn& r, const bf16* P, int b, int h, int w, int l, int cn, bool bwd) {
    const bf16* row = P + (size_t)(b * SEQ + cn * 64 + l) * NIN;
    const int colz = (bwd ? CFB : CFF) + h * 128 + 16 * w, colv = CIH + h * 128 + 16 * w, colq = CQH + h * 128 + 16 * w;
    r.z[0] = *(const GAS v4u*)(row + colz); r.z[1] = *(const GAS v4u*)(row + colz + 8); r.v[0] = *(const GAS v4u*)(row + colv); r.v[1] = *(const GAS v4u*)(row + colv + 8);
    if (FULL) { r.q[0] = *(const GAS v4u*)(row + colq); r.q[1] = *(const GAS v4u*)(row + colq + 8); } else { r.q[0] = r.z[0]; r.q[1] = r.z[1]; }
}
__device__ __forceinline__ void hgrn_pass1(Frame& F, const bf16* P, float* SL, float* DL) {
    LAS unsigned char* L = F.lds + RING_OFF;
    const int w = F.wave, l = F.lane, g = l >> 4, fr = l & 15;
    for (int item = F.vcu; item < 256; item += F.G) { const int b = item >> 6, h = (item >> 3) & 7, sc = item & 7;
        HgIn in; hg_load<false>(in, P, b, h, w, l, sc * 4, false);
        f32x4 S[8]; float dtot[16];
        for (int t = 0; t < 8; ++t) { const bool bwd = t >= 4; const int n = t & 3, buf = t & 1;
            if (n == 0) { hg_write_lb(L, F.lbf, F.lbb, bwd, h, w, l);
#pragma unroll
                for (int kt = 0; kt < 8; ++kt) S[kt] = (f32x4){0.f, 0.f, 0.f, 0.f};
#pragma unroll
                for (int i = 0; i < 16; ++i) dtot[i] = 1.0f; }
            float el[16];
            hg_stage_v(L, buf ? H2_VT1 : H2_VT0, w, l, in.v);
            hg_stage<false>(L, buf ? H2_KT1 : H2_KT0, buf ? H2_DEC1 : H2_DEC0, w, l, bwd, in.z, in.q, el);
            if (t + 1 < 8) { const bool nb = (t + 1) >= 4; const int nn = (t + 1) & 3; hg_load<false>(in, P, b, h, w, l, sc * 4 + (nb ? 3 - nn : nn), nb); }
#pragma unroll
            for (int i = 0; i < 16; ++i) dtot[i] *= el[i];
            __syncthreads();
            hg_state_update(L, buf ? H2_KT1 : H2_KT0, buf ? H2_VT1 : H2_VT0, buf ? H2_DEC1 : H2_DEC0, w, g, fr, S);
            if (n == 3) { const size_t slot = hg_slot(bwd ? 1 : 0, b, h, sc); float* so = SL + slot * 16384;
#pragma unroll
                for (int kt = 0; kt < 8; ++kt) *(GAS f32x4*)(so + (size_t)((kt * 8 + w) * 64 + l) * 4) = S[kt];
                if (l == 0) {
#pragma unroll
                    for (int i = 0; i < 16; ++i) DL[slot * 128 + 16 * w + i] = dtot[i];
                } }
        }
        __syncthreads();
    }
}

__device__ __forceinline__ void hgrn_pass2_compute(LAS unsigned char* L, int w, int g, int fr, bool bwd, int vtoff, f32x4 (&S)[8], f32x4 (&o)[4]) {
    {   const int ct = w >> 1, sh = w & 1;
        bf16x8 qfr[4];
#pragma unroll
        for (int ks = 0; ks < 4; ++ks) qfr[ks] = ldsfrag(L + H2_QD, 16 * ct + fr, 272, 64 * ks + 16 * g);
#pragma unroll
        for (int t2 = 0; t2 < 2; ++t2) { const int st = 2 * sh + t2; f32x4 sc4 = (f32x4){0.f, 0.f, 0.f, 0.f};
#pragma unroll
            for (int ks = 0; ks < 4; ++ks) sc4 = __builtin_amdgcn_mfma_f32_16x16x32_bf16(ldsfrag(L + H2_KD, 16 * st + fr, 272, 64 * ks + 16 * g), qfr[ks], sc4, 0, 0, 0);
            const int c = 16 * ct + fr, s0 = 16 * st + 4 * g;
            float m[4];
#pragma unroll
            for (int r = 0; r < 4; ++r) { const bool keep = bwd ? (s0 + r >= c) : (s0 + r <= c); m[r] = keep ? sc4[r] : 0.f; }
            v2u pw; pw.x = pk2(m[0], m[1]); pw.y = pk2(m[2], m[3]);
            *(LAS v2u*)(L + H2_PS + c * 144 + 2 * s0) = pw; } }
    {   bf16x8 sa[4];
#pragma unroll
        for (int k2 = 0; k2 < 4; ++k2) { v4u t; t.x = pk2(S[2 * k2][0], S[2 * k2][1]); t.y = pk2(S[2 * k2][2], S[2 * k2][3]); t.z = pk2(S[2 * k2 + 1][0], S[2 * k2 + 1][1]); t.w = pk2(S[2 * k2 + 1][2], S[2 * k2 + 1][3]); sa[k2] = __builtin_bit_cast(bf16x8, t); }
#pragma unroll
        for (int ct = 0; ct < 4; ++ct) { const LAS unsigned char* qrow = L + H2_QD + (16 * ct + fr) * 272; o[ct] = (f32x4){0.f, 0.f, 0.f, 0.f};
#pragma unroll
            for (int k2 = 0; k2 < 4; ++k2) { const v2u b0 = *(const LAS v2u*)(qrow + 2 * (32 * k2 + 4 * g)), b1 = *(const LAS v2u*)(qrow + 2 * (32 * k2 + 16 + 4 * g));
                const v4u bv = (v4u){b0.x, b0.y, b1.x, b1.y};
                o[ct] = __builtin_amdgcn_mfma_f32_16x16x32_bf16(sa[k2], __builtin_bit_cast(bf16x8, bv), o[ct], 0, 0, 0); } } }
    hg_state_update(L, H2_KT0, vtoff, H2_DEC0, w, g, fr, S);
    __syncthreads();
    {   bf16x8 vf[2];
#pragma unroll
        for (int k2 = 0; k2 < 2; ++k2) vf[k2] = ldsfrag(L + vtoff, 16 * w + fr, 144, 64 * k2 + 16 * g);
#pragma unroll
        for (int ct = 0; ct < 4; ++ct)
#pragma unroll
            for (int k2 = 0; k2 < 2; ++k2) o[ct] = __builtin_amdgcn_mfma_f32_16x16x32_bf16(vf[k2], ldsfrag(L + H2_PS, 16 * ct + fr, 144, 64 * k2 + 16 * g), o[ct], 0, 0, 0); }
}
__device__ __forceinline__ void hgrn_pass2(Frame& F, const bf16* P, const float* SL, const float* DL, float* OFW, bf16* Y) {
    LAS unsigned char* L = F.lds + RING_OFF;
    const int w = F.wave, l = F.lane, g = l >> 4, fr = l & 15;
    LAS float* RED = (LAS float*)(L + H2_RED);
    for (int item = F.vcu; item < 256; item += F.G) { const int b = item >> 6, h = (item >> 3) & 7, sc = item & 7;
        HgIn in; hg_load<true>(in, P, b, h, w, l, sc * 4, false);
        const f32x4 gn = *(const GAS f32x4*)(F.ognorm + h * 128 + 16 * w + 4 * g);
        f32x4 S[8];
        for (int t = 0; t < 8; ++t) { const bool bwd = t >= 4; const int n = t & 3, j = bwd ? 3 - n : n, dir = bwd ? 1 : 0;
            if (n == 0) {
                if (bwd) { asm volatile("s_waitcnt vmcnt(0)" ::: "memory"); }
                hg_write_lb(L, F.lbf, F.lbb, bwd, h, w, l);
#pragma unroll
                for (int kt = 0; kt < 8; ++kt) S[kt] = (f32x4){0.f, 0.f, 0.f, 0.f};
                const int nf = bwd ? 7 - sc : sc;
                LAS float* DLS = (LAS float*)(L + H2_PS);
                for (int u = F.tid; u < nf * 128; u += NWAVES * 64) { const int tt = u >> 7; const int i = bwd ? 7 - tt : tt; DLS[u] = DL[hg_slot(dir, b, h, i) * 128 + (u & 127)]; }
                __syncthreads();
                int tt = 0;
                for (; tt + 1 < nf; tt += 2) {
                    const int i0 = bwd ? 7 - tt : tt, i1 = bwd ? 6 - tt : tt + 1;
                    const float* sl0 = SL + hg_slot(dir, b, h, i0) * 16384 + (size_t)(w * 64 + l) * 4; const float* sl1 = SL + hg_slot(dir, b, h, i1) * 16384 + (size_t)(w * 64 + l) * 4;
                    f32x4 s4a[8], s4b[8];
#pragma unroll
                    for (int kt = 0; kt < 8; ++kt) { s4a[kt] = *(const GAS f32x4*)(sl0 + (size_t)kt * 8 * 256); s4b[kt] = *(const GAS f32x4*)(sl1 + (size_t)kt * 8 * 256); }
                    asm volatile("" ::: "memory");
#pragma unroll
                    for (int kt = 0; kt < 8; ++kt) { const f32x4 d0 = *(const LAS f32x4*)(DLS + tt * 128 + 16 * kt + 4 * g), d1 = *(const LAS f32x4*)(DLS + (tt + 1) * 128 + 16 * kt + 4 * g);
                        S[kt] = (S[kt] * d0 + s4a[kt]) * d1 + s4b[kt]; } }
                if (tt < nf) { const int i = bwd ? 7 - tt : tt; const float* sl = SL + hg_slot(dir, b, h, i) * 16384 + (size_t)(w * 64 + l) * 4;
                    f32x4 s4[8];
#pragma unroll
                    for (int kt = 0; kt < 8; ++kt) s4[kt] = *(const GAS f32x4*)(sl + (size_t)kt * 8 * 256);
                    asm volatile("" ::: "memory");
#pragma unroll
                    for (int kt = 0; kt < 8; ++kt) { const f32x4 d4 = *(const LAS f32x4*)(DLS + tt * 128 + 16 * kt + 4 * g); S[kt] = S[kt] * d4 + s4[kt]; } }
            }
            const int vtoff = (t & 1) ? H2_VT1 : H2_VT0;
            {   float el[16];
                hg_stage_v(L, vtoff, w, l, in.v);
                hg_stage<true>(L, H2_KT0, H2_DEC0, w, l, bwd, in.z, in.q, el); }
            if (t + 1 < 8) { const bool nb = (t + 1) >= 4; const int nn = (t + 1) & 3; hg_load<true>(in, P, b, h, w, l, sc * 4 + (nb ? 3 - nn : nn), nb); }
            float* ofw = OFW + ((size_t)((item * 4 + j) * 4) * 8 + w) * 256 + (size_t)l * 4;
            f32x4 of[4]; v2u gr[4];
            if (bwd) {
#pragma unroll
                for (int ct = 0; ct < 4; ++ct) { of[ct] = *(const GAS f32x4*)(ofw + (size_t)ct * 8 * 256);
                    gr[ct] = *(const GAS v2u*)(P + (size_t)(b * SEQ + (sc * 4 + j) * 64 + ct * 16 + fr) * NIN + CGH + h * 128 + 16 * w + 4 * g); }
            }
            __syncthreads();
            f32x4 o[4];
            hgrn_pass2_compute(L, w, g, fr, bwd, vtoff, S, o);
            if (!bwd) {
#pragma unroll
                for (int ct = 0; ct < 4; ++ct) *(GAS f32x4*)(ofw + (size_t)ct * 8 * 256) = o[ct];
            } else {
                float ps[4];
#pragma unroll
                for (int ct = 0; ct < 4; ++ct) { o[ct] = o[ct] + of[ct]; const f32x4 v = o[ct];
                    float s2 = (v[0] * v[0] + v[1] * v[1]) + (v[2] * v[2] + v[3] * v[3]); s2 += __shfl_xor(s2, 16); s2 += __shfl_xor(s2, 32); ps[ct] = s2; }
                if (g == 0) {
#pragma unroll
                    for (int ct = 0; ct < 4; ++ct) RED[w * 64 + ct * 16 + fr] = ps[ct];
                }
                __syncthreads();
#pragma unroll
                for (int ct = 0; ct < 4; ++ct) { const int ti = ct * 16 + fr; float tot = 0.f;
#pragma unroll
                    for (int ww = 0; ww < 8; ++ww) tot += RED[ww * 64 + ti];
                    const float rs = 1.0f / sqrtf(tot * (1.f / 128.f) + EPS);
                    const size_t row = (size_t)(b * SEQ + (sc * 4 + j) * 64 + ti);
                    const f32x4 v = o[ct];
                    v2u o2; o2.x = pk2(v[0] * rs * gn[0] * pg8::silu_f(bf_lo(gr[ct].x)), v[1] * rs * gn[1] * pg8::silu_f(bf_hi(gr[ct].x)));
                    o2.y = pk2(v[2] * rs * gn[2] * pg8::silu_f(bf_lo(gr[ct].y)), v[3] * rs * gn[3] * pg8::silu_f(bf_hi(gr[ct].y)));
                    *(GAS v2u*)(Y + row * D + h * 128 + 16 * w + 4 * g) = o2; }
            }
        }
        __syncthreads();
    }
}

constexpr int AT_K = 0, AT_V = 34816, AT_TB = 69632, AT_END = 69632 + 2 * 264 * 4;
__device__ __forceinline__ int t5_bucket(int rel) {
    const int n = rel < 0 ? -rel : rel; int bkt;
    if (n < 8) bkt = n; else { int j = 0; while (j < 7 && 64 * (2 << j) <= n * n) ++j; bkt = 8 + j; }
    return bkt + (rel > 0 ? 16 : 0);
}
struct AtRegs { v4u k[4], v[4]; };
__device__ __forceinline__ void at_load(AtRegs& r, const bf16* P, int b, int kb, int kvh, int tid) {
    const bf16* kvbase = P + (size_t)(b * SEQ + kb * 128) * NIN;
#pragma unroll
    for (int i = 0; i < 4; ++i) { const int id = tid + 512 * i; r.k[i] = *(const GAS v4u*)(kvbase + (size_t)(id >> 4) * NIN + CKA + kvh * 128 + 8 * (id & 15)); }
#pragma unroll
    for (int i = 0; i < 4; ++i) { const int id = tid + 512 * i; r.v[i] = *(const GAS v4u*)(kvbase + (size_t)(id & 127) * NIN + CVA + kvh * 128 + 8 * (id >> 7)); }
}
__device__ __forceinline__ void at_stage(LAS unsigned char* L, const AtRegs& r, int tid) {
#pragma unroll
    for (int i = 0; i < 4; ++i) { const int id = tid + 512 * i; *(LAS v4u*)(L + AT_K + (id >> 4) * 272 + 16 * (id & 15)) = r.k[i]; }
#pragma unroll
    for (int i = 0; i < 4; ++i) { const int id = tid + 512 * i; const int key = id & 127, ch = id >> 7;
#pragma unroll
        for (int e = 0; e < 4; ++e) { *(LAS unsigned short*)(L + AT_V + (8 * ch + 2 * e) * 272 + 2 * key) = (unsigned short)(r.v[i][e] & 0xffffu); *(LAS unsigned short*)(L + AT_V + (8 * ch + 2 * e + 1) * 272 + 2 * key) = (unsigned short)(r.v[i][e] >> 16); } }
}
__device__ __forceinline__ void at_head(LAS unsigned char* L, const LAS float* TB, int relbase, int g, int fr, const bf16x8 (&bq)[4], float& mrun, float& lrun, f32x4 (&ot)[8]) {
    const float scale = 0.08838834764831845f;
    f32x4 st[8];
#pragma unroll
    for (int mt = 0; mt < 8; ++mt) { st[mt] = (f32x4){0.f, 0.f, 0.f, 0.f};
#pragma unroll
        for (int ks = 0; ks < 4; ++ks) st[mt] = __builtin_amdgcn_mfma_f32_16x16x32_bf16(ldsfrag(L + AT_K, 16 * mt + fr, 272, 64 * ks + 16 * g), bq[ks], st[mt], 0, 0, 0); }
    float mx = -3.0e38f;
#pragma unroll
    for (int mt = 0; mt < 8; ++mt)
#pragma unroll
        for (int r = 0; r < 4; ++r) { const int rel = relbase + 16 * mt + r; const bool ok = rel >= -128 && rel <= 128; const int ri = min(max(rel + 128, 0), 256);
            const float tb = TB[ri]; const float s = ok ? st[mt][r] * scale + tb : -1.0e30f; st[mt][r] = s; mx = fmaxf(mx, s); }
    mx = fmaxf(mx, __shfl_xor(mx, 16)); mx = fmaxf(mx, __shfl_xor(mx, 32));
    const float mnew = fmaxf(mrun, mx), alpha = __expf(mrun - mnew); mrun = mnew;
    float ls = 0.f;
#pragma unroll
    for (int mt = 0; mt < 8; ++mt)
#pragma unroll
        for (int r = 0; r < 4; ++r) { const float p = __expf(st[mt][r] - mnew); st[mt][r] = p; ls += p; }
    ls += __shfl_xor(ls, 16); ls += __shfl_xor(ls, 32);
    lrun = lrun * alpha + ls;
#pragma unroll
    for (int dt = 0; dt < 8; ++dt) ot[dt] = ot[dt] * alpha;
#pragma unroll
    for (int k2 = 0; k2 < 4; ++k2) {
        v4u pb; pb.x = pk2(st[2 * k2][0], st[2 * k2][1]); pb.y = pk2(st[2 * k2][2], st[2 * k2][3]); pb.z = pk2(st[2 * k2 + 1][0], st[2 * k2 + 1][1]); pb.w = pk2(st[2 * k2 + 1][2], st[2 * k2 + 1][3]);
        const bf16x8 pfrag = __builtin_bit_cast(bf16x8, pb);
#pragma unroll
        for (int dt = 0; dt < 8; ++dt) { const LAS unsigned char* vrow = L + AT_V + (16 * dt + fr) * 272;
            const v2u a0 = *(const LAS v2u*)(vrow + 2 * (32 * k2 + 4 * g)), a1 = *(const LAS v2u*)(vrow + 2 * (32 * k2 + 16 + 4 * g));
            const v4u av = (v4u){a0.x, a0.y, a1.x, a1.y};
            ot[dt] = __builtin_amdgcn_mfma_f32_16x16x32_bf16(__builtin_bit_cast(bf16x8, av), pfrag, ot[dt], 0, 0, 0); } }
}
__device__ __forceinline__ void attn_item(Frame& F, const bf16* P, bf16* Y, int item) {
    LAS unsigned char* L = F.lds + RING_OFF;
    const int w = F.wave, l = F.lane, g = l >> 4, fr = l & 15, tid = F.tid;
    {
        const int hq = item & 3, blk = (item >> 2) & 15, kvh = (item >> 6) & 1, b = item >> 7, h = kvh * 4 + hq;
        LAS float* TB = (LAS float*)(L + AT_TB);
        if (tid < 257) TB[tid] = F.relb[t5_bucket(tid - 128) * AH + h];
        const int jt0 = blk == 0 ? 1 : 0, jt1 = blk == 15 ? 1 : 2;
        AtRegs R; at_load(R, P, b, blk - 1 + jt0, kvh, tid);
        const int qrow = b * SEQ + blk * 128 + 16 * w + fr;
        bf16x8 bq[4];
#pragma unroll
        for (int ks = 0; ks < 4; ++ks) bq[ks] = *(const GAS bf16x8*)(P + (size_t)qrow * NIN + CQA + h * 128 + 32 * ks + 8 * g);
        float mrun = F.sink[h], lrun = 1.0f;
        f32x4 ot[8];
#pragma unroll
        for (int dt = 0; dt < 8; ++dt) ot[dt] = (f32x4){0.f, 0.f, 0.f, 0.f};
        for (int jt = jt0; jt <= jt1; ++jt) {
            at_stage(L, R, tid);
            __syncthreads();
            if (jt < jt1) at_load(R, P, b, blk + jt, kvh, tid);
            const int relbase = (jt - 1) * 128 + 4 * g - (16 * w + fr);
            at_head(L, TB, relbase, g, fr, bq, mrun, lrun, ot);
            __syncthreads();
        }
        const float inv = 1.0f / lrun;
#pragma unroll
        for (int dt = 0; dt < 8; ++dt) { v2u o2; o2.x = pk2(ot[dt][0] * inv, ot[dt][1] * inv); o2.y = pk2(ot[dt][2] * inv, ot[dt][3] * inv);
            *(GAS v2u*)(Y + (size_t)qrow * D + HW + h * 128 + 16 * dt + 4 * g) = o2; }
        __syncthreads();
    }
}
__device__ __forceinline__ void attn_phase(Frame& F, const bf16* P, bf16* Y) { for (int item = F.vcu; item < 512; item += F.G) attn_item(F, P, Y, item); }
constexpr int CW_GRP = 1024;
__device__ __forceinline__ void hg_group_publish(Frame& F, int grp) {
    asm volatile("s_waitcnt vmcnt(0)" ::: "memory");
    __syncthreads();
    if (F.tid == 0) { __builtin_amdgcn_fence(__ATOMIC_RELEASE, "agent"); asm volatile("s_waitcnt vmcnt(0)" ::: "memory");
        __hip_atomic_fetch_add((unsigned*)(F.ctl + CW_GRP + 64 * grp), 1u, __ATOMIC_RELAXED, __HIP_MEMORY_SCOPE_AGENT); }
}
__device__ __forceinline__ void hg_group_wait(Frame& F, int grp) {
    if (F.tid == 0) { unsigned sp = 0;
        while (__hip_atomic_load((unsigned*)(F.ctl + CW_GRP + 64 * grp), __ATOMIC_RELAXED, __HIP_MEMORY_SCOPE_AGENT) < 8u) { __builtin_amdgcn_s_sleep(2); if (++sp > (1u << 20)) break; }
        __builtin_amdgcn_fence(__ATOMIC_ACQUIRE, "agent"); asm volatile("s_waitcnt vmcnt(0)" ::: "memory"); }
    __syncthreads();
}

struct Args { const float* in[18]; float* out; unsigned char* ws; int ph_lo, ph_hi, li, pad; };
__global__ void __launch_bounds__(NWAVES * 64, 2) hymba_fwd(Args args) {
    extern __shared__ __attribute__((aligned(16))) unsigned char lds[];
    Frame F;
    F.lds = (LAS unsigned char*)lds;
    F.MISC = (volatile LAS unsigned*)(F.lds + MISC_OFF);
    F.tid = threadIdx.x; F.lane = F.tid & 63; F.wave = __builtin_amdgcn_readfirstlane(F.tid >> 6);
    F.G = gridDim.x; { const int bx = blockIdx.x; F.vcu = (F.G % 8 == 0) ? (bx % 8) * (F.G / 8) + bx / 8 : bx; }
    unsigned char* ws = args.ws;
    F.ctl = (gu32*)(ws + WS_CTL);
    F.x = args.in[0]; F.pre1 = args.in[1]; F.post1 = args.in[2]; F.w1gu = args.in[3]; F.w1d = args.in[4]; F.prem = args.in[5]; F.postm = args.in[6]; F.win = args.in[7];
    F.lbf = args.in[8]; F.lbb = args.in[9]; F.ognorm = args.in[10]; F.sink = args.in[11]; F.wout = args.in[12]; F.pre2 = args.in[13]; F.post2 = args.in[14];
    F.w2gu = args.in[15]; F.w2d = args.in[16]; F.relb = args.in[17]; F.out = args.out;
    F.W1GU = (bf16*)(ws + WS_W1GU); F.W1D = (bf16*)(ws + WS_W1D); F.WIN = (bf16*)(ws + WS_WIN); F.WOUT = (bf16*)(ws + WS_WOUT); F.W2GU = (bf16*)(ws + WS_W2GU); F.W2D = (bf16*)(ws + WS_W2D);
    F.H = (bf16*)(ws + WS_H); F.ACT = (bf16*)(ws + WS_ACT); F.FFB = (bf16*)(ws + WS_FF); F.SLB = (float*)(ws + WS_FF); F.XR = (bf16*)(ws + WS_FF + 32 * MiB); F.ssq = (float*)(ws + WS_SSQ);
    for (int u = F.tid; u < (LDS_BYTES - LDSCTL_OFF) / 4; u += NWAVES * 64) ((LAS unsigned*)(F.lds + LDSCTL_OFF))[u] = 0u;
    __syncthreads();
    XcdBarrier bar; bar.bar = (unsigned*)(F.ctl + CW_BAR); bar.x = 0; bar.st = nullptr;
    if (N_LAUNCHES != PER_PHASE) bar = xcd_barrier_post((unsigned*)(F.ctl + CW_BAR), F.MISC + 8);
#define GRID_BAR() do { if (N_LAUNCHES != PER_PHASE) xcd_barrier(bar); } while (0)
    const int lo = args.ph_lo, hi = args.ph_hi;
    unsigned long long pr_t0 = 0, pr_dt = 0;
#ifdef PROBE_PHASE
#define TS(k) do { if ((k) == PROBE_PHASE) pr_t0 = __builtin_amdgcn_s_memrealtime(); } while (0)
#define TE(k) do { if ((k) == PROBE_PHASE) pr_dt = __builtin_amdgcn_s_memrealtime() - pr_t0; } while (0)
#else
#define TS(k) do {} while (0)
#define TE(k) do {} while (0)
#endif
#define IN(k) (lo <= (k) && (k) < hi)
#define BOTH(k) (IN(k) && IN((k) + 1))
    typedef pg8::StaticOrder SO;
    TS(0); if (IN(0)) for (int r_ = 0; r_ < REP_P0; ++r_) { p0_prologue(F); if (BOTH(0)) GRID_BAR(); }
    TE(0);
    TS(1); if (IN(1)) for (int r_ = 0; r_ < REP_P1; ++r_) { pg8::Gemm gm{F.H, F.W1GU, M, NGU, D}; SO S; S.init(M, NGU, F.G, (int)blockIdx.x); pg8::EpiSwiglu E{F.ACT, FF};
        pg8::gemm_phase<pg8::EpiSwiglu, SO, PG8_ALIGN, PG8_SP2>(F.lds + RING_OFF, gm, S, E);
        { const int nfull = (M / 256) * (NGU / 256) % F.G;
          if (nfull != 0 && (int)blockIdx.x >= nfull && r_ == 0) convert_list<1>(F, ((int)blockIdx.x - nfull) * NWAVES + F.wave, (F.G - nfull) * NWAVES);
          else if (nfull == 0 && r_ == 0) convert_list<1>(F, F.vcu * NWAVES + F.wave, F.G * NWAVES); }
        if (BOTH(1)) GRID_BAR(); }
    TE(1);
    TS(2); if (IN(2)) for (int r_ = 0; r_ < REP_P2; ++r_) { pg8::Gemm gm{F.ACT, F.W1D, M, D, FF}; SO S; S.init(M, D, F.G, (int)blockIdx.x); pg8::EpiBf16Ssq E{F.FFB, D, F.ssq};
        pg8::gemm_phase<pg8::EpiBf16Ssq, SO, PG8_ALIGN, PG8_SP2>(F.lds + RING_OFF, gm, S, E); if (BOTH(2)) GRID_BAR(); }
    TE(2);
    TS(3); if (IN(3)) for (int r_ = 0; r_ < REP_P3; ++r_) { ew_phase<true, false>(F, F.x, F.FFB, F.ssq, F.post1, 0.5f, F.XR, F.prem, F.H); if (BOTH(3)) GRID_BAR(); }
    TE(3);
    TS(4); if (IN(4)) for (int r_ = 0; r_ < REP_P4; ++r_) { pg8::Gemm gm{F.H, F.WIN, M, NIN, D}; SO S; S.init(M, NIN, F.G, (int)blockIdx.x); pg8::EpiBf16 E{F.ACT, NIN};
        pg8::gemm_phase<pg8::EpiBf16, SO, PG8_ALIGN, PG8_SP2>(F.lds + RING_OFF, gm, S, E);
        { const int nfull = (M / 256) * (NIN / 256) % F.G;
          if (nfull != 0 && (int)blockIdx.x >= nfull && r_ == 0) convert_list<2>(F, ((int)blockIdx.x - nfull) * NWAVES + F.wave, (F.G - nfull) * NWAVES);
          else if (nfull == 0 && r_ == 0) convert_list<2>(F, F.vcu * NWAVES + F.wave, F.G * NWAVES); }
        if (BOTH(4)) GRID_BAR(); }
    TE(4);
    TS(5); if (IN(5)) {
        if (F.G == 256 && REP_HG == 1 && REP_AT == 1) {
            const int grp = F.vcu >> 3;
            hgrn_pass1(F, F.ACT, F.SLB, F.ssq); hg_group_publish(F, grp);
            attn_item(F, F.ACT, F.H, F.vcu);
            hg_group_wait(F, grp); hgrn_pass2(F, F.ACT, F.SLB, F.ssq, F.out, F.H);
            attn_item(F, F.ACT, F.H, F.vcu + 256);
        } else {
            for (int r_ = 0; r_ < REP_HG; ++r_) hgrn_pass1(F, F.ACT, F.SLB, F.ssq); for (int r_ = 0; r_ < REP_AT; ++r_) attn_phase(F, F.ACT, F.H); GRID_BAR();
            hgrn_pass2(F, F.ACT, F.SLB, F.ssq, F.out, F.H);
        }
        if (BOTH(5)) GRID_BAR(); }
    TE(5);
    TS(6);
    TE(6);
    TS(7); if (IN(7)) for (int r_ = 0; r_ < REP_P7; ++r_) { pg8::Gemm gm{F.H, F.WOUT, M, D, D}; SO S; S.init(M, D, F.G, (int)blockIdx.x); pg8::EpiBf16Ssq E{F.FFB, D, F.ssq};
        pg8::gemm_phase<pg8::EpiBf16Ssq, SO, PG8_ALIGN, PG8_SP2>(F.lds + RING_OFF, gm, S, E); if (BOTH(7)) GRID_BAR(); }
    TE(7);
    TS(8); if (IN(8)) { ew_phase<false, false>(F, F.XR, F.FFB, F.ssq, F.postm, 1.0f, F.XR, F.pre2, F.H); if (BOTH(8)) GRID_BAR(); }
    TE(8);
    TS(9); if (IN(9)) { pg8::Gemm gm{F.H, F.W2GU, M, NGU, D}; SO S; S.init(M, NGU, F.G, (int)blockIdx.x); pg8::EpiSwiglu E{F.ACT, FF};
        pg8::gemm_phase<pg8::EpiSwiglu, SO, PG8_ALIGN, PG8_SP2>(F.lds + RING_OFF, gm, S, E);
        { const int nfull = (M / 256) * (NGU / 256) % F.G;
          if (nfull != 0 && (int)blockIdx.x >= nfull) convert_list<3>(F, ((int)blockIdx.x - nfull) * NWAVES + F.wave, (F.G - nfull) * NWAVES);
          else if (nfull == 0) convert_list<3>(F, F.vcu * NWAVES + F.wave, F.G * NWAVES); }
        if (BOTH(9)) GRID_BAR(); }
    TE(9);
    TS(10); if (IN(10)) { pg8::Gemm gm{F.ACT, F.W2D, M, D, FF}; SO S; S.init(M, D, F.G, (int)blockIdx.x); pg8::EpiBf16Ssq E{F.FFB, D, F.ssq};
        pg8::gemm_phase<pg8::EpiBf16Ssq, SO, PG8_ALIGN, PG8_SP2>(F.lds + RING_OFF, gm, S, E); if (BOTH(10)) GRID_BAR(); }
    TE(10);
    TS(11); if (IN(11)) { ew_phase<false, true>(F, F.XR, F.FFB, F.ssq, F.post2, 0.5f, F.out, nullptr, nullptr); }
    TE(11);
#undef IN
#undef BOTH
#ifdef PROBE_PHASE
    if (blockIdx.x == 0 && F.tid == 0) { const unsigned long long te = __builtin_amdgcn_s_memrealtime(); while (__builtin_amdgcn_s_memrealtime() - te < (unsigned long long)PROBE_MULT * pr_dt) __builtin_amdgcn_s_sleep(8); }
#endif
}

extern "C" void kernel_launch(void* const* d_in, const int* in_sizes, int n_in, void* d_out, int out_size, void* d_ws, size_t ws_size, hipStream_t stream) {
    static int grid = 0;
    if (grid == 0) {
        if (n_in != 18 || in_sizes[0] != M * D || out_size != M * D || ws_size < WS_END) { fprintf(stderr, "kernel_launch: unexpected shapes/workspace (n_in %d, ws %zu)\n", n_in, ws_size); grid = -1; return; }
        int dev = 0, cus = 0;
        if (hipGetDevice(&dev) != hipSuccess || hipDeviceGetAttribute(&cus, hipDeviceAttributeMultiprocessorCount, dev) != hipSuccess) { grid = -1; return; }
        if (hipFuncSetAttribute((const void*)hymba_fwd, hipFuncAttributeMaxDynamicSharedMemorySize, LDS_BYTES) != hipSuccess) { fprintf(stderr, "kernel_launch: hipFuncSetAttribute failed\n"); grid = -1; return; }
        (void)hipGetLastError();
        grid = cus;
    }
    if (grid < 0) return;
    if (hipMemsetAsync((char*)d_ws + WS_CTL, 0, CTL_ZERO_BYTES, stream) != hipSuccess) return;
    Args a{};
    for (int i = 0; i < 18; ++i) a.in[i] = (const float*)d_in[i];
    a.out = (float*)d_out; a.ws = (unsigned char*)d_ws;
    if (N_LAUNCHES == 1) { a.ph_lo = 0; a.ph_hi = PER_PHASE; a.li = 0; hipLaunchKernelGGL(hymba_fwd, dim3(grid), dim3(NWAVES * 64), LDS_BYTES, stream, a); }
    else { for (int li = 0; li < PER_PHASE; ++li) { a.ph_lo = li; a.ph_hi = li + 1; a.li = li; hipLaunchKernelGGL(hymba_fwd, dim3(grid), dim3(NWAVES * 64), LDS_BYTES, stream, a); } }
}
```

```cpp
#include <hip/hip_runtime.h>
#include <cstdio>
#include <cstdint>

#ifndef MK_N_LAUNCHES
#define MK_N_LAUNCHES 1
#endif

namespace pg8 {
#define PG8_LAS __attribute__((address_space(3)))
typedef unsigned short bf16_t;
typedef short bf16x8 __attribute__((ext_vector_type(8)));
typedef float f32x4 __attribute__((ext_vector_type(4)));
typedef unsigned u32x4 __attribute__((ext_vector_type(4)));
#ifndef PG8_WGM
#define PG8_WGM 8
#endif
constexpr int BM = 256, BK = 64, HALF = 128, HTB = HALF * BK * 2  , STAGE_BYTES = 8 * HTB, NXCD = 8, WGM = PG8_WGM;

__host__ __device__ __forceinline__ int lds_byte(int r, int c) { const int st = (r >> 4) * 2 + (c >> 5), rr = r & 15, cc = c & 31, ob = rr * 64 + cc * 2; return st * 1024 + (ob ^ (((ob >> 9) & 1) << 5)); }
__host__ __device__ __forceinline__ void stage_rc(int b, int& R, int& C) { const int st = b / 1024, sb = b % 1024, swz = sb ^ (((sb >> 9) & 1) << 5); R = (st >> 1) * 16 + swz / 64; C = (st & 1) * 32 + (swz % 64) / 2; }
__host__ __device__ __forceinline__ int perm32(int rho) { const int n = rho >> 4, i = rho & 15; return 8 * (i >> 2) + 4 * n + (i & 3); }

struct Unit { int pm, pn; };
struct Gemm { const bf16_t* A; const bf16_t* Bt; int M, N, K; };

struct StaticOrder {
    int nM, nN, nwg, G, c;
    __host__ __device__ void init(int M, int N, int G_, int c_) { nM = M / BM; nN = N / BM; nwg = nM * nN; G = G_; c = c_; }
    __host__ __device__ bool next(int i, Unit& u) const {
        const long L = (long)i * G + c; if (L >= nwg) return false;
        int wgid = (int)L; { const int q = nwg / NXCD, r = nwg % NXCD, xcd = wgid % NXCD, off = wgid / NXCD; wgid = (xcd < r ? xcd * (q + 1) : r * (q + 1) + (xcd - r) * q) + off; }
        const int nig = WGM * nN, gid = wgid / nig, fm = gid * WGM, gsz = (nM - fm) < WGM ? (nM - fm) : WGM;
        u.pm = fm + ((wgid % nig) % gsz); u.pn = (wgid % nig) / gsz; return true;
    }
    __device__ __forceinline__ void a_ready(const Unit&) const {}
    __device__ __forceinline__ void done(const Unit&) const {}
};

typedef __bf16 bf16v2_t __attribute__((ext_vector_type(2)));
typedef float f32v2_t __attribute__((ext_vector_type(2)));
__device__ __forceinline__ unsigned cvt_pk_bf16(float lo, float hi) { const f32v2_t v = {lo, hi}; const bf16v2_t b = __builtin_convertvector(v, bf16v2_t); return __builtin_bit_cast(unsigned, b); }

struct EpiBf16 {
    static constexpr bool PERM = true, AFTER_DRAIN = false;
    bf16_t* O; int ldc;
    __device__ __forceinline__ void operator()(const f32x4 (&acc)[2][2][4][2], const Unit& u, int wr, int wc, int fr, int fq) const {
        const int row0 = u.pm * BM + wr * 64 + fr; const int col0 = u.pn * BM + wc * 32 + 8 * fq;
#pragma unroll
        for (int ai = 0; ai < 2; ++ai)
#pragma unroll
            for (int m = 0; m < 4; ++m) { bf16_t* rowp = O + (size_t)(row0 + ai * HALF + m * 16) * ldc + col0;
#pragma unroll
                for (int bj = 0; bj < 2; ++bj) { const f32x4 v0 = acc[ai][bj][m][0], v1 = acc[ai][bj][m][1];
                    u32x4 w; w.x = cvt_pk_bf16(v0[0], v0[1]); w.y = cvt_pk_bf16(v0[2], v0[3]); w.z = cvt_pk_bf16(v1[0], v1[1]); w.w = cvt_pk_bf16(v1[2], v1[3]);
                    *(u32x4*)(rowp + bj * HALF) = w; } }
    }
};
__device__ __forceinline__ float silu_f(float x) { return x * __builtin_amdgcn_rcpf(1.0f + __builtin_amdgcn_exp2f(-1.4426950408889634f * x)); }
struct EpiSwiglu {
    static constexpr bool PERM = true, AFTER_DRAIN = false;
    bf16_t* O; int ldc;
    __device__ __forceinline__ void operator()(const f32x4 (&acc)[2][2][4][2], const Unit& u, int wr, int wc, int fr, int fq) const {
        const int row0 = u.pm * BM + wr * 64 + fr; const int col0 = u.pn * HALF + wc * 32 + 8 * fq;
#pragma unroll
        for (int ai = 0; ai < 2; ++ai)
#pragma unroll
            for (int m = 0; m < 4; ++m) { bf16_t* rowp = O + (size_t)(row0 + ai * HALF + m * 16) * ldc + col0;
                const f32x4 g0 = acc[ai][0][m][0], g1 = acc[ai][0][m][1], u0 = acc[ai][1][m][0], u1 = acc[ai][1][m][1];
                float r[8];
#pragma unroll
                for (int e = 0; e < 4; ++e) { r[e] = silu_f(g0[e]) * u0[e]; r[4 + e] = silu_f(g1[e]) * u1[e]; }
                u32x4 w; w.x = cvt_pk_bf16(r[0], r[1]); w.y = cvt_pk_bf16(r[2], r[3]); w.z = cvt_pk_bf16(r[4], r[5]); w.w = cvt_pk_bf16(r[6], r[7]);
                *(u32x4*)rowp = w; }
    }
};
struct EpiBf16Ssq {
    static constexpr bool PERM = true, AFTER_DRAIN = false;
    bf16_t* C; int ldc; float* ssq;
    __device__ __forceinline__ void operator()(const f32x4 (&acc)[2][2][4][2], const Unit& u, int wr, int wc, int fr, int fq) const {
        const int row0 = u.pm * BM + wr * 64 + fr, col0 = u.pn * BM + wc * 32 + 8 * fq;
#pragma unroll
        for (int ai = 0; ai < 2; ++ai)
#pragma unroll
            for (int m = 0; m < 4; ++m) { const int row = row0 + ai * HALF + m * 16; bf16_t* rowp = C + (size_t)row * ldc + col0; float s = 0.f;
#pragma unroll
                for (int bj = 0; bj < 2; ++bj) { const f32x4 v0 = acc[ai][bj][m][0], v1 = acc[ai][bj][m][1];
                    s += ((v0[0] * v0[0] + v0[1] * v0[1]) + (v0[2] * v0[2] + v0[3] * v0[3])) + ((v1[0] * v1[0] + v1[1] * v1[1]) + (v1[2] * v1[2] + v1[3] * v1[3]));
                    u32x4 w; w.x = cvt_pk_bf16(v0[0], v0[1]); w.y = cvt_pk_bf16(v0[2], v0[3]); w.z = cvt_pk_bf16(v1[0], v1[1]); w.w = cvt_pk_bf16(v1[2], v1[3]);
                    *(u32x4*)(rowp + bj * HALF) = w; }
                s += __shfl_xor(s, 16); s += __shfl_xor(s, 32);
                if (fq == 0) ssq[row * 32 + u.pn * 4 + wc] = s; }
    }
};

template <class Epi, class Sched, bool ALIGN_EPI = false, bool SP2 = false>
__device__ __forceinline__ void gemm_phase(PG8_LAS unsigned char* lds, const Gemm g, const Sched& S, const Epi& E) {
    const int tid = threadIdx.x, wid = __builtin_amdgcn_readfirstlane(tid >> 6), lane = tid & 63, wr = wid >> 2, wc = wid & 3, fr = lane & 15, fq = lane >> 4;
    const int K = g.K, nt = K / BK;
    unsigned voffA[2], voffB[2];
#pragma unroll
    for (int i = 0; i < 2; ++i) { int R, C; stage_rc(tid * 16 + i * 8192, R, C); const int Rb = Epi::PERM ? ((R & ~31) + perm32(R & 31)) : R;
        voffA[i] = (unsigned)(R * K + C) * 2u; voffB[i] = (unsigned)(Rb * K + C) * 2u; }
    const size_t kstep = (size_t)(BK * 2);
    const size_t hstep = (size_t)HALF * K * 2;
    const size_t tstep = 2 * hstep;
    const unsigned ldsw = (unsigned)wid * 1024u;
    const int aoff = lds_byte(wr * 64 + fr, fq * 8), boff = lds_byte(wc * 32 + fr, fq * 8);
#define PG8_SA(b, h) (((b) * 2 + (h)) * HTB)
#define PG8_SB(b, h) ((4 + (b) * 2 + (h)) * HTB)
#define PG8_STAGE(bufoff, gbase, voff) do { _Pragma("unroll") for (int _i = 0; _i < 2; ++_i) \
        __builtin_amdgcn_global_load_lds((const unsigned*)((const char*)(gbase) + (voff)[_i]), (PG8_LAS unsigned*)(lds + (bufoff) + ldsw + _i * 8192), 16, 0, 0); } while (0)
#define PG8_LDA(dst, b, h) do { _Pragma("unroll") for (int m = 0; m < 4; ++m) _Pragma("unroll") for (int k = 0; k < 2; ++k) dst[m][k] = *(const PG8_LAS bf16x8*)(lds + PG8_SA(b, h) + aoff + m * 2048 + k * 1024); } while (0)
#define PG8_LDB(dst, b, h) do { _Pragma("unroll") for (int n = 0; n < 2; ++n) _Pragma("unroll") for (int k = 0; k < 2; ++k) dst[n][k] = *(const PG8_LAS bf16x8*)(lds + PG8_SB(b, h) + boff + n * 2048 + k * 1024); } while (0)
#define PG8_MMA(ai, bj, At, Bt) do { __builtin_amdgcn_s_setprio(1); _Pragma("unroll") for (int m = 0; m < 4; ++m) _Pragma("unroll") for (int n = 0; n < 2; ++n) _Pragma("unroll") for (int k = 0; k < 2; ++k) \
        acc[ai][bj][m][n] = __builtin_amdgcn_mfma_f32_16x16x32_bf16(Bt[n][k], At[m][k], acc[ai][bj][m][n], 0, 0, 0); __builtin_amdgcn_s_setprio(0); } while (0)
#define PG8_WAIT_V(n) asm volatile("s_waitcnt vmcnt(" #n ")" ::: "memory")
#define PG8_WAIT_L(n) asm volatile("s_waitcnt lgkmcnt(" #n ")" ::: "memory")
#define PG8_BAR __builtin_amdgcn_s_barrier()
#define PG8_SCHED __builtin_amdgcn_sched_barrier(0)
    Unit cur, nxt; int ui = 0;
    if (!S.next(0, cur)) return;
    f32x4 acc[2][2][4][2];
#pragma unroll
    for (int a = 0; a < 2; ++a)
#pragma unroll
        for (int b = 0; b < 2; ++b)
#pragma unroll
            for (int m = 0; m < 4; ++m)
#pragma unroll
                for (int n = 0; n < 2; ++n) acc[a][b][m][n] = (f32x4){0.f, 0.f, 0.f, 0.f};
    bf16x8 At[4][2], B0[2][2], B1[2][2];
    const char* cA = (const char*)g.A + (size_t)cur.pm * tstep; const char* cB = (const char*)g.Bt + (size_t)cur.pn * tstep;
    S.a_ready(cur);
    if constexpr (SP2) {
        PG8_STAGE(PG8_SB(0, 0), cB, voffB); PG8_STAGE(PG8_SB(0, 1), cB + hstep, voffB); PG8_STAGE(PG8_SA(0, 0), cA, voffA); PG8_STAGE(PG8_SA(0, 1), cA + hstep, voffA);
        if (wr == 1) PG8_BAR;
        PG8_WAIT_V(2); PG8_BAR;
        PG8_STAGE(PG8_SB(1, 0), cB + kstep, voffB); PG8_STAGE(PG8_SA(1, 0), cA + kstep, voffA); PG8_STAGE(PG8_SB(1, 1), cB + hstep + kstep, voffB);
        PG8_WAIT_V(6); PG8_BAR;
    } else {
        PG8_STAGE(PG8_SB(0, 0), cB, voffB); PG8_STAGE(PG8_SA(0, 0), cA, voffA); PG8_STAGE(PG8_SB(0, 1), cB + hstep, voffB); PG8_STAGE(PG8_SA(0, 1), cA + hstep, voffA);
        if (wr == 1) PG8_BAR;
        PG8_WAIT_V(4); PG8_BAR;
        PG8_STAGE(PG8_SB(1, 0), cB + kstep, voffB); PG8_STAGE(PG8_SA(1, 0), cA + kstep, voffA); PG8_STAGE(PG8_SB(1, 1), cB + hstep + kstep, voffB);
        PG8_WAIT_V(6); PG8_BAR;
    }
    for (;;) {
        const bool has_next = S.next(ui + 1, nxt);
        const char* nA = has_next ? (const char*)g.A + (size_t)nxt.pm * tstep : cA; const char* nB = has_next ? (const char*)g.Bt + (size_t)nxt.pn * tstep : cB;
        for (int t = 0; t < nt; t += 2) {
            const bool last = (t == nt - 2);
            const char* a1 = cA + (size_t)(t + 1) * kstep;
            const char* a2 = last ? nA : cA + (size_t)(t + 2) * kstep; const char* b2 = last ? nB : cB + (size_t)(t + 2) * kstep;
            const char* a3 = a2 + kstep; const char* b3 = b2 + kstep;
            if (last && has_next) S.a_ready(nxt);
            if constexpr (SP2) {
            PG8_LDB(B0, 0, 0); PG8_LDB(B1, 0, 1); PG8_SCHED; PG8_LDA(At, 0, 0); PG8_STAGE(PG8_SA(1, 1), a1 + hstep, voffA);
            PG8_WAIT_V(8); PG8_WAIT_L(0); PG8_BAR; PG8_MMA(0, 0, At, B0); PG8_MMA(0, 1, At, B1); PG8_BAR; PG8_SCHED;
            PG8_LDA(At, 0, 1); PG8_STAGE(PG8_SB(0, 0), b2, voffB); PG8_STAGE(PG8_SB(0, 1), b2 + hstep, voffB); PG8_STAGE(PG8_SA(0, 0), a2, voffA);
            PG8_WAIT_V(8); PG8_WAIT_L(0); PG8_BAR; PG8_MMA(1, 0, At, B0); PG8_MMA(1, 1, At, B1); PG8_BAR; PG8_SCHED;
            PG8_LDB(B0, 1, 0); PG8_LDB(B1, 1, 1); PG8_SCHED; PG8_LDA(At, 1, 0); PG8_STAGE(PG8_SA(0, 1), a2 + hstep, voffA);
            PG8_WAIT_V(8); PG8_WAIT_L(0); PG8_BAR; PG8_MMA(0, 0, At, B0); PG8_MMA(0, 1, At, B1); PG8_BAR; PG8_SCHED;
            PG8_LDA(At, 1, 1); PG8_STAGE(PG8_SB(1, 0), b3, voffB); PG8_STAGE(PG8_SB(1, 1), b3 + hstep, voffB); PG8_STAGE(PG8_SA(1, 0), a3, voffA);
            PG8_WAIT_V(8); PG8_WAIT_L(0); PG8_BAR; PG8_MMA(1, 0, At, B0); PG8_MMA(1, 1, At, B1); PG8_BAR; PG8_SCHED;
            } else {
            PG8_LDB(B0, 0, 0); PG8_SCHED; PG8_LDA(At, 0, 0); PG8_STAGE(PG8_SA(1, 1), a1 + hstep, voffA);
            PG8_WAIT_L(8); PG8_BAR; PG8_WAIT_L(0); PG8_MMA(0, 0, At, B0); PG8_BAR; PG8_SCHED;
            PG8_LDB(B1, 0, 1); PG8_STAGE(PG8_SB(0, 0), b2, voffB);
            PG8_BAR; PG8_WAIT_L(0); PG8_MMA(0, 1, At, B1); PG8_BAR;
            PG8_LDA(At, 0, 1); PG8_STAGE(PG8_SA(0, 0), a2, voffA);
            PG8_BAR; PG8_WAIT_L(0); PG8_MMA(1, 0, At, B0); PG8_BAR; PG8_SCHED;
            PG8_STAGE(PG8_SB(0, 1), b2 + hstep, voffB);
            PG8_WAIT_V(6); PG8_BAR; PG8_MMA(1, 1, At, B1); PG8_BAR;
            PG8_LDB(B0, 1, 0); PG8_SCHED; PG8_LDA(At, 1, 0); PG8_STAGE(PG8_SA(0, 1), a2 + hstep, voffA);
            PG8_WAIT_L(8); PG8_BAR; PG8_WAIT_L(0); PG8_MMA(0, 0, At, B0); PG8_BAR; PG8_SCHED;
            PG8_LDB(B1, 1, 1); PG8_STAGE(PG8_SB(1, 0), b3, voffB);
            PG8_BAR; PG8_WAIT_L(0); PG8_MMA(0, 1, At, B1); PG8_BAR;
            PG8_LDA(At, 1, 1); PG8_STAGE(PG8_SA(1, 0), a3, voffA);
            PG8_BAR; PG8_WAIT_L(0); PG8_MMA(1, 0, At, B0); PG8_BAR; PG8_SCHED;
            PG8_STAGE(PG8_SB(1, 1), b3 + hstep, voffB);
            PG8_WAIT_V(6); PG8_BAR; PG8_MMA(1, 1, At, B1); PG8_BAR;
            }
        }
        if constexpr (ALIGN_EPI) { if (wr == 0) PG8_BAR; }
        if constexpr (!Epi::AFTER_DRAIN) { E(acc, cur, wr, wc, fr, fq); S.done(cur); }
        if (!has_next) break;
#pragma unroll
        for (int a = 0; a < 2; ++a)
#pragma unroll
            for (int b = 0; b < 2; ++b)
#pragma unroll
                for (int m = 0; m < 4; ++m)
#pragma unroll
                    for (int n = 0; n < 2; ++n) acc[a][b][m][n] = (f32x4){0.f, 0.f, 0.f, 0.f};
        cur = nxt; cA = nA; cB = nB; ++ui;
        if constexpr (ALIGN_EPI) { if (wr == 1) PG8_BAR; }
    }
    PG8_WAIT_V(0);
    if constexpr (!ALIGN_EPI) { if (wr == 0) PG8_BAR; }
    PG8_BAR;
#undef PG8_SA
#undef PG8_SB
#undef PG8_STAGE
#undef PG8_LDA
#undef PG8_LDB
#undef PG8_MMA
#undef PG8_WAIT_V
#undef PG8_WAIT_L
#undef PG8_BAR
#undef PG8_SCHED
}
}

#ifndef REP_P0
#define REP_P0 1
#endif
#ifndef REP_P1
#define REP_P1 1
#endif
#ifndef REP_P2
#define REP_P2 1
#endif
#ifndef REP_P3
#define REP_P3 1
#endif
#ifndef REP_P4
#define REP_P4 1
#endif
#ifndef REP_HG
#define REP_HG 1
#endif
#ifndef REP_AT
#define REP_AT 1
#endif
#ifndef REP_P6
#define REP_P6 1
#endif
#ifndef REP_P7
#define REP_P7 1
#endif
#ifndef PROBE_MULT
#define PROBE_MULT 8
#endif
#ifndef PG8_SP2
#define PG8_SP2 true
#endif
#ifndef PG8_ALIGN
#define PG8_ALIGN true
#endif

constexpr int NWAVES = 8;
constexpr int N_LAUNCHES = MK_N_LAUNCHES;
constexpr int PER_PHASE = 12;

constexpr int BATCH = 4, SEQ = 2048, D = 2048, FF = 5632, NGU = 2 * FF, NIN = 6656;
constexpr int M = BATCH * SEQ;
constexpr int HW = 1024, HH = 8, HD = 128;
constexpr int AH = 8, AKV = 2;
constexpr int CQH = 0, CIH = 1024, CFF = 2048, CFB = 3072, CGH = 4096, CQA = 5120, CKA = 6144, CVA = 6400;
constexpr float EPS = 1e-6f;

constexpr size_t MiB = 1u << 20;
constexpr size_t WS_CTL = 0, CTL_ZERO_BYTES = 32768;
constexpr size_t WS_W1GU = 2 * MiB, WS_W1D = 46 * MiB, WS_WIN = 68 * MiB, WS_WOUT = 94 * MiB, WS_W2GU = 102 * MiB, WS_W2D = 146 * MiB;
constexpr size_t WS_H = 168 * MiB;
constexpr size_t WS_ACT = 200 * MiB;
constexpr size_t WS_FF = 304 * MiB;
constexpr size_t WS_END = 368 * MiB;
constexpr int CW_BAR = 4096;
constexpr size_t WS_SSQ = 1 * MiB;

constexpr int RING_OFF = 0, RING_BYTES = 131072;
constexpr int LDSCTL_OFF = RING_BYTES, MISC_OFF = LDSCTL_OFF + 320;
constexpr int LDS_BYTES = 147456;

#define GAS __attribute__((address_space(1)))
#define LAS __attribute__((address_space(3)))
typedef unsigned short bf16;
typedef unsigned v4u __attribute__((ext_vector_type(4)));
typedef unsigned v2u __attribute__((ext_vector_type(2)));
typedef float f32x4 __attribute__((ext_vector_type(4)));
typedef short bf16x8 __attribute__((ext_vector_type(8)));
typedef short bf16x4 __attribute__((ext_vector_type(4)));
typedef GAS unsigned gu32;
#define RLX_AGENT __ATOMIC_RELAXED, __HIP_MEMORY_SCOPE_AGENT
#define LDS_WAIT() asm volatile("s_waitcnt lgkmcnt(0)" ::: "memory")
#define VM_WAIT() asm volatile("s_waitcnt vmcnt(0)" ::: "memory")
__device__ __forceinline__ unsigned f2bf(float f) { unsigned u = __builtin_bit_cast(unsigned, f); return (u + 0x7fffu + ((u >> 16) & 1u)) >> 16; }
__device__ __forceinline__ unsigned pk2(float lo, float hi) { return pg8::cvt_pk_bf16(lo, hi); }
__device__ __forceinline__ float bf_lo(unsigned u) { return __builtin_bit_cast(float, u << 16); }
__device__ __forceinline__ float bf_hi(unsigned u) { return __builtin_bit_cast(float, u & 0xffff0000u); }

#define XB_TMO      128
#define XB_XCNT(j)  (256  + 64 * (j))
#define XB_XSUB(j)  (1280 + 64 * (j))
#define XB_XGEN(j)  (2304 + 64 * (j))
#define XB_TOP      3328
#define XB_TOPGEN   3392
#define XCD_BAR_WORDS 3456
#define XB_SPIN_CAP (1u << 20)

__device__ __forceinline__ unsigned xb_ld(unsigned* p)              { return __hip_atomic_load(p, __ATOMIC_RELAXED, __HIP_MEMORY_SCOPE_AGENT); }
__device__ __forceinline__ unsigned xb_add(unsigned* p, unsigned v) { return __hip_atomic_fetch_add(p, v, __ATOMIC_RELAXED, __HIP_MEMORY_SCOPE_AGENT); }
__device__ __forceinline__ unsigned xb_xcc_id() { return (unsigned)__builtin_amdgcn_s_getreg((3 << 11) | 20) & 0xFu; }
#define XB_SPIN(cond, bar) do { unsigned _sp = 0; while (cond) { __builtin_amdgcn_s_sleep(1); \
    if ((++_sp & 255u) == 0u) { if (xb_ld(&(bar)[XB_TMO])) break; if (_sp > XB_SPIN_CAP) { atomicAdd(&(bar)[XB_TMO], 1u); break; } } } } while (0)

struct XcdBarrier { unsigned* bar; unsigned x; volatile LAS unsigned* st; };

__device__ __forceinline__ XcdBarrier xcd_barrier_post(unsigned* bar, volatile LAS unsigned* st) {
    XcdBarrier b; b.bar = bar; b.x = xb_xcc_id(); b.st = st;
    if (threadIdx.x == 0) (void)xb_add(&bar[XB_XCNT(b.x)], 1u);
    return b;
}
__device__ __forceinline__ void xcd_barrier_complete(unsigned* bar, unsigned x, unsigned& nloc, unsigned& nx) {
    const unsigned G = gridDim.x * gridDim.y * gridDim.z;
    unsigned sum, cnt, mine, sp = 0u;
    for (;;) {
        sum = 0u; cnt = 0u; mine = 0u;
#pragma unroll
        for (unsigned j = 0; j < 16; ++j) { const unsigned c = xb_ld(&bar[XB_XCNT(j)]); sum += c; cnt += (c > 0u) ? 1u : 0u; mine = (j == x) ? c : mine; }
        if (sum == G) break;
        __builtin_amdgcn_s_sleep(1);
        if ((++sp & 255u) == 0u) { if (xb_ld(&bar[XB_TMO])) break; if (sp > XB_SPIN_CAP) { atomicAdd(&bar[XB_TMO], 1u); break; } }
    }
    nloc = mine > 0u ? mine : 1u; nx = cnt > 0u ? cnt : 1u;
}
__device__ __forceinline__ void xcd_barrier(const XcdBarrier& b) {
    asm volatile("s_waitcnt vmcnt(0)" ::: "memory");
    __syncthreads();
    if (threadIdx.x == 0) {
        unsigned* bar = b.bar;
        __builtin_amdgcn_s_waitcnt(0);
        unsigned nloc = b.st[0], nx = b.st[1];
        if (nloc == 0u) { xcd_barrier_complete(bar, b.x, nloc, nx); b.st[0] = nloc; b.st[1] = nx; }
        const unsigned old = xb_add(&bar[XB_XSUB(b.x)], 1u);
        const unsigned gen = old / nloc;
        if (old + 1u == (gen + 1u) * nloc) {
            __builtin_amdgcn_fence(__ATOMIC_RELEASE, "agent");
            asm volatile("s_waitcnt vmcnt(0)" ::: "memory");
            const unsigned og = xb_add(&bar[XB_TOP], 1u);
            const unsigned tg = og / nx;
            if (og + 1u == (tg + 1u) * nx) xb_add(&bar[XB_TOPGEN], 1u);
            else XB_SPIN(xb_ld(&bar[XB_TOPGEN]) == tg, bar);
            __builtin_amdgcn_fence(__ATOMIC_ACQUIRE, "agent");
            xb_add(&bar[XB_XGEN(b.x)], 1u);
            asm volatile("s_waitcnt vmcnt(0)" ::: "memory");
        } else {
            XB_SPIN(xb_ld(&bar[XB_XGEN(b.x)]) == gen, bar);
            __builtin_amdgcn_fence(__ATOMIC_ACQUIRE, "agent");
            asm volatile("s_waitcnt vmcnt(0)" ::: "memory");
        }
    }
    __syncthreads();
}

struct Frame {
    LAS unsigned char* lds;
    volatile LAS unsigned* MISC;
    gu32* ctl;
    int tid, lane, wave;
    int vcu, G;
    const float* x; float* out;
    const float *pre1, *post1, *w1gu, *w1d, *prem, *postm, *win, *lbf, *lbb, *ognorm, *sink, *wout, *pre2, *post2, *w2gu, *w2d, *relb;
    bf16 *W1GU, *W1D, *WIN, *WOUT, *W2GU, *W2D;
    bf16 *H, *ACT, *FFB, *XR; float* SLB; float* ssq;
};

__device__ __forceinline__ float wave_sum(float v) {
#pragma unroll
    for (int o = 1; o < 64; o <<= 1) v += __shfl_xor(v, o);
    return v;
}
struct CvItem { const float* src; bf16* dst; int K, N; };
__device__ __forceinline__ CvItem cv_item(const float* W, int K, int N, bf16* WT, bool gu, int item) {
    const int nblk = N / 32, kb = item / nblk, nb = item % nblk, k0 = 64 * kb, n0 = 32 * nb;
    int r0 = n0;
    if (gu) { const int half = N / 2; const int nn = n0 < half ? n0 : n0 - half; r0 = 256 * (nn / 128) + (nn % 128) + (n0 < half ? 0 : 128); }
    CvItem c; c.src = W + (size_t)k0 * N + n0; c.dst = WT + (size_t)r0 * K + k0; c.K = K; c.N = N; return c;
}
constexpr int I_GU = (D / 64) * (NGU / 32), I_DN = (FF / 64) * (D / 32), I_IN = (D / 64) * (NIN / 32), I_OUT = (D / 64) * (D / 32);
template <int LIST>
__device__ __forceinline__ CvItem cv_list_item(Frame& F, int r) {
    if (LIST == 0) return cv_item(F.w1gu, D, NGU, F.W1GU, true, r);
    if (LIST == 1) { if (r < I_DN) return cv_item(F.w1d, FF, D, F.W1D, false, r); r -= I_DN; if (r < I_IN) return cv_item(F.win, D, NIN, F.WIN, false, r); r -= I_IN; return cv_item(F.wout, D, D, F.WOUT, false, r); }
    if (LIST == 2) return cv_item(F.w2gu, D, NGU, F.W2GU, true, r);
    return cv_item(F.w2d, FF, D, F.W2D, false, r);
}
template <int LIST>
__device__ __forceinline__ void convert_list(Frame& F, int worker, int nworkers) {
    LAS float* scr = (LAS float*)(F.lds + RING_OFF + F.wave * 16384);
    constexpr int NITEMS = LIST == 0 ? I_GU : (LIST == 1 ? I_DN + I_IN + I_OUT : (LIST == 2 ? I_GU : I_DN));
    const int lane = F.lane;
    int it = worker; if (it >= NITEMS) return;
    CvItem cur = cv_list_item<LIST>(F, it);
    float r[32];
#pragma unroll
    for (int i = 0; i < 32; ++i) r[i] = __builtin_nontemporal_load(cur.src + (size_t)(2 * i + (lane >> 5)) * cur.N + (lane & 31));
    for (;;) {
#pragma unroll
        for (int i = 0; i < 32; ++i) scr[(2 * i + (lane >> 5)) * 33 + (lane & 31)] = r[i];
        const int nxt = it + nworkers; const bool has = nxt < NITEMS; CvItem nd = cur;
        if (has) { nd = cv_list_item<LIST>(F, nxt);
#pragma unroll
            for (int i = 0; i < 32; ++i) r[i] = __builtin_nontemporal_load(nd.src + (size_t)(2 * i + (lane >> 5)) * nd.N + (lane & 31)); }
        LDS_WAIT(); asm volatile("" ::: "memory");
        const int c = lane & 7;
#pragma unroll
        for (int j = 0; j < 4; ++j) { const int n = (lane >> 3) + 8 * j; const LAS float* sp = scr + (8 * c) * 33 + n;
            v4u o; o.x = pk2(sp[0 * 33], sp[1 * 33]); o.y = pk2(sp[2 * 33], sp[3 * 33]); o.z = pk2(sp[4 * 33], sp[5 * 33]); o.w = pk2(sp[6 * 33], sp[7 * 33]);
            *(GAS v4u*)(cur.dst + (size_t)n * cur.K + 8 * c) = o; }
        LDS_WAIT(); asm volatile("" ::: "memory");
        if (!has) break;
        cur = nd; it = nxt;
    }
}
__device__ __forceinline__ void rms_rows_to_bf16(int lane, const float* x, const float* gain, bf16* out, int first, int stride) {
    if (first >= M) return;
    f32x4 v[8];
#pragma unroll
    for (int j = 0; j < 8; ++j) v[j] = __builtin_nontemporal_load((const GAS f32x4*)(x + (size_t)first * D + 8 * (lane + 64 * (j >> 1)) + 4 * (j & 1)));
    for (int m = first; m < M; m += stride) {
        f32x4 c[8]; float s = 0.f;
#pragma unroll
        for (int j = 0; j < 8; ++j) { c[j] = v[j]; s += (c[j].x * c[j].x + c[j].y * c[j].y) + (c[j].z * c[j].z + c[j].w * c[j].w); }
        if (m + stride < M) {
#pragma unroll
            for (int j = 0; j < 8; ++j) v[j] = __builtin_nontemporal_load((const GAS f32x4*)(x + (size_t)(m + stride) * D + 8 * (lane + 64 * (j >> 1)) + 4 * (j & 1))); }
        const float rs = 1.0f / sqrtf(wave_sum(s) * (1.f / D) + EPS);
#pragma unroll
        for (int j = 0; j < 4; ++j) { const f32x4 g0 = *(const GAS f32x4*)(gain + 8 * (lane + 64 * j)), g1 = *(const GAS f32x4*)(gain + 8 * (lane + 64 * j) + 4); const f32x4 c0 = c[2 * j], c1 = c[2 * j + 1];
            v4u o; o.x = pk2(c0.x * rs * g0.x, c0.y * rs * g0.y); o.y = pk2(c0.z * rs * g0.z, c0.w * rs * g0.w); o.z = pk2(c1.x * rs * g1.x, c1.y * rs * g1.y); o.w = pk2(c1.z * rs * g1.z, c1.w * rs * g1.w);
            *(GAS v4u*)(out + (size_t)m * D + 8 * (lane + 64 * j)) = o; }
    }
}
__device__ __forceinline__ void p0_prologue(Frame& F) {
    const int gw = F.vcu * NWAVES + F.wave, NGW = F.G * NWAVES;
    convert_list<0>(F, gw, NGW);
    rms_rows_to_bf16(F.lane, F.x, F.pre1, F.H, gw, NGW);
}
__device__ __forceinline__ void unpack8(const v4u t, float (&o)[8]) { o[0] = bf_lo(t.x); o[1] = bf_hi(t.x); o[2] = bf_lo(t.y); o[3] = bf_hi(t.y); o[4] = bf_lo(t.z); o[5] = bf_hi(t.z); o[6] = bf_lo(t.w); o[7] = bf_hi(t.w); }
template <bool XIN_F32, bool XOUT_F32>
__device__ __forceinline__ void ew_phase(Frame& F, const void* xi, const bf16* ff, const float* ssq, const float* post, float coef, void* xo, const float* pre, bf16* h) {
    const int gw = F.vcu * NWAVES + F.wave, NGW = F.G * NWAVES, lane = F.lane;
    for (int m = gw; m < M; m += NGW) {
        const float part = (lane < 32) ? ssq[m * 32 + lane] : 0.f;
        const float rs = coef / sqrtf(wave_sum(part) * (1.f / D) + EPS);
        float v[4][8]; float s = 0.f;
#pragma unroll
        for (int j = 0; j < 4; ++j) { const size_t e0 = (size_t)m * D + 8 * (lane + 64 * j); float a[8], b[8];
            if (XIN_F32) { const f32x4 a0 = __builtin_nontemporal_load((const GAS f32x4*)((const float*)xi + e0)), a1 = __builtin_nontemporal_load((const GAS f32x4*)((const float*)xi + e0 + 4));
                a[0] = a0.x; a[1] = a0.y; a[2] = a0.z; a[3] = a0.w; a[4] = a1.x; a[5] = a1.y; a[6] = a1.z; a[7] = a1.w; }
            else unpack8(__builtin_nontemporal_load((const GAS v4u*)((const bf16*)xi + e0)), a);
            unpack8(__builtin_nontemporal_load((const GAS v4u*)(ff + e0)), b);
            const f32x4 g0 = *(const GAS f32x4*)(post + 8 * (lane + 64 * j)), g1 = *(const GAS f32x4*)(post + 8 * (lane + 64 * j) + 4);
            const float gg[8] = {g0.x, g0.y, g0.z, g0.w, g1.x, g1.y, g1.z, g1.w};
#pragma unroll
            for (int e = 0; e < 8; ++e) v[j][e] = a[e] + b[e] * gg[e] * rs;
            if (XOUT_F32) { __builtin_nontemporal_store((f32x4){v[j][0], v[j][1], v[j][2], v[j][3]}, (GAS f32x4*)((float*)xo + e0)); __builtin_nontemporal_store((f32x4){v[j][4], v[j][5], v[j][6], v[j][7]}, (GAS f32x4*)((float*)xo + e0 + 4)); }
            else { v4u o; o.x = pk2(v[j][0], v[j][1]); o.y = pk2(v[j][2], v[j][3]); o.z = pk2(v[j][4], v[j][5]); o.w = pk2(v[j][6], v[j][7]);
                   __builtin_nontemporal_store(o, (GAS v4u*)((bf16*)xo + e0)); unpack8(o, v[j]); }
#pragma unroll
            for (int e = 0; e < 8; ++e) s += v[j][e] * v[j][e]; }
        if (h) {
            const float r2 = 1.0f / sqrtf(wave_sum(s) * (1.f / D) + EPS);
#pragma unroll
            for (int j = 0; j < 4; ++j) { const f32x4 g0 = *(const GAS f32x4*)(pre + 8 * (lane + 64 * j)), g1 = *(const GAS f32x4*)(pre + 8 * (lane + 64 * j) + 4);
                v4u o; o.x = pk2(v[j][0] * r2 * g0.x, v[j][1] * r2 * g0.y); o.y = pk2(v[j][2] * r2 * g0.z, v[j][3] * r2 * g0.w); o.z = pk2(v[j][4] * r2 * g1.x, v[j][5] * r2 * g1.y); o.w = pk2(v[j][6] * r2 * g1.z, v[j][7] * r2 * g1.w);
                *(GAS v4u*)(h + (size_t)m * D + 8 * (lane + 64 * j)) = o; }
        }
    }
}

__device__ __forceinline__ bf16x8 ldsfrag(LAS unsigned char* base, int row, int stride, int kbyte) { return *(const LAS bf16x8*)(base + row * stride + kbyte); }
constexpr int H2_QD = 0, H2_KD = 17408, H2_KT0 = 34816, H2_KT1 = 53248, H2_VT0 = 71680, H2_VT1 = 90112, H2_PS = 108544, H2_DEC0 = 117760, H2_DEC1 = 118272, H2_RED = 118784, H2_LB = 126976, H2_END = 127488;
static_assert(H2_END <= RING_BYTES, "HGRN LDS map");
static_assert((CW_BAR + 3456) * 4 <= (int)CTL_ZERO_BYTES, "barrier words inside the memset region");
__device__ __forceinline__ void wave_scan_mul8(float (&v)[8]) {
#define SCAN_ROUND(ctrl) \
    "v_mul_f32_dpp %0, %0, %0 " ctrl "\n\tv_mul_f32_dpp %1, %1, %1 " ctrl "\n\tv_mul_f32_dpp %2, %2, %2 " ctrl "\n\tv_mul_f32_dpp %3, %3, %3 " ctrl "\n\t" \
    "v_mul_f32_dpp %4, %4, %4 " ctrl "\n\tv_mul_f32_dpp %5, %5, %5 " ctrl "\n\tv_mul_f32_dpp %6, %6, %6 " ctrl "\n\tv_mul_f32_dpp %7, %7, %7 " ctrl "\n\t"
    asm volatile("s_nop 1\n\t"
        SCAN_ROUND("row_shr:1 row_mask:0xf bank_mask:0xf") SCAN_ROUND("row_shr:2 row_mask:0xf bank_mask:0xf") SCAN_ROUND("row_shr:4 row_mask:0xf bank_mask:0xf")
        SCAN_ROUND("row_shr:8 row_mask:0xf bank_mask:0xf") SCAN_ROUND("row_bcast:15 row_mask:0xa bank_mask:0xf") SCAN_ROUND("row_bcast:31 row_mask:0xc bank_mask:0xf")
        "s_nop 1"
        : "+v"(v[0]), "+v"(v[1]), "+v"(v[2]), "+v"(v[3]), "+v"(v[4]), "+v"(v[5]), "+v"(v[6]), "+v"(v[7]));
#undef SCAN_ROUND
}
template <bool FULL>
__device__ __forceinline__ void hg_stage(LAS unsigned char* L, int ktoff, int decoff, int w, int l, bool bwd, const v4u (&zr)[2], const v4u (&qr)[2], float (&el)[16]) {
#pragma unroll
    for (int hh = 0; hh < 2; ++hh) {
        float f[8], kk[8], E[8], lbv[8];
        { const f32x4 l0 = *(const LAS f32x4*)(L + H2_LB + (16 * w + 8 * hh) * 4), l1 = *(const LAS f32x4*)(L + H2_LB + (16 * w + 8 * hh + 4) * 4);
          lbv[0] = l0[0]; lbv[1] = l0[1]; lbv[2] = l0[2]; lbv[3] = l0[3]; lbv[4] = l1[0]; lbv[5] = l1[1]; lbv[6] = l1[2]; lbv[7] = l1[3]; }
#pragma unroll
        for (int i = 0; i < 8; ++i) { const unsigned zw = zr[hh][i >> 1]; const float z = (i & 1) ? bf_hi(zw) : bf_lo(zw);
            const float sig = __builtin_amdgcn_rcpf(1.0f + __builtin_amdgcn_exp2f(-1.4426950408889634f * z)); f[i] = lbv[i] + (1.0f - lbv[i]) * sig; kk[i] = 1.0f - f[i]; }
#pragma unroll
        for (int i = 0; i < 8; ++i) E[i] = f[i];
        wave_scan_mul8(E);
        float qd[8], kd[8], kt[8];
#pragma unroll
        for (int i = 0; i < 8; ++i) { const float last = __builtin_bit_cast(float, __builtin_amdgcn_readlane(__builtin_bit_cast(int, E[i]), 63)); el[8 * hh + i] = last;
            const float rE = __builtin_amdgcn_rcpf(E[i]); const float C = bwd ? last * f[i] * rE : E[i]; const float Cinv = bwd ? __builtin_amdgcn_rcpf(C) : rE;
            kd[i] = kk[i] * Cinv; kt[i] = kd[i] * last;
            if (FULL) { const unsigned qw = qr[hh][i >> 1]; const float q = (i & 1) ? bf_hi(qw) : bf_lo(qw); qd[i] = q * C; } }
        if (FULL) { v4u a;
            a.x = pk2(qd[0], qd[1]); a.y = pk2(qd[2], qd[3]); a.z = pk2(qd[4], qd[5]); a.w = pk2(qd[6], qd[7]);
            *(LAS v4u*)(L + H2_QD + l * 272 + 32 * w + 16 * hh) = a;
            a.x = pk2(kd[0], kd[1]); a.y = pk2(kd[2], kd[3]); a.z = pk2(kd[4], kd[5]); a.w = pk2(kd[6], kd[7]);
            *(LAS v4u*)(L + H2_KD + l * 272 + 32 * w + 16 * hh) = a; }
#pragma unroll
        for (int i = 0; i < 8; i += 2) { const unsigned pw = pk2(kt[i], kt[i + 1]);
            *(LAS unsigned short*)(L + ktoff + (16 * w + 8 * hh + i) * 144 + 2 * l) = (unsigned short)(pw & 0xffffu); *(LAS unsigned short*)(L + ktoff + (16 * w + 8 * hh + i + 1) * 144 + 2 * l) = (unsigned short)(pw >> 16); }
        if (l == 0) {
#pragma unroll
            for (int i = 0; i < 8; ++i) *(LAS float*)(L + decoff + (16 * w + 8 * hh + i) * 4) = el[8 * hh + i];
        }
    }
}
__device__ __forceinline__ void hg_write_lb(LAS unsigned char* L, const float* lbf, const float* lbb, bool bwd, int h, int w, int l) {
    if (l < 16) { const int i0 = h * 128 + 16 * w + l; const float f0 = lbf[i0], f1 = lbf[HW + i0], b0 = lbb[i0], b1 = lbb[HW + i0];
        const float a0 = bwd ? b0 : f0, a1 = bwd ? b1 : f1; *(LAS float*)(L + H2_LB + (16 * w + l) * 4) = 1.0f / (1.0f + __expf(a1 - a0)); }
}
__device__ __forceinline__ void hg_stage_v(LAS unsigned char* L, int vtoff, int w, int l, const v4u (&vr)[2]) {
#pragma unroll
    for (int i = 0; i < 8; ++i) { const unsigned vw = vr[i >> 2][i & 3];
        *(LAS unsigned short*)(L + vtoff + (16 * w + 2 * i) * 144 + 2 * l) = (unsigned short)(vw & 0xffffu); *(LAS unsigned short*)(L + vtoff + (16 * w + 2 * i + 1) * 144 + 2 * l) = (unsigned short)(vw >> 16); }
}
__device__ __forceinline__ void hg_state_update(LAS unsigned char* L, int ktoff, int vtoff, int decoff, int w, int g, int fr, f32x4 (&S)[8]) {
    bf16x8 vf[2];
#pragma unroll
    for (int k2 = 0; k2 < 2; ++k2) vf[k2] = ldsfrag(L + vtoff, 16 * w + fr, 144, 64 * k2 + 16 * g);
#pragma unroll
    for (int kt = 0; kt < 8; ++kt) { const f32x4 d4 = *(const LAS f32x4*)(L + decoff + (16 * kt + 4 * g) * 4); S[kt] = S[kt] * d4;
#pragma unroll
        for (int k2 = 0; k2 < 2; ++k2) S[kt] = __builtin_amdgcn_mfma_f32_16x16x32_bf16(ldsfrag(L + ktoff, 16 * kt + fr, 144, 64 * k2 + 16 * g), vf[k2], S[kt], 0, 0, 0); }
}
__device__ __forceinline__ size_t hg_slot(int dir, int b, int h, int sc) { return (size_t)(((dir * BATCH + b) * HH + h) * 8 + sc); }

struct HgIn { v4u z[2], q[2], v[2]; };
template <bool FULL>
__device__ __forceinline__ void hg_load(HgIn& r, const bf16* P, int b, int h, int w, int l, int cn, bool bwd) {
    const bf16* row = P + (size_t)(b * SEQ + cn * 64 + l) * NIN;
    const int colz = (bwd ? CFB : CFF) + h * 128 + 16 * w, colv = CIH + h * 128 + 16 * w, colq = CQH + h * 128 + 16 * w;
    r.z[0] = *(const GAS v4u*)(row + colz); r.z[1] = *(const GAS v4u*)(row + colz + 8); r.v[0] = *(const GAS v4u*)(row + colv); r.v[1] = *(const GAS v4u*)(row + colv + 8);
    if (FULL) { r.q[0] = *(const GAS v4u*)(row + colq); r.q[1] = *(const GAS v4u*)(row + colq + 8); } else { r.q[0] = r.z[0]; r.q[1] = r.z[1]; }
}
__device__ __forceinline__ void hgrn_pass1(Frame& F, const bf16* P, float* SL, float* DL) {
    LAS unsigned char* L = F.lds + RING_OFF;
    const int w = F.wave, l = F.lane, g = l >> 4, fr = l & 15;
    for (int item = F.vcu; item < 256; item += F.G) { const int b = item >> 6, h = (item >> 3) & 7, sc = item & 7;
        HgIn in; hg_load<false>(in, P, b, h, w, l, sc * 4, false);
        f32x4 S[8]; float dtot[16];
        for (int t = 0; t < 8; ++t) { const bool bwd = t >= 4; const int n = t & 3, buf = t & 1;
            if (n == 0) { hg_write_lb(L, F.lbf, F.lbb, bwd, h, w, l);
#pragma unroll
                for (int kt = 0; kt < 8; ++kt) S[kt] = (f32x4){0.f, 0.f, 0.f, 0.f};
#pragma unroll
                for (int i = 0; i < 16; ++i) dtot[i] = 1.0f; }
            float el[16];
            hg_stage_v(L, buf ? H2_VT1 : H2_VT0, w, l, in.v);
            hg_stage<false>(L, buf ? H2_KT1 : H2_KT0, buf ? H2_DEC1 : H2_DEC0, w, l, bwd, in.z, in.q, el);
            if (t + 1 < 8) { const bool nb = (t + 1) >= 4; const int nn = (t + 1) & 3; hg_load<false>(in, P, b, h, w, l, sc * 4 + (nb ? 3 - nn : nn), nb); }
#pragma unroll
            for (int i = 0; i < 16; ++i) dtot[i] *= el[i];
            __syncthreads();
            hg_state_update(L, buf ? H2_KT1 : H2_KT0, buf ? H2_VT1 : H2_VT0, buf ? H2_DEC1 : H2_DEC0, w, g, fr, S);
            if (n == 3) { const size_t slot = hg_slot(bwd ? 1 : 0, b, h, sc); float* so = SL + slot * 16384;
#pragma unroll
                for (int kt = 0; kt < 8; ++kt) *(GAS f32x4*)(so + (size_t)((kt * 8 + w) * 64 + l) * 4) = S[kt];
                if (l == 0) {
#pragma unroll
                    for (int i = 0; i < 16; ++i) DL[slot * 128 + 16 * w + i] = dtot[i];
                } }
        }
        __syncthreads();
    }
}

__device__ __forceinline__ void hgrn_pass2_compute(LAS unsigned char* L, int w, int g, int fr, bool bwd, int vtoff, f32x4 (&S)[8], f32x4 (&o)[4]) {
    {   const int ct = w >> 1, sh = w & 1;
        bf16x8 qfr[4];
#pragma unroll
        for (int ks = 0; ks < 4; ++ks) qfr[ks] = ldsfrag(L + H2_QD, 16 * ct + fr, 272, 64 * ks + 16 * g);
#pragma unroll
        for (int t2 = 0; t2 < 2; ++t2) { const int st = 2 * sh + t2; f32x4 sc4 = (f32x4){0.f, 0.f, 0.f, 0.f};
#pragma unroll
            for (int ks = 0; ks < 4; ++ks) sc4 = __builtin_amdgcn_mfma_f32_16x16x32_bf16(ldsfrag(L + H2_KD, 16 * st + fr, 272, 64 * ks + 16 * g), qfr[ks], sc4, 0, 0, 0);
            const int c = 16 * ct + fr, s0 = 16 * st + 4 * g;
            float m[4];
#pragma unroll
            for (int r = 0; r < 4; ++r) { const bool keep = bwd ? (s0 + r >= c) : (s0 + r <= c); m[r] = keep ? sc4[r] : 0.f; }
            v2u pw; pw.x = pk2(m[0], m[1]); pw.y = pk2(m[2], m[3]);
            *(LAS v2u*)(L + H2_PS + c * 144 + 2 * s0) = pw; } }
    {   bf16x8 sa[4];
#pragma unroll
        for (int k2 = 0; k2 < 4; ++k2) { v4u t; t.x = pk2(S[2 * k2][0], S[2 * k2][1]); t.y = pk2(S[2 * k2][2], S[2 * k2][3]); t.z = pk2(S[2 * k2 + 1][0], S[2 * k2 + 1][1]); t.w = pk2(S[2 * k2 + 1][2], S[2 * k2 + 1][3]); sa[k2] = __builtin_bit_cast(bf16x8, t); }
#pragma unroll
        for (int ct = 0; ct < 4; ++ct) { const LAS unsigned char* qrow = L + H2_QD + (16 * ct + fr) * 272; o[ct] = (f32x4){0.f, 0.f, 0.f, 0.f};
#pragma unroll
            for (int k2 = 0; k2 < 4; ++k2) { const v2u b0 = *(const LAS v2u*)(qrow + 2 * (32 * k2 + 4 * g)), b1 = *(const LAS v2u*)(qrow + 2 * (32 * k2 + 16 + 4 * g));
                const v4u bv = (v4u){b0.x, b0.y, b1.x, b1.y};
                o[ct] = __builtin_amdgcn_mfma_f32_16x16x32_bf16(sa[k2], __builtin_bit_cast(bf16x8, bv), o[ct], 0, 0, 0); } } }
    hg_state_update(L, H2_KT0, vtoff, H2_DEC0, w, g, fr, S);
    __syncthreads();
    {   bf16x8 vf[2];
#pragma unroll
        for (int k2 = 0; k2 < 2; ++k2) vf[k2] = ldsfrag(L + vtoff, 16 * w + fr, 144, 64 * k2 + 16 * g);
#pragma unroll
        for (int ct = 0; ct < 4; ++ct)
#pragma unroll
            for (int k2 = 0; k2 < 2; ++k2) o[ct] = __builtin_amdgcn_mfma_f32_16x16x32_bf16(vf[k2], ldsfrag(L + H2_PS, 16 * ct + fr, 144, 64 * k2 + 16 * g), o[ct], 0, 0, 0); }
}
__device__ __forceinline__ void hgrn_pass2(Frame& F, const bf16* P, const float* SL, const float* DL, float* OFW, bf16* Y) {
    LAS unsigned char* L = F.lds + RING_OFF;
    const int w = F.wave, l = F.lane, g = l >> 4, fr = l & 15;
    LAS float* RED = (LAS float*)(L + H2_RED);
    for (int item = F.vcu; item < 256; item += F.G) { const int b = item >> 6, h = (item >> 3) & 7, sc = item & 7;
        HgIn in; hg_load<true>(in, P, b, h, w, l, sc * 4, false);
        const f32x4 gn = *(const GAS f32x4*)(F.ognorm + h * 128 + 16 * w + 4 * g);
        f32x4 S[8];
        for (int t = 0; t < 8; ++t) { const bool bwd = t >= 4; const int n = t & 3, j = bwd ? 3 - n : n, dir = bwd ? 1 : 0;
            if (n == 0) {
                if (bwd) { asm volatile("s_waitcnt vmcnt(0)" ::: "memory"); }
                hg_write_lb(L, F.lbf, F.lbb, bwd, h, w, l);
#pragma unroll
                for (int kt = 0; kt < 8; ++kt) S[kt] = (f32x4){0.f, 0.f, 0.f, 0.f};
                const int nf = bwd ? 7 - sc : sc;
                LAS float* DLS = (LAS float*)(L + H2_PS);
                for (int u = F.tid; u < nf * 128; u += NWAVES * 64) { const int tt = u >> 7; const int i = bwd ? 7 - tt : tt; DLS[u] = DL[hg_slot(dir, b, h, i) * 128 + (u & 127)]; }
                __syncthreads();
                int tt = 0;
                for (; tt + 1 < nf; tt += 2) {
                    const int i0 = bwd ? 7 - tt : tt, i1 = bwd ? 6 - tt : tt + 1;
                    const float* sl0 = SL + hg_slot(dir, b, h, i0) * 16384 + (size_t)(w * 64 + l) * 4; const float* sl1 = SL + hg_slot(dir, b, h, i1) * 16384 + (size_t)(w * 64 + l) * 4;
                    f32x4 s4a[8], s4b[8];
#pragma unroll
                    for (int kt = 0; kt < 8; ++kt) { s4a[kt] = *(const GAS f32x4*)(sl0 + (size_t)kt * 8 * 256); s4b[kt] = *(const GAS f32x4*)(sl1 + (size_t)kt * 8 * 256); }
                    asm volatile("" ::: "memory");
#pragma unroll
                    for (int kt = 0; kt < 8; ++kt) { const f32x4 d0 = *(const LAS f32x4*)(DLS + tt * 128 + 16 * kt + 4 * g), d1 = *(const LAS f32x4*)(DLS + (tt + 1) * 128 + 16 * kt + 4 * g);
                        S[kt] = (S[kt] * d0 + s4a[kt]) * d1 + s4b[kt]; } }
                if (tt < nf) { const int i = bwd ? 7 - tt : tt; const float* sl = SL + hg_slot(dir, b, h, i) * 16384 + (size_t)(w * 64 + l) * 4;
                    f32x4 s4[8];
#pragma unroll
                    for (int kt = 0; kt < 8; ++kt) s4[kt] = *(const GAS f32x4*)(sl + (size_t)kt * 8 * 256);
                    asm volatile("" ::: "memory");
#pragma unroll
                    for (int kt = 0; kt < 8; ++kt) { const f32x4 d4 = *(const LAS f32x4*)(DLS + tt * 128 + 16 * kt + 4 * g); S[kt] = S[kt] * d4 + s4[kt]; } }
            }
            const int vtoff = (t & 1) ? H2_VT1 : H2_VT0;
            {   float el[16];
                hg_stage_v(L, vtoff, w, l, in.v);
                hg_stage<true>(L, H2_KT0, H2_DEC0, w, l, bwd, in.z, in.q, el); }
            if (t + 1 < 8) { const bool nb = (t + 1) >= 4; const int nn = (t + 1) & 3; hg_load<true>(in, P, b, h, w, l, sc * 4 + (nb ? 3 - nn : nn), nb); }
            float* ofw = OFW + ((size_t)((item * 4 + j) * 4) * 8 + w) * 256 + (size_t)l * 4;
            f32x4 of[4]; v2u gr[4];
            if (bwd) {
#pragma unroll
                for (int ct = 0; ct < 4; ++ct) { of[ct] = *(const GAS f32x4*)(ofw + (size_t)ct * 8 * 256);
                    gr[ct] = *(const GAS v2u*)(P + (size_t)(b * SEQ + (sc * 4 + j) * 64 + ct * 16 + fr) * NIN + CGH + h * 128 + 16 * w + 4 * g); }
            }
            __syncthreads();
            f32x4 o[4];
            hgrn_pass2_compute(L, w, g, fr, bwd, vtoff, S, o);
            if (!bwd) {
#pragma unroll
                for (int ct = 0; ct < 4; ++ct) *(GAS f32x4*)(ofw + (size_t)ct * 8 * 256) = o[ct];
            } else {
                float ps[4];
#pragma unroll
                for (int ct = 0; ct < 4; ++ct) { o[ct] = o[ct] + of[ct]; const f32x4 v = o[ct];
                    float s2 = (v[0] * v[0] + v[1] * v[1]) + (v[2] * v[2] + v[3] * v[3]); s2 += __shfl_xor(s2, 16); s2 += __shfl_xor(s2, 32); ps[ct] = s2; }
                if (g == 0) {
#pragma unroll
                    for (int ct = 0; ct < 4; ++ct) RED[w * 64 + ct * 16 + fr] = ps[ct];
                }
                __syncthreads();
#pragma unroll
                for (int ct = 0; ct < 4; ++ct) { const int ti = ct * 16 + fr; float tot = 0.f;
#pragma unroll
                    for (int ww = 0; ww < 8; ++ww) tot += RED[ww * 64 + ti];
                    const float rs = 1.0f / sqrtf(tot * (1.f / 128.f) + EPS);
                    const size_t row = (size_t)(b * SEQ + (sc * 4 + j) * 64 + ti);
                    const f32x4 v = o[ct];
                    v2u o2; o2.x = pk2(v[0] * rs * gn[0] * pg8::silu_f(bf_lo(gr[ct].x)), v[1] * rs * gn[1] * pg8::silu_f(bf_hi(gr[ct].x)));
                    o2.y = pk2(v[2] * rs * gn[2] * pg8::silu_f(bf_lo(gr[ct].y)), v[3] * rs * gn[3] * pg8::silu_f(bf_hi(gr[ct].y)));
                    *(GAS v2u*)(Y + row * D + h * 128 + 16 * w + 4 * g) = o2; }
            }
        }
        __syncthreads();
    }
}

constexpr int AT_K = 0, AT_V = 34816, AT_TB = 69632, AT_END = 69632 + 2 * 264 * 4;
__device__ __forceinline__ int t5_bucket(int rel) {
    const int n = rel < 0 ? -rel : rel; int bkt;
    if (n < 8) bkt = n; else { int j = 0; while (j < 7 && 64 * (2 << j) <= n * n) ++j; bkt = 8 + j; }
    return bkt + (rel > 0 ? 16 : 0);
}
struct AtRegs { v4u k[4], v[4]; };
__device__ __forceinline__ void at_load(AtRegs& r, const bf16* P, int b, int kb, int kvh, int tid) {
    const bf16* kvbase = P + (size_t)(b * SEQ + kb * 128) * NIN;
#pragma unroll
    for (int i = 0; i < 4; ++i) { const int id = tid + 512 * i; r.k[i] = *(const GAS v4u*)(kvbase + (size_t)(id >> 4) * NIN + CKA + kvh * 128 + 8 * (id & 15)); }
#pragma unroll
    for (int i = 0; i < 4; ++i) { const int id = tid + 512 * i; r.v[i] = *(const GAS v4u*)(kvbase + (size_t)(id & 127) * NIN + CVA + kvh * 128 + 8 * (id >> 7)); }
}
__device__ __forceinline__ void at_stage(LAS unsigned char* L, const AtRegs& r, int tid) {
#pragma unroll
    for (int i = 0; i < 4; ++i) { const int id = tid + 512 * i; *(LAS v4u*)(L + AT_K + (id >> 4) * 272 + 16 * (id & 15)) = r.k[i]; }
#pragma unroll
    for (int i = 0; i < 4; ++i) { const int id = tid + 512 * i; const int key = id & 127, ch = id >> 7;
#pragma unroll
        for (int e = 0; e < 4; ++e) { *(LAS unsigned short*)(L + AT_V + (8 * ch + 2 * e) * 272 + 2 * key) = (unsigned short)(r.v[i][e] & 0xffffu); *(LAS unsigned short*)(L + AT_V + (8 * ch + 2 * e + 1) * 272 + 2 * key) = (unsigned short)(r.v[i][e] >> 16); } }
}
__device__ __forceinline__ void at_head(LAS unsigned char* L, const LAS float* TB, int relbase, int g, int fr, const bf16x8 (&bq)[4], float& mrun, float& lrun, f32x4 (&ot)[8]) {
    const float scale = 0.08838834764831845f;
    f32x4 st[8];
#pragma unroll
    for (int mt = 0; mt < 8; ++mt) { st[mt] = (f32x4){0.f, 0.f, 0.f, 0.f};
#pragma unroll
        for (int ks = 0; ks < 4; ++ks) st[mt] = __builtin_amdgcn_mfma_f32_16x16x32_bf16(ldsfrag(L + AT_K, 16 * mt + fr, 272, 64 * ks + 16 * g), bq[ks], st[mt], 0, 0, 0); }
    float mx = -3.0e38f;
#pragma unroll
    for (int mt = 0; mt < 8; ++mt)
#pragma unroll
        for (int r = 0; r < 4; ++r) { const int rel = relbase + 16 * mt + r; const bool ok = rel >= -128 && rel <= 128; const int ri = min(max(rel + 128, 0), 256);
            const float tb = TB[ri]; const float s = ok ? st[mt][r] * scale + tb : -1.0e30f; st[mt][r] = s; mx = fmaxf(mx, s); }
    mx = fmaxf(mx, __shfl_xor(mx, 16)); mx = fmaxf(mx, __shfl_xor(mx, 32));
    const float mnew = fmaxf(mrun, mx), alpha = __expf(mrun - mnew); mrun = mnew;
    float ls = 0.f;
#pragma unroll
    for (int mt = 0; mt < 8; ++mt)
#pragma unroll
        for (int r = 0; r < 4; ++r) { const float p = __expf(st[mt][r] - mnew); st[mt][r] = p; ls += p; }
    ls += __shfl_xor(ls, 16); ls += __shfl_xor(ls, 32);
    lrun = lrun * alpha + ls;
#pragma unroll
    for (int dt = 0; dt < 8; ++dt) ot[dt] = ot[dt] * alpha;
#pragma unroll
    for (int k2 = 0; k2 < 4; ++k2) {
        v4u pb; pb.x = pk2(st[2 * k2][0], st[2 * k2][1]); pb.y = pk2(st[2 * k2][2], st[2 * k2][3]); pb.z = pk2(st[2 * k2 + 1][0], st[2 * k2 + 1][1]); pb.w = pk2(st[2 * k2 + 1][2], st[2 * k2 + 1][3]);
        const bf16x8 pfrag = __builtin_bit_cast(bf16x8, pb);
#pragma unroll
        for (int dt = 0; dt < 8; ++dt) { const LAS unsigned char* vrow = L + AT_V + (16 * dt + fr) * 272;
            const v2u a0 = *(const LAS v2u*)(vrow + 2 * (32 * k2 + 4 * g)), a1 = *(const LAS v2u*)(vrow + 2 * (32 * k2 + 16 + 4 * g));
            const v4u av = (v4u){a0.x, a0.y, a1.x, a1.y};
            ot[dt] = __builtin_amdgcn_mfma_f32_16x16x32_bf16(__builtin_bit_cast(bf16x8, av), pfrag, ot[dt], 0, 0, 0); } }
}
__device__ __forceinline__ void attn_item(Frame& F, const bf16* P, bf16* Y, int item) {
    LAS unsigned char* L = F.lds + RING_OFF;
    const int w = F.wave, l = F.lane, g = l >> 4, fr = l & 15, tid = F.tid;
    {
        const int hq = item & 3, blk = (item >> 2) & 15, kvh = (item >> 6) & 1, b = item >> 7, h = kvh * 4 + hq;
        LAS float* TB = (LAS float*)(L + AT_TB);
        if (tid < 257) TB[tid] = F.relb[t5_bucket(tid - 128) * AH + h];
        const int jt0 = blk == 0 ? 1 : 0, jt1 = blk == 15 ? 1 : 2;
        AtRegs R; at_load(R, P, b, blk - 1 + jt0, kvh, tid);
        const int qrow = b * SEQ + blk * 128 + 16 * w + fr;
        bf16x8 bq[4];
#pragma unroll
        for (int ks = 0; ks < 4; ++ks) bq[ks] = *(const GAS bf16x8*)(P + (size_t)qrow * NIN + CQA + h * 128 + 32 * ks + 8 * g);
        float mrun = F.sink[h], lrun = 1.0f;
        f32x4 ot[8];
#pragma unroll
        for (int dt = 0; dt < 8; ++dt) ot[dt] = (f32x4){0.f, 0.f, 0.f, 0.f};
        for (int jt = jt0; jt <= jt1; ++jt) {
            at_stage(L, R, tid);
            __syncthreads();
            if (jt < jt1) at_load(R, P, b, blk + jt, kvh, tid);
            const int relbase = (jt - 1) * 128 + 4 * g - (16 * w + fr);
            at_head(L, TB, relbase, g, fr, bq, mrun, lrun, ot);
            __syncthreads();
        }
        const float inv = 1.0f / lrun;
#pragma unroll
        for (int dt = 0; dt < 8; ++dt) { v2u o2; o2.x = pk2(ot[dt][0] * inv, ot[dt][1] * inv); o2.y = pk2(ot[dt][2] * inv, ot[dt][3] * inv);
            *(GAS v2u*)(Y + (size_t)qrow * D + HW + h * 128 + 16 * dt + 4 * g) = o2; }
        __syncthreads();
    }
}
__device__ __forceinline__ void attn_phase(Frame& F, const bf16* P, bf16* Y) { for (int item = F.vcu; item < 512; item += F.G) attn_item(F, P, Y, item); }
constexpr int CW_GRP = 1024;
__device__ __forceinline__ void hg_group_publish(Frame& F, int grp) {
    asm volatile("s_waitcnt vmcnt(0)" ::: "memory");
    __syncthreads();
    if (F.tid == 0) { __builtin_amdgcn_fence(__ATOMIC_RELEASE, "agent"); asm volatile("s_waitcnt vmcnt(0)" ::: "memory");
        __hip_atomic_fetch_add((unsigned*)(F.ctl + CW_GRP + 64 * grp), 1u, __ATOMIC_RELAXED, __HIP_MEMORY_SCOPE_AGENT); }
}
__device__ __forceinline__ void hg_group_wait(Frame& F, int grp) {
    if (F.tid == 0) { unsigned sp = 0;
        while (__hip_atomic_load((unsigned*)(F.ctl + CW_GRP + 64 * grp), __ATOMIC_RELAXED, __HIP_MEMORY_SCOPE_AGENT) < 8u) { __builtin_amdgcn_s_sleep(2); if (++sp > (1u << 20)) break; }
        __builtin_amdgcn_fence(__ATOMIC_ACQUIRE, "agent"); asm volatile("s_waitcnt vmcnt(0)" ::: "memory"); }
    __syncthreads();
}

struct Args { const float* in[18]; float* out; unsigned char* ws; int ph_lo, ph_hi, li, pad; };
__global__ void __launch_bounds__(NWAVES * 64, 2) hymba_fwd(Args args) {
    extern __shared__ __attribute__((aligned(16))) unsigned char lds[];
    Frame F;
    F.lds = (LAS unsigned char*)lds;
    F.MISC = (volatile LAS unsigned*)(F.lds + MISC_OFF);
    F.tid = threadIdx.x; F.lane = F.tid & 63; F.wave = __builtin_amdgcn_readfirstlane(F.tid >> 6);
    F.G = gridDim.x; { const int bx = blockIdx.x; F.vcu = (F.G % 8 == 0) ? (bx % 8) * (F.G / 8) + bx / 8 : bx; }
    unsigned char* ws = args.ws;
    F.ctl = (gu32*)(ws + WS_CTL);
    F.x = args.in[0]; F.pre1 = args.in[1]; F.post1 = args.in[2]; F.w1gu = args.in[3]; F.w1d = args.in[4]; F.prem = args.in[5]; F.postm = args.in[6]; F.win = args.in[7];
    F.lbf = args.in[8]; F.lbb = args.in[9]; F.ognorm = args.in[10]; F.sink = args.in[11]; F.wout = args.in[12]; F.pre2 = args.in[13]; F.post2 = args.in[14];
    F.w2gu = args.in[15]; F.w2d = args.in[16]; F.relb = args.in[17]; F.out = args.out;
    F.W1GU = (bf16*)(ws + WS_W1GU); F.W1D = (bf16*)(ws + WS_W1D); F.WIN = (bf16*)(ws + WS_WIN); F.WOUT = (bf16*)(ws + WS_WOUT); F.W2GU = (bf16*)(ws + WS_W2GU); F.W2D = (bf16*)(ws + WS_W2D);
    F.H = (bf16*)(ws + WS_H); F.ACT = (bf16*)(ws + WS_ACT); F.FFB = (bf16*)(ws + WS_FF); F.SLB = (float*)(ws + WS_FF); F.XR = (bf16*)(ws + WS_FF + 32 * MiB); F.ssq = (float*)(ws + WS_SSQ);
    for (int u = F.tid; u < (LDS_BYTES - LDSCTL_OFF) / 4; u += NWAVES * 64) ((LAS unsigned*)(F.lds + LDSCTL_OFF))[u] = 0u;
    __syncthreads();
    XcdBarrier bar; bar.bar = (unsigned*)(F.ctl + CW_BAR); bar.x = 0; bar.st = nullptr;
    if (N_LAUNCHES != PER_PHASE) bar = xcd_barrier_post((unsigned*)(F.ctl + CW_BAR), F.MISC + 8);
#define GRID_BAR() do { if (N_LAUNCHES != PER_PHASE) xcd_barrier(bar); } while (0)
    const int lo = args.ph_lo, hi = args.ph_hi;
    unsigned long long pr_t0 = 0, pr_dt = 0;
#ifdef PROBE_PHASE
#define TS(k) do { if ((k) == PROBE_PHASE) pr_t0 = __builtin_amdgcn_s_memrealtime(); } while (0)
#define TE(k) do { if ((k) == PROBE_PHASE) pr_dt = __builtin_amdgcn_s_memrealtime() - pr_t0; } while (0)
#else
#define TS(k) do {} while (0)
#define TE(k) do {} while (0)
#endif
#define IN(k) (lo <= (k) && (k) < hi)
#define BOTH(k) (IN(k) && IN((k) + 1))
    typedef pg8::StaticOrder SO;
    TS(0); if (IN(0)) for (int r_ = 0; r_ < REP_P0; ++r_) { p0_prologue(F); if (BOTH(0)) GRID_BAR(); }
    TE(0);
    TS(1); if (IN(1)) for (int r_ = 0; r_ < REP_P1; ++r_) { pg8::Gemm gm{F.H, F.W1GU, M, NGU, D}; SO S; S.init(M, NGU, F.G, (int)blockIdx.x); pg8::EpiSwiglu E{F.ACT, FF};
        pg8::gemm_phase<pg8::EpiSwiglu, SO, PG8_ALIGN, PG8_SP2>(F.lds + RING_OFF, gm, S, E);
        { const int nfull = (M / 256) * (NGU / 256) % F.G;
          if (nfull != 0 && (int)blockIdx.x >= nfull && r_ == 0) convert_list<1>(F, ((int)blockIdx.x - nfull) * NWAVES + F.wave, (F.G - nfull) * NWAVES);
          else if (nfull == 0 && r_ == 0) convert_list<1>(F, F.vcu * NWAVES + F.wave, F.G * NWAVES); }
        if (BOTH(1)) GRID_BAR(); }
    TE(1);
    TS(2); if (IN(2)) for (int r_ = 0; r_ < REP_P2; ++r_) { pg8::Gemm gm{F.ACT, F.W1D, M, D, FF}; SO S; S.init(M, D, F.G, (int)blockIdx.x); pg8::EpiBf16Ssq E{F.FFB, D, F.ssq};
        pg8::gemm_phase<pg8::EpiBf16Ssq, SO, PG8_ALIGN, PG8_SP2>(F.lds + RING_OFF, gm, S, E); if (BOTH(2)) GRID_BAR(); }
    TE(2);
    TS(3); if (IN(3)) for (int r_ = 0; r_ < REP_P3; ++r_) { ew_phase<true, false>(F, F.x, F.FFB, F.ssq, F.post1, 0.5f, F.XR, F.prem, F.H); if (BOTH(3)) GRID_BAR(); }
    TE(3);
    TS(4); if (IN(4)) for (int r_ = 0; r_ < REP_P4; ++r_) { pg8::Gemm gm{F.H, F.WIN, M, NIN, D}; SO S; S.init(M, NIN, F.G, (int)blockIdx.x); pg8::EpiBf16 E{F.ACT, NIN};
        pg8::gemm_phase<pg8::EpiBf16, SO, PG8_ALIGN, PG8_SP2>(F.lds + RING_OFF, gm, S, E);
        { const int nfull = (M / 256) * (NIN / 256) % F.G;
          if (nfull != 0 && (int)blockIdx.x >= nfull && r_ == 0) convert_list<2>(F, ((int)blockIdx.x - nfull) * NWAVES + F.wave, (F.G - nfull) * NWAVES);
          else if (nfull == 0 && r_ == 0) convert_list<2>(F, F.vcu * NWAVES + F.wave, F.G * NWAVES); }
        if (BOTH(4)) GRID_BAR(); }
    TE(4);
    TS(5); if (IN(5)) {
        if (F.G == 256 && REP_HG == 1 && REP_AT == 1) {
            const int grp = F.vcu >> 3;
            hgrn_pass1(F, F.ACT, F.SLB, F.ssq); hg_group_publish(F, grp);
            attn_item(F, F.ACT, F.H, F.vcu);
            hg_group_wait(F, grp); hgrn_pass2(F, F.ACT, F.SLB, F.ssq, F.out, F.H);
            attn_item(F, F.ACT, F.H, F.vcu + 256);
        } else {
            for (int r_ = 0; r_ < REP_HG; ++r_) hgrn_pass1(F, F.ACT, F.SLB, F.ssq); for (int r_ = 0; r_ < REP_AT; ++r_) attn_phase(F, F.ACT, F.H); GRID_BAR();
            hgrn_pass2(F, F.ACT, F.SLB, F.ssq, F.out, F.H);
        }
        if (BOTH(5)) GRID_BAR(); }
    TE(5);
    TS(6);
    TE(6);
    TS(7); if (IN(7)) for (int r_ = 0; r_ < REP_P7; ++r_) { pg8::Gemm gm{F.H, F.WOUT, M, D, D}; SO S; S.init(M, D, F.G, (int)blockIdx.x); pg8::EpiBf16Ssq E{F.FFB, D, F.ssq};
        pg8::gemm_phase<pg8::EpiBf16Ssq, SO, PG8_ALIGN, PG8_SP2>(F.lds + RING_OFF, gm, S, E); if (BOTH(7)) GRID_BAR(); }
    TE(7);
    TS(8); if (IN(8)) { ew_phase<false, false>(F, F.XR, F.FFB, F.ssq, F.postm, 1.0f, F.XR, F.pre2, F.H); if (BOTH(8)) GRID_BAR(); }
    TE(8);
    TS(9); if (IN(9)) { pg8::Gemm gm{F.H, F.W2GU, M, NGU, D}; SO S; S.init(M, NGU, F.G, (int)blockIdx.x); pg8::EpiSwiglu E{F.ACT, FF};
        pg8::gemm_phase<pg8::EpiSwiglu, SO, PG8_ALIGN, PG8_SP2>(F.lds + RING_OFF, gm, S, E);
        { const int nfull = (M / 256) * (NGU / 256) % F.G;
          if (nfull != 0 && (int)blockIdx.x >= nfull) convert_list<3>(F, ((int)blockIdx.x - nfull) * NWAVES + F.wave, (F.G - nfull) * NWAVES);
          else if (nfull == 0) convert_list<3>(F, F.vcu * NWAVES + F.wave, F.G * NWAVES); }
        if (BOTH(9)) GRID_BAR(); }
    TE(9);
    TS(10); if (IN(10)) { pg8::Gemm gm{F.ACT, F.W2D, M, D, FF}; SO S; S.init(M, D, F.G, (int)blockIdx.x); pg8::EpiBf16Ssq E{F.FFB, D, F.ssq};
        pg8::gemm_phase<pg8::EpiBf16Ssq, SO, PG8_ALIGN, PG8_SP2>(F.lds + RING_OFF, gm, S, E); if (BOTH(10)) GRID_BAR(); }
    TE(10);
    TS(11); if (IN(11)) { ew_phase<false, true>(F, F.XR, F.FFB, F.ssq, F.post2, 0.5f, F.out, nullptr, nullptr); }
    TE(11);
#undef IN
#undef BOTH
#ifdef PROBE_PHASE
    if (blockIdx.x == 0 && F.tid == 0) { const unsigned long long te = __builtin_amdgcn_s_memrealtime(); while (__builtin_amdgcn_s_memrealtime() - te < (unsigned long long)PROBE_MULT * pr_dt) __builtin_amdgcn_s_sleep(8); }
#endif
}

extern "C" void kernel_launch(void* const* d_in, const int* in_sizes, int n_in, void* d_out, int out_size, void* d_ws, size_t ws_size, hipStream_t stream) {
    static int grid = 0;
    if (grid == 0) {
        if (n_in != 18 || in_sizes[0] != M * D || out_size != M * D || ws_size < WS_END) { fprintf(stderr, "kernel_launch: unexpected shapes/workspace (n_in %d, ws %zu)\n", n_in, ws_size); grid = -1; return; }
        int dev = 0, cus = 0;
        if (hipGetDevice(&dev) != hipSuccess || hipDeviceGetAttribute(&cus, hipDeviceAttributeMultiprocessorCount, dev) != hipSuccess) { grid = -1; return; }
        if (hipFuncSetAttribute((const void*)hymba_fwd, hipFuncAttributeMaxDynamicSharedMemorySize, LDS_BYTES) != hipSuccess) { fprintf(stderr, "kernel_launch: hipFuncSetAttribute failed\n"); grid = -1; return; }
        (void)hipGetLastError();
        grid = cus;
    }
    if (grid < 0) return;
    if (hipMemsetAsync((char*)d_ws + WS_CTL, 0, CTL_ZERO_BYTES, stream) != hipSuccess) return;
    Args a{};
    for (int i = 0; i < 18; ++i) a.in[i] = (const float*)d_in[i];
    a.out = (float*)d_out; a.ws = (unsigned char*)d_ws;
    if (N_LAUNCHES == 1) { a.ph_lo = 0; a.ph_hi = PER_PHASE; a.li = 0; hipLaunchKernelGGL(hymba_fwd, dim3(grid), dim3(NWAVES * 64), LDS_BYTES, stream, a); }
    else { for (int li = 0; li < PER_PHASE; ++li) { a.ph_lo = li; a.ph_hi = li + 1; a.li = li; hipLaunchKernelGGL(hymba_fwd, dim3(grid), dim3(NWAVES * 64), LDS_BYTES, stream, a); } }
}
```

```cpp
#include <hip/hip_runtime.h>
#include <cstdio>
#include <cstdint>

#ifndef MK_N_LAUNCHES
#define MK_N_LAUNCHES 1
#endif

namespace pg8 {
#define PG8_LAS __attribute__((address_space(3)))
typedef unsigned short bf16_t;
typedef short bf16x8 __attribute__((ext_vector_type(8)));
typedef float f32x4 __attribute__((ext_vector_type(4)));
typedef unsigned u32x4 __attribute__((ext_vector_type(4)));
#ifndef PG8_WGM
#define PG8_WGM 8
#endif
constexpr int BM = 256, BK = 64, HALF = 128, HTB = HALF * BK * 2  , STAGE_BYTES = 8 * HTB, NXCD = 8, WGM = PG8_WGM;

__host__ __device__ __forceinline__ int lds_byte(int r, int c) { const int st = (r >> 4) * 2 + (c >> 5), rr = r & 15, cc = c & 31, ob = rr * 64 + cc * 2; return st * 1024 + (ob ^ (((ob >> 9) & 1) << 5)); }
__host__ __device__ __forceinline__ void stage_rc(int b, int& R, int& C) { const int st = b / 1024, sb = b % 1024, swz = sb ^ (((sb >> 9) & 1) << 5); R = (st >> 1) * 16 + swz / 64; C = (st & 1) * 32 + (swz % 64) / 2; }
__host__ __device__ __forceinline__ int perm32(int rho) { const int n = rho >> 4, i = rho & 15; return 8 * (i >> 2) + 4 * n + (i & 3); }

struct Unit { int pm, pn; };
struct Gemm { const bf16_t* A; const bf16_t* Bt; int M, N, K; };

struct StaticOrder {
    int nM, nN, nwg, G, c;
    __host__ __device__ void init(int M, int N, int G_, int c_) { nM = M / BM; nN = N / BM; nwg = nM * nN; G = G_; c = c_; }
    __host__ __device__ bool next(int i, Unit& u) const {
        const long L = (long)i * G + c; if (L >= nwg) return false;
        int wgid = (int)L; { const int q = nwg / NXCD, r = nwg % NXCD, xcd = wgid % NXCD, off = wgid / NXCD; wgid = (xcd < r ? xcd * (q + 1) : r * (q + 1) + (xcd - r) * q) + off; }
        const int nig = WGM * nN, gid = wgid / nig, fm = gid * WGM, gsz = (nM - fm) < WGM ? (nM - fm) : WGM;
        u.pm = fm + ((wgid % nig) % gsz); u.pn = (wgid % nig) / gsz; return true;
    }
    __device__ __forceinline__ void a_ready(const Unit&) const {}
    __device__ __forceinline__ void done(const Unit&) const {}
};

typedef __bf16 bf16v2_t __attribute__((ext_vector_type(2)));
typedef float f32v2_t __attribute__((ext_vector_type(2)));
__device__ __forceinline__ unsigned cvt_pk_bf16(float lo, float hi) { const f32v2_t v = {lo, hi}; const bf16v2_t b = __builtin_convertvector(v, bf16v2_t); return __builtin_bit_cast(unsigned, b); }

struct EpiBf16 {
    static constexpr bool PERM = true, AFTER_DRAIN = false;
    bf16_t* O; int ldc;
    __device__ __forceinline__ void operator()(const f32x4 (&acc)[2][2][4][2], const Unit& u, int wr, int wc, int fr, int fq) const {
        const int row0 = u.pm * BM + wr * 64 + fr; const int col0 = u.pn * BM + wc * 32 + 8 * fq;
#pragma unroll
        for (int ai = 0; ai < 2; ++ai)
#pragma unroll
            for (int m = 0; m < 4; ++m) { bf16_t* rowp = O + (size_t)(row0 + ai * HALF + m * 16) * ldc + col0;
#pragma unroll
                for (int bj = 0; bj < 2; ++bj) { const f32x4 v0 = acc[ai][bj][m][0], v1 = acc[ai][bj][m][1];
                    u32x4 w; w.x = cvt_pk_bf16(v0[0], v0[1]); w.y = cvt_pk_bf16(v0[2], v0[3]); w.z = cvt_pk_bf16(v1[0], v1[1]); w.w = cvt_pk_bf16(v1[2], v1[3]);
                    *(u32x4*)(rowp + bj * HALF) = w; } }
    }
};
__device__ __forceinline__ float silu_f(float x) { return x * __builtin_amdgcn_rcpf(1.0f + __builtin_amdgcn_exp2f(-1.4426950408889634f * x)); }
struct EpiSwiglu {
    static constexpr bool PERM = true, AFTER_DRAIN = false;
    bf16_t* O; int ldc;
    __device__ __forceinline__ void operator()(const f32x4 (&acc)[2][2][4][2], const Unit& u, int wr, int wc, int fr, int fq) const {
        const int row0 = u.pm * BM + wr * 64 + fr; const int col0 = u.pn * HALF + wc * 32 + 8 * fq;
#pragma unroll
        for (int ai = 0; ai < 2; ++ai)
#pragma unroll
            for (int m = 0; m < 4; ++m) { bf16_t* rowp = O + (size_t)(row0 + ai * HALF + m * 16) * ldc + col0;
                const f32x4 g0 = acc[ai][0][m][0], g1 = acc[ai][0][m][1], u0 = acc[ai][1][m][0], u1 = acc[ai][1][m][1];
                float r[8];
#pragma unroll
                for (int e = 0; e < 4; ++e) { r[e] = silu_f(g0[e]) * u0[e]; r[4 + e] = silu_f(g1[e]) * u1[e]; }
                u32x4 w; w.x = cvt_pk_bf16(r[0], r[1]); w.y = cvt_pk_bf16(r[2], r[3]); w.z = cvt_pk_bf16(r[4], r[5]); w.w = cvt_pk_bf16(r[6], r[7]);
                *(u32x4*)rowp = w; }
    }
};
struct EpiBf16Ssq {
    static constexpr bool PERM = true, AFTER_DRAIN = false;
    bf16_t* C; int ldc; float* ssq;
    __device__ __forceinline__ void operator()(const f32x4 (&acc)[2][2][4][2], const Unit& u, int wr, int wc, int fr, int fq) const {
        const int row0 = u.pm * BM + wr * 64 + fr, col0 = u.pn * BM + wc * 32 + 8 * fq;
#pragma unroll
        for (int ai = 0; ai < 2; ++ai)
#pragma unroll
            for (int m = 0; m < 4; ++m) { const int row = row0 + ai * HALF + m * 16; bf16_t* rowp = C + (size_t)row * ldc + col0; float s = 0.f;
#pragma unroll
                for (int bj = 0; bj < 2; ++bj) { const f32x4 v0 = acc[ai][bj][m][0], v1 = acc[ai][bj][m][1];
                    s += ((v0[0] * v0[0] + v0[1] * v0[1]) + (v0[2] * v0[2] + v0[3] * v0[3])) + ((v1[0] * v1[0] + v1[1] * v1[1]) + (v1[2] * v1[2] + v1[3] * v1[3]));
                    u32x4 w; w.x = cvt_pk_bf16(v0[0], v0[1]); w.y = cvt_pk_bf16(v0[2], v0[3]); w.z = cvt_pk_bf16(v1[0], v1[1]); w.w = cvt_pk_bf16(v1[2], v1[3]);
                    *(u32x4*)(rowp + bj * HALF) = w; }
                s += __shfl_xor(s, 16); s += __shfl_xor(s, 32);
                if (fq == 0) ssq[row * 32 + u.pn * 4 + wc] = s; }
    }
};

template <class Epi, class Sched, bool ALIGN_EPI = false, bool SP2 = false>
__device__ __forceinline__ void gemm_phase(PG8_LAS unsigned char* lds, const Gemm g, const Sched& S, const Epi& E) {
    const int tid = threadIdx.x, wid = __builtin_amdgcn_readfirstlane(tid >> 6), lane = tid & 63, wr = wid >> 2, wc = wid & 3, fr = lane & 15, fq = lane >> 4;
    const int K = g.K, nt = K / BK;
    unsigned voffA[2], voffB[2];
#pragma unroll
    for (int i = 0; i < 2; ++i) { int R, C; stage_rc(tid * 16 + i * 8192, R, C); const int Rb = Epi::PERM ? ((R & ~31) + perm32(R & 31)) : R;
        voffA[i] = (unsigned)(R * K + C) * 2u; voffB[i] = (unsigned)(Rb * K + C) * 2u; }
    const size_t kstep = (size_t)(BK * 2);
    const size_t hstep = (size_t)HALF * K * 2;
    const size_t tstep = 2 * hstep;
    const unsigned ldsw = (unsigned)wid * 1024u;
    const int aoff = lds_byte(wr * 64 + fr, fq * 8), boff = lds_byte(wc * 32 + fr, fq * 8);
#define PG8_SA(b, h) (((b) * 2 + (h)) * HTB)
#define PG8_SB(b, h) ((4 + (b) * 2 + (h)) * HTB)
#define PG8_STAGE(bufoff, gbase, voff) do { _Pragma("unroll") for (int _i = 0; _i < 2; ++_i) \
        __builtin_amdgcn_global_load_lds((const unsigned*)((const char*)(gbase) + (voff)[_i]), (PG8_LAS unsigned*)(lds + (bufoff) + ldsw + _i * 8192), 16, 0, 0); } while (0)
#define PG8_LDA(dst, b, h) do { _Pragma("unroll") for (int m = 0; m < 4; ++m) _Pragma("unroll") for (int k = 0; k < 2; ++k) dst[m][k] = *(const PG8_LAS bf16x8*)(lds + PG8_SA(b, h) + aoff + m * 2048 + k * 1024); } while (0)
#define PG8_LDB(dst, b, h) do { _Pragma("unroll") for (int n = 0; n < 2; ++n) _Pragma("unroll") for (int k = 0; k < 2; ++k) dst[n][k] = *(const PG8_LAS bf16x8*)(lds + PG8_SB(b, h) + boff + n * 2048 + k * 1024); } while (0)
#define PG8_MMA(ai, bj, At, Bt) do { __builtin_amdgcn_s_setprio(1); _Pragma("unroll") for (int m = 0; m < 4; ++m) _Pragma("unroll") for (int n = 0; n < 2; ++n) _Pragma("unroll") for (int k = 0; k < 2; ++k) \
        acc[ai][bj][m][n] = __builtin_amdgcn_mfma_f32_16x16x32_bf16(Bt[n][k], At[m][k], acc[ai][bj][m][n], 0, 0, 0); __builtin_amdgcn_s_setprio(0); } while (0)
#define PG8_WAIT_V(n) asm volatile("s_waitcnt vmcnt(" #n ")" ::: "memory")
#define PG8_WAIT_L(n) asm volatile("s_waitcnt lgkmcnt(" #n ")" ::: "memory")
#define PG8_BAR __builtin_amdgcn_s_barrier()
#define PG8_SCHED __builtin_amdgcn_sched_barrier(0)
    Unit cur, nxt; int ui = 0;
    if (!S.next(0, cur)) return;
    f32x4 acc[2][2][4][2];
#pragma unroll
    for (int a = 0; a < 2; ++a)
#pragma unroll
        for (int b = 0; b < 2; ++b)
#pragma unroll
            for (int m = 0; m < 4; ++m)
#pragma unroll
                for (int n = 0; n < 2; ++n) acc[a][b][m][n] = (f32x4){0.f, 0.f, 0.f, 0.f};
    bf16x8 At[4][2], B0[2][2], B1[2][2];
    const char* cA = (const char*)g.A + (size_t)cur.pm * tstep; const char* cB = (const char*)g.Bt + (size_t)cur.pn * tstep;
    S.a_ready(cur);
    if constexpr (SP2) {
        PG8_STAGE(PG8_SB(0, 0), cB, voffB); PG8_STAGE(PG8_SB(0, 1), cB + hstep, voffB); PG8_STAGE(PG8_SA(0, 0), cA, voffA); PG8_STAGE(PG8_SA(0, 1), cA + hstep, voffA);
        if (wr == 1) PG8_BAR;
        PG8_WAIT_V(2); PG8_BAR;
        PG8_STAGE(PG8_SB(1, 0), cB + kstep, voffB); PG8_STAGE(PG8_SA(1, 0), cA + kstep, voffA); PG8_STAGE(PG8_SB(1, 1), cB + hstep + kstep, voffB);
        PG8_WAIT_V(6); PG8_BAR;
    } else {
        PG8_STAGE(PG8_SB(0, 0), cB, voffB); PG8_STAGE(PG8_SA(0, 0), cA, voffA); PG8_STAGE(PG8_SB(0, 1), cB + hstep, voffB); PG8_STAGE(PG8_SA(0, 1), cA + hstep, voffA);
        if (wr == 1) PG8_BAR;
        PG8_WAIT_V(4); PG8_BAR;
        PG8_STAGE(PG8_SB(1, 0), cB + kstep, voffB); PG8_STAGE(PG8_SA(1, 0), cA + kstep, voffA); PG8_STAGE(PG8_SB(1, 1), cB + hstep + kstep, voffB);
        PG8_WAIT_V(6); PG8_BAR;
    }
    for (;;) {
        const bool has_next = S.next(ui + 1, nxt);
        const char* nA = has_next ? (const char*)g.A + (size_t)nxt.pm * tstep : cA; const char* nB = has_next ? (const char*)g.Bt + (size_t)nxt.pn * tstep : cB;
        for (int t = 0; t < nt; t += 2) {
            const bool last = (t == nt - 2);
            const char* a1 = cA + (size_t)(t + 1) * kstep;
            const char* a2 = last ? nA : cA + (size_t)(t + 2) * kstep; const char* b2 = last ? nB : cB + (size_t)(t + 2) * kstep;
            const char* a3 = a2 + kstep; const char* b3 = b2 + kstep;
            if (last && has_next) S.a_ready(nxt);
            if constexpr (SP2) {
            PG8_LDB(B0, 0, 0); PG8_LDB(B1, 0, 1); PG8_SCHED; PG8_LDA(At, 0, 0); PG8_STAGE(PG8_SA(1, 1), a1 + hstep, voffA);
            PG8_WAIT_V(8); PG8_WAIT_L(0); PG8_BAR; PG8_MMA(0, 0, At, B0); PG8_MMA(0, 1, At, B1); PG8_BAR; PG8_SCHED;
            PG8_LDA(At, 0, 1); PG8_STAGE(PG8_SB(0, 0), b2, voffB); PG8_STAGE(PG8_SB(0, 1), b2 + hstep, voffB); PG8_STAGE(PG8_SA(0, 0), a2, voffA);
            PG8_WAIT_V(8); PG8_WAIT_L(0); PG8_BAR; PG8_MMA(1, 0, At, B0); PG8_MMA(1, 1, At, B1); PG8_BAR; PG8_SCHED;
            PG8_LDB(B0, 1, 0); PG8_LDB(B1, 1, 1); PG8_SCHED; PG8_LDA(At, 1, 0); PG8_STAGE(PG8_SA(0, 1), a2 + hstep, voffA);
            PG8_WAIT_V(8); PG8_WAIT_L(0); PG8_BAR; PG8_MMA(0, 0, At, B0); PG8_MMA(0, 1, At, B1); PG8_BAR; PG8_SCHED;
            PG8_LDA(At, 1, 1); PG8_STAGE(PG8_SB(1, 0), b3, voffB); PG8_STAGE(PG8_SB(1, 1), b3 + hstep, voffB); PG8_STAGE(PG8_SA(1, 0), a3, voffA);
            PG8_WAIT_V(8); PG8_WAIT_L(0); PG8_BAR; PG8_MMA(1, 0, At, B0); PG8_MMA(1, 1, At, B1); PG8_BAR; PG8_SCHED;
            } else {
            PG8_LDB(B0, 0, 0); PG8_SCHED; PG8_LDA(At, 0, 0); PG8_STAGE(PG8_SA(1, 1), a1 + hstep, voffA);
            PG8_WAIT_L(8); PG8_BAR; PG8_WAIT_L(0); PG8_MMA(0, 0, At, B0); PG8_BAR; PG8_SCHED;
            PG8_LDB(B1, 0, 1); PG8_STAGE(PG8_SB(0, 0), b2, voffB);
            PG8_BAR; PG8_WAIT_L(0); PG8_MMA(0, 1, At, B1); PG8_BAR;
            PG8_LDA(At, 0, 1); PG8_STAGE(PG8_SA(0, 0), a2, voffA);
            PG8_BAR; PG8_WAIT_L(0); PG8_MMA(1, 0, At, B0); PG8_BAR; PG8_SCHED;
            PG8_STAGE(PG8_SB(0, 1), b2 + hstep, voffB);
            PG8_WAIT_V(6); PG8_BAR; PG8_MMA(1, 1, At, B1); PG8_BAR;
            PG8_LDB(B0, 1, 0); PG8_SCHED; PG8_LDA(At, 1, 0); PG8_STAGE(PG8_SA(0, 1), a2 + hstep, voffA);
            PG8_WAIT_L(8); PG8_BAR; PG8_WAIT_L(0); PG8_MMA(0, 0, At, B0); PG8_BAR; PG8_SCHED;
            PG8_LDB(B1, 1, 1); PG8_STAGE(PG8_SB(1, 0), b3, voffB);
            PG8_BAR; PG8_WAIT_L(0); PG8_MMA(0, 1, At, B1); PG8_BAR;
            PG8_LDA(At, 1, 1); PG8_STAGE(PG8_SA(1, 0), a3, voffA);
            PG8_BAR; PG8_WAIT_L(0); PG8_MMA(1, 0, At, B0); PG8_BAR; PG8_SCHED;
            PG8_STAGE(PG8_SB(1, 1), b3 + hstep, voffB);
            PG8_WAIT_V(6); PG8_BAR; PG8_MMA(1, 1, At, B1); PG8_BAR;
            }
        }
        if constexpr (ALIGN_EPI) { if (wr == 0) PG8_BAR; }
        if constexpr (!Epi::AFTER_DRAIN) { E(acc, cur, wr, wc, fr, fq); S.done(cur); }
        if (!has_next) break;
#pragma unroll
        for (int a = 0; a < 2; ++a)
#pragma unroll
            for (int b = 0; b < 2; ++b)
#pragma unroll
                for (int m = 0; m < 4; ++m)
#pragma unroll
                    for (int n = 0; n < 2; ++n) acc[a][b][m][n] = (f32x4){0.f, 0.f, 0.f, 0.f};
        cur = nxt; cA = nA; cB = nB; ++ui;
        if constexpr (ALIGN_EPI) { if (wr == 1) PG8_BAR; }
    }
    PG8_WAIT_V(0);
    if constexpr (!ALIGN_EPI) { if (wr == 0) PG8_BAR; }
    PG8_BAR;
#undef PG8_SA
#undef PG8_SB
#undef PG8_STAGE
#undef PG8_LDA
#undef PG8_LDB
#undef PG8_MMA
#undef PG8_WAIT_V
#undef PG8_WAIT_L
#undef PG8_BAR
#undef PG8_SCHED
}
}

#ifndef REP_P0
#define REP_P0 1
#endif
#ifndef REP_P1
#define REP_P1 1
#endif
#ifndef REP_P2
#define REP_P2 1
#endif
#ifndef REP_P3
#define REP_P3 1
#endif
#ifndef REP_P4
#define REP_P4 1
#endif
#ifndef REP_HG
#define REP_HG 1
#endif
#ifndef REP_AT
#define REP_AT 1
#endif
#ifndef REP_P6
#define REP_P6 1
#endif
#ifndef REP_P7
#define REP_P7 1
#endif
#ifndef PROBE_MULT
#define PROBE_MULT 8
#endif
#ifndef PG8_SP2
#define PG8_SP2 true
#endif
#ifndef PG8_ALIGN
#define PG8_ALIGN true
#endif

constexpr int NWAVES = 8;
constexpr int N_LAUNCHES = MK_N_LAUNCHES;
constexpr int PER_PHASE = 12;

constexpr int BATCH = 4, SEQ = 2048, D = 2048, FF = 5632, NGU = 2 * FF, NIN = 6656;
constexpr int M = BATCH * SEQ;
constexpr int HW = 1024, HH = 8, HD = 128;
constexpr int AH = 8, AKV = 2;
constexpr int CQH = 0, CIH = 1024, CFF = 2048, CFB = 3072, CGH = 4096, CQA = 5120, CKA = 6144, CVA = 6400;
constexpr float EPS = 1e-6f;

constexpr size_t MiB = 1u << 20;
constexpr size_t WS_CTL = 0, CTL_ZERO_BYTES = 32768;
constexpr size_t WS_W1GU = 2 * MiB, WS_W1D = 46 * MiB, WS_WIN = 68 * MiB, WS_WOUT = 94 * MiB, WS_W2GU = 102 * MiB, WS_W2D = 146 * MiB;
constexpr size_t WS_H = 168 * MiB;
constexpr size_t WS_ACT = 200 * MiB;
constexpr size_t WS_FF = 304 * MiB;
constexpr size_t WS_END = 368 * MiB;
constexpr int CW_BAR = 4096;
constexpr size_t WS_SSQ = 1 * MiB;

constexpr int RING_OFF = 0, RING_BYTES = 131072;
constexpr int LDSCTL_OFF = RING_BYTES, MISC_OFF = LDSCTL_OFF + 320;
constexpr int LDS_BYTES = 147456;

#define GAS __attribute__((address_space(1)))
#define LAS __attribute__((address_space(3)))
typedef unsigned short bf16;
typedef unsigned v4u __attribute__((ext_vector_type(4)));
typedef unsigned v2u __attribute__((ext_vector_type(2)));
typedef float f32x4 __attribute__((ext_vector_type(4)));
typedef short bf16x8 __attribute__((ext_vector_type(8)));
typedef short bf16x4 __attribute__((ext_vector_type(4)));
typedef GAS unsigned gu32;
#define RLX_AGENT __ATOMIC_RELAXED, __HIP_MEMORY_SCOPE_AGENT
#define LDS_WAIT() asm volatile("s_waitcnt lgkmcnt(0)" ::: "memory")
#define VM_WAIT() asm volatile("s_waitcnt vmcnt(0)" ::: "memory")
__device__ __forceinline__ unsigned f2bf(float f) { unsigned u = __builtin_bit_cast(unsigned, f); return (u + 0x7fffu + ((u >> 16) & 1u)) >> 16; }
__device__ __forceinline__ unsigned pk2(float lo, float hi) { return pg8::cvt_pk_bf16(lo, hi); }
__device__ __forceinline__ float bf_lo(unsigned u) { return __builtin_bit_cast(float, u << 16); }
__device__ __forceinline__ float bf_hi(unsigned u) { return __builtin_bit_cast(float, u & 0xffff0000u); }

#define XB_TMO      128
#define XB_XCNT(j)  (256  + 64 * (j))
#define XB_XSUB(j)  (1280 + 64 * (j))
#define XB_XGEN(j)  (2304 + 64 * (j))
#define XB_TOP      3328
#define XB_TOPGEN   3392
#define XCD_BAR_WORDS 3456
#define XB_SPIN_CAP (1u << 20)

__device__ __forceinline__ unsigned xb_ld(unsigned* p)              { return __hip_atomic_load(p, __ATOMIC_RELAXED, __HIP_MEMORY_SCOPE_AGENT); }
__device__ __forceinline__ unsigned xb_add(unsigned* p, unsigned v) { return __hip_atomic_fetch_add(p, v, __ATOMIC_RELAXED, __HIP_MEMORY_SCOPE_AGENT); }
__device__ __forceinline__ unsigned xb_xcc_id() { return (unsigned)__builtin_amdgcn_s_getreg((3 << 11) | 20) & 0xFu; }
#define XB_SPIN(cond, bar) do { unsigned _sp = 0; while (cond) { __builtin_amdgcn_s_sleep(1); \
    if ((++_sp & 255u) == 0u) { if (xb_ld(&(bar)[XB_TMO])) break; if (_sp > XB_SPIN_CAP) { atomicAdd(&(bar)[XB_TMO], 1u); break; } } } } while (0)

struct XcdBarrier { unsigned* bar; unsigned x; volatile LAS unsigned* st; };

__device__ __forceinline__ XcdBarrier xcd_barrier_post(unsigned* bar, volatile LAS unsigned* st) {
    XcdBarrier b; b.bar = bar; b.x = xb_xcc_id(); b.st = st;
    if (threadIdx.x == 0) (void)xb_add(&bar[XB_XCNT(b.x)], 1u);
    return b;
}
__device__ __forceinline__ void xcd_barrier_complete(unsigned* bar, unsigned x, unsigned& nloc, unsigned& nx) {
    const unsigned G = gridDim.x * gridDim.y * gridDim.z;
    unsigned sum, cnt, mine, sp = 0u;
    for (;;) {
        sum = 0u; cnt = 0u; mine = 0u;
#pragma unroll
        for (unsigned j = 0; j < 16; ++j) { const unsigned c = xb_ld(&bar[XB_XCNT(j)]); sum += c; cnt += (c > 0u) ? 1u : 0u; mine = (j == x) ? c : mine; }
        if (sum == G) break;
        __builtin_amdgcn_s_sleep(1);
        if ((++sp & 255u) == 0u) { if (xb_ld(&bar[XB_TMO])) break; if (sp > XB_SPIN_CAP) { atomicAdd(&bar[XB_TMO], 1u); break; } }
    }
    nloc = mine > 0u ? mine : 1u; nx = cnt > 0u ? cnt : 1u;
}
__device__ __forceinline__ void xcd_barrier(const XcdBarrier& b) {
    asm volatile("s_waitcnt vmcnt(0)" ::: "memory");
    __syncthreads();
    if (threadIdx.x == 0) {
        unsigned* bar = b.bar;
        __builtin_amdgcn_s_waitcnt(0);
        unsigned nloc = b.st[0], nx = b.st[1];
        if (nloc == 0u) { xcd_barrier_complete(bar, b.x, nloc, nx); b.st[0] = nloc; b.st[1] = nx; }
        const unsigned old = xb_add(&bar[XB_XSUB(b.x)], 1u);
        const unsigned gen = old / nloc;
        if (old + 1u == (gen + 1u) * nloc) {
            __builtin_amdgcn_fence(__ATOMIC_RELEASE, "agent");
            asm volatile("s_waitcnt vmcnt(0)" ::: "memory");
            const unsigned og = xb_add(&bar[XB_TOP], 1u);
            const unsigned tg = og / nx;
            if (og + 1u == (tg + 1u) * nx) xb_add(&bar[XB_TOPGEN], 1u);
            else XB_SPIN(xb_ld(&bar[XB_TOPGEN]) == tg, bar);
            __builtin_amdgcn_fence(__ATOMIC_ACQUIRE, "agent");
            xb_add(&bar[XB_XGEN(b.x)], 1u);
            asm volatile("s_waitcnt vmcnt(0)" ::: "memory");
        } else {
            XB_SPIN(xb_ld(&bar[XB_XGEN(b.x)]) == gen, bar);
            __builtin_amdgcn_fence(__ATOMIC_ACQUIRE, "agent");
            asm volatile("s_waitcnt vmcnt(0)" ::: "memory");
        }
    }
    __syncthreads();
}

struct Frame {
    LAS unsigned char* lds;
    volatile LAS unsigned* MISC;
    gu32* ctl;
    int tid, lane, wave;
    int vcu, G;
    const float* x; float* out;
    const float *pre1, *post1, *w1gu, *w1d, *prem, *postm, *win, *lbf, *lbb, *ognorm, *sink, *wout, *pre2, *post2, *w2gu, *w2d, *relb;
    bf16 *W1GU, *W1D, *WIN, *WOUT, *W2GU, *W2D;
    bf16 *H, *ACT, *FFB, *XR; float* SLB; float* ssq;
};

__device__ __forceinline__ float wave_sum(float v) {
#pragma unroll
    for (int o = 1; o < 64; o <<= 1) v += __shfl_xor(v, o);
    return v;
}
struct CvItem { const float* src; bf16* dst; int K, N; };
__device__ __forceinline__ CvItem cv_item(const float* W, int K, int N, bf16* WT, bool gu, int item) {
    const int nblk = N / 32, kb = item / nblk, nb = item % nblk, k0 = 64 * kb, n0 = 32 * nb;
    int r0 = n0;
    if (gu) { const int half = N / 2; const int nn = n0 < half ? n0 : n0 - half; r0 = 256 * (nn / 128) + (nn % 128) + (n0 < half ? 0 : 128); }
    CvItem c; c.src = W + (size_t)k0 * N + n0; c.dst = WT + (size_t)r0 * K + k0; c.K = K; c.N = N; return c;
}
constexpr int I_GU = (D / 64) * (NGU / 32), I_DN = (FF / 64) * (D / 32), I_IN = (D / 64) * (NIN / 32), I_OUT = (D / 64) * (D / 32);
template <int LIST>
__device__ __forceinline__ CvItem cv_list_item(Frame& F, int r) {
    if (LIST == 0) return cv_item(F.w1gu, D, NGU, F.W1GU, true, r);
    if (LIST == 1) { if (r < I_DN) return cv_item(F.w1d, FF, D, F.W1D, false, r); r -= I_DN; if (r < I_IN) return cv_item(F.win, D, NIN, F.WIN, false, r); r -= I_IN; return cv_item(F.wout, D, D, F.WOUT, false, r); }
    if (LIST == 2) return cv_item(F.w2gu, D, NGU, F.W2GU, true, r);
    return cv_item(F.w2d, FF, D, F.W2D, false, r);
}
template <int LIST>
__device__ __forceinline__ void convert_list(Frame& F, int worker, int nworkers) {
    LAS float* scr = (LAS float*)(F.lds + RING_OFF + F.wave * 16384);
    constexpr int NITEMS = LIST == 0 ? I_GU : (LIST == 1 ? I_DN + I_IN + I_OUT : (LIST == 2 ? I_GU : I_DN));
    const int lane = F.lane;
    int it = worker; if (it >= NITEMS) return;
    CvItem cur = cv_list_item<LIST>(F, it);
    float r[32];
#pragma unroll
    for (int i = 0; i < 32; ++i) r[i] = __builtin_nontemporal_load(cur.src + (size_t)(2 * i + (lane >> 5)) * cur.N + (lane & 31));
    for (;;) {
#pragma unroll
        for (int i = 0; i < 32; ++i) scr[(2 * i + (lane >> 5)) * 33 + (lane & 31)] = r[i];
        const int nxt = it + nworkers; const bool has = nxt < NITEMS; CvItem nd = cur;
        if (has) { nd = cv_list_item<LIST>(F, nxt);
#pragma unroll
            for (int i = 0; i < 32; ++i) r[i] = __builtin_nontemporal_load(nd.src + (size_t)(2 * i + (lane >> 5)) * nd.N + (lane & 31)); }
        LDS_WAIT(); asm volatile("" ::: "memory");
        const int c = lane & 7;
#pragma unroll
        for (int j = 0; j < 4; ++j) { const int n = (lane >> 3) + 8 * j; const LAS float* sp = scr + (8 * c) * 33 + n;
            v4u o; o.x = pk2(sp[0 * 33], sp[1 * 33]); o.y = pk2(sp[2 * 33], sp[3 * 33]); o.z = pk2(sp[4 * 33], sp[5 * 33]); o.w = pk2(sp[6 * 33], sp[7 * 33]);
            *(GAS v4u*)(cur.dst + (size_t)n * cur.K + 8 * c) = o; }
        LDS_WAIT(); asm volatile("" ::: "memory");
        if (!has) break;
        cur = nd; it = nxt;
    }
}
__device__ __forceinline__ void rms_rows_to_bf16(int lane, const float* x, const float* gain, bf16* out, int first, int stride) {
    if (first >= M) return;
    f32x4 v[8];
#pragma unroll
    for (int j = 0; j < 8; ++j) v[j] = __builtin_nontemporal_load((const GAS f32x4*)(x + (size_t)first * D + 8 * (lane + 64 * (j >> 1)) + 4 * (j & 1)));
    for (int m = first; m < M; m += stride) {
        f32x4 c[8]; float s = 0.f;
#pragma unroll
        for (int j = 0; j < 8; ++j) { c[j] = v[j]; s += (c[j].x * c[j].x + c[j].y * c[j].y) + (c[j].z * c[j].z + c[j].w * c[j].w); }
        if (m + stride < M) {
#pragma unroll
            for (int j = 0; j < 8; ++j) v[j] = __builtin_nontemporal_load((const GAS f32x4*)(x + (size_t)(m + stride) * D + 8 * (lane + 64 * (j >> 1)) + 4 * (j & 1))); }
        const float rs = 1.0f / sqrtf(wave_sum(s) * (1.f / D) + EPS);
#pragma unroll
        for (int j = 0; j < 4; ++j) { const f32x4 g0 = *(const GAS f32x4*)(gain + 8 * (lane + 64 * j)), g1 = *(const GAS f32x4*)(gain + 8 * (lane + 64 * j) + 4); const f32x4 c0 = c[2 * j], c1 = c[2 * j + 1];
            v4u o; o.x = pk2(c0.x * rs * g0.x, c0.y * rs * g0.y); o.y = pk2(c0.z * rs * g0.z, c0.w * rs * g0.w); o.z = pk2(c1.x * rs * g1.x, c1.y * rs * g1.y); o.w = pk2(c1.z * rs * g1.z, c1.w * rs * g1.w);
            *(GAS v4u*)(out + (size_t)m * D + 8 * (lane + 64 * j)) = o; }
    }
}
__device__ __forceinline__ void p0_prologue(Frame& F) {
    const int gw = F.vcu * NWAVES + F.wave, NGW = F.G * NWAVES;
    convert_list<0>(F, gw, NGW);
    rms_rows_to_bf16(F.lane, F.x, F.pre1, F.H, gw, NGW);
}
__device__ __forceinline__ void unpack8(const v4u t, float (&o)[8]) { o[0] = bf_lo(t.x); o[1] = bf_hi(t.x); o[2] = bf_lo(t.y); o[3] = bf_hi(t.y); o[4] = bf_lo(t.z); o[5] = bf_hi(t.z); o[6] = bf_lo(t.w); o[7] = bf_hi(t.w); }
template <bool XIN_F32, bool XOUT_F32>
__device__ __forceinline__ void ew_phase(Frame& F, const void* xi, const bf16* ff, const float* ssq, const float* post, float coef, void* xo, const float* pre, bf16* h) {
    const int gw = F.vcu * NWAVES + F.wave, NGW = F.G * NWAVES, lane = F.lane;
    for (int m = gw; m < M; m += NGW) {
        const float part = (lane < 32) ? ssq[m * 32 + lane] : 0.f;
        const float rs = coef / sqrtf(wave_sum(part) * (1.f / D) + EPS);
        float v[4][8]; float s = 0.f;
#pragma unroll
        for (int j = 0; j < 4; ++j) { const size_t e0 = (size_t)m * D + 8 * (lane + 64 * j); float a[8], b[8];
            if (XIN_F32) { const f32x4 a0 = __builtin_nontemporal_load((const GAS f32x4*)((const float*)xi + e0)), a1 = __builtin_nontemporal_load((const GAS f32x4*)((const float*)xi + e0 + 4));
                a[0] = a0.x; a[1] = a0.y; a[2] = a0.z; a[3] = a0.w; a[4] = a1.x; a[5] = a1.y; a[6] = a1.z; a[7] = a1.w; }
            else unpack8(__builtin_nontemporal_load((const GAS v4u*)((const bf16*)xi + e0)), a);
            unpack8(__builtin_nontemporal_load((const GAS v4u*)(ff + e0)), b);
            const f32x4 g0 = *(const GAS f32x4*)(post + 8 * (lane + 64 * j)), g1 = *(const GAS f32x4*)(post + 8 * (lane + 64 * j) + 4);
            const float gg[8] = {g0.x, g0.y, g0.z, g0.w, g1.x, g1.y, g1.z, g1.w};
#pragma unroll
            for (int e = 0; e < 8; ++e) v[j][e] = a[e] + b[e] * gg[e] * rs;
            if (XOUT_F32) { __builtin_nontemporal_store((f32x4){v[j][0], v[j][1], v[j][2], v[j][3]}, (GAS f32x4*)((float*)xo + e0)); __builtin_nontemporal_store((f32x4){v[j][4], v[j][5], v[j][6], v[j][7]}, (GAS f32x4*)((float*)xo + e0 + 4)); }
            else { v4u o; o.x = pk2(v[j][0], v[j][1]); o.y = pk2(v[j][2], v[j][3]); o.z = pk2(v[j][4], v[j][5]); o.w = pk2(v[j][6], v[j][7]);
                   __builtin_nontemporal_store(o, (GAS v4u*)((bf16*)xo + e0)); unpack8(o, v[j]); }
#pragma unroll
            for (int e = 0; e < 8; ++e) s += v[j][e] * v[j][e]; }
        if (h) {
            const float r2 = 1.0f / sqrtf(wave_sum(s) * (1.f / D) + EPS);
#pragma unroll
            for (int j = 0; j < 4; ++j) { const f32x4 g0 = *(const GAS f32x4*)(pre + 8 * (lane + 64 * j)), g1 = *(const GAS f32x4*)(pre + 8 * (lane + 64 * j) + 4);
                v4u o; o.x = pk2(v[j][0] * r2 * g0.x, v[j][1] * r2 * g0.y); o.y = pk2(v[j][2] * r2 * g0.z, v[j][3] * r2 * g0.w); o.z = pk2(v[j][4] * r2 * g1.x, v[j][5] * r2 * g1.y); o.w = pk2(v[j][6] * r2 * g1.z, v[j][7] * r2 * g1.w);
                *(GAS v4u*)(h + (size_t)m * D + 8 * (lane + 64 * j)) = o; }
        }
    }
}

__device__ __forceinline__ bf16x8 ldsfrag(LAS unsigned char* base, int row, int stride, int kbyte) { return *(const LAS bf16x8*)(base + row * stride + kbyte); }
constexpr int H2_QD = 0, H2_KD = 17408, H2_KT0 = 34816, H2_KT1 = 53248, H2_VT0 = 71680, H2_VT1 = 90112, H2_PS = 108544, H2_DEC0 = 117760, H2_DEC1 = 118272, H2_RED = 118784, H2_LB = 126976, H2_END = 127488;
static_assert(H2_END <= RING_BYTES, "HGRN LDS map");
static_assert((CW_BAR + 3456) * 4 <= (int)CTL_ZERO_BYTES, "barrier words inside the memset region");
__device__ __forceinline__ void wave_scan_mul8(float (&v)[8]) {
#define SCAN_ROUND(ctrl) \
    "v_mul_f32_dpp %0, %0, %0 " ctrl "\n\tv_mul_f32_dpp %1, %1, %1 " ctrl "\n\tv_mul_f32_dpp %2, %2, %2 " ctrl "\n\tv_mul_f32_dpp %3, %3, %3 " ctrl "\n\t" \
    "v_mul_f32_dpp %4, %4, %4 " ctrl "\n\tv_mul_f32_dpp %5, %5, %5 " ctrl "\n\tv_mul_f32_dpp %6, %6, %6 " ctrl "\n\tv_mul_f32_dpp %7, %7, %7 " ctrl "\n\t"
    asm volatile("s_nop 1\n\t"
        SCAN_ROUND("row_shr:1 row_mask:0xf bank_mask:0xf") SCAN_ROUND("row_shr:2 row_mask:0xf bank_mask:0xf") SCAN_ROUND("row_shr:4 row_mask:0xf bank_mask:0xf")
        SCAN_ROUND("row_shr:8 row_mask:0xf bank_mask:0xf") SCAN_ROUND("row_bcast:15 row_mask:0xa bank_mask:0xf") SCAN_ROUND("row_bcast:31 row_mask:0xc bank_mask:0xf")
        "s_nop 1"
        : "+v"(v[0]), "+v"(v[1]), "+v"(v[2]), "+v"(v[3]), "+v"(v[4]), "+v"(v[5]), "+v"(v[6]), "+v"(v[7]));
#undef SCAN_ROUND
}
template <bool FULL>
__device__ __forceinline__ void hg_stage(LAS unsigned char* L, int ktoff, int decoff, int w, int l, bool bwd, const v4u (&zr)[2], const v4u (&qr)[2], float (&el)[16]) {
#pragma unroll
    for (int hh = 0; hh < 2; ++hh) {
        float f[8], kk[8], E[8], lbv[8];
        { const f32x4 l0 = *(const LAS f32x4*)(L + H2_LB + (16 * w + 8 * hh) * 4), l1 = *(const LAS f32x4*)(L + H2_LB + (16 * w + 8 * hh + 4) * 4);
          lbv[0] = l0[0]; lbv[1] = l0[1]; lbv[2] = l0[2]; lbv[3] = l0[3]; lbv[4] = l1[0]; lbv[5] = l1[1]; lbv[6] = l1[2]; lbv[7] = l1[3]; }
#pragma unroll
        for (int i = 0; i < 8; ++i) { const unsigned zw = zr[hh][i >> 1]; const float z = (i & 1) ? bf_hi(zw) : bf_lo(zw);
            const float sig = __builtin_amdgcn_rcpf(1.0f + __builtin_amdgcn_exp2f(-1.4426950408889634f * z)); f[i] = lbv[i] + (1.0f - lbv[i]) * sig; kk[i] = 1.0f - f[i]; }
#pragma unroll
        for (int i = 0; i < 8; ++i) E[i] = f[i];
        wave_scan_mul8(E);
        float qd[8], kd[8], kt[8];
#pragma unroll
        for (int i = 0; i < 8; ++i) { const float last = __builtin_bit_cast(float, __builtin_amdgcn_readlane(__builtin_bit_cast(int, E[i]), 63)); el[8 * hh + i] = last;
            const float rE = __builtin_amdgcn_rcpf(E[i]); const float C = bwd ? last * f[i] * rE : E[i]; const float Cinv = bwd ? __builtin_amdgcn_rcpf(C) : rE;
            kd[i] = kk[i] * Cinv; kt[i] = kd[i] * last;
            if (FULL) { const unsigned qw = qr[hh][i >> 1]; const float q = (i & 1) ? bf_hi(qw) : bf_lo(qw); qd[i] = q * C; } }
        if (FULL) { v4u a;
            a.x = pk2(qd[0], qd[1]); a.y = pk2(qd[2], qd[3]); a.z = pk2(qd[4], qd[5]); a.w = pk2(qd[6], qd[7]);
            *(LAS v4u*)(L + H2_QD + l * 272 + 32 * w + 16 * hh) = a;
            a.x = pk2(kd[0], kd[1]); a.y = pk2(kd[2], kd[3]); a.z = pk2(kd[4], kd[5]); a.w = pk2(kd[6], kd[7]);
            *(LAS v4u*)(L + H2_KD + l * 272 + 32 * w + 16 * hh) = a; }
#pragma unroll
        for (int i = 0; i < 8; i += 2) { const unsigned pw = pk2(kt[i], kt[i + 1]);
            *(LAS unsigned short*)(L + ktoff + (16 * w + 8 * hh + i) * 144 + 2 * l) = (unsigned short)(pw & 0xffffu); *(LAS unsigned short*)(L + ktoff + (16 * w + 8 * hh + i + 1) * 144 + 2 * l) = (unsigned short)(pw >> 16); }
        if (l == 0) {
#pragma unroll
            for (int i = 0; i < 8; ++i) *(LAS float*)(L + decoff + (16 * w + 8 * hh + i) * 4) = el[8 * hh + i];
        }
    }
}
__device__ __forceinline__ void hg_write_lb(LAS unsigned char* L, const float* lbf, const float* lbb, bool bwd, int h, int w, int l) {
    if (l < 16) { const int i0 = h * 128 + 16 * w + l; const float f0 = lbf[i0], f1 = lbf[HW + i0], b0 = lbb[i0], b1 = lbb[HW + i0];
        const float a0 = bwd ? b0 : f0, a1 = bwd ? b1 : f1; *(LAS float*)(L + H2_LB + (16 * w + l) * 4) = 1.0f / (1.0f + __expf(a1 - a0)); }
}
__device__ __forceinline__ void hg_stage_v(LAS unsigned char* L, int vtoff, int w, int l, const v4u (&vr)[2]) {
#pragma unroll
    for (int i = 0; i < 8; ++i) { const unsigned vw = vr[i >> 2][i & 3];
        *(LAS unsigned short*)(L + vtoff + (16 * w + 2 * i) * 144 + 2 * l) = (unsigned short)(vw & 0xffffu); *(LAS unsigned short*)(L + vtoff + (16 * w + 2 * i + 1) * 144 + 2 * l) = (unsigned short)(vw >> 16); }
}
__device__ __forceinline__ void hg_state_update(LAS unsigned char* L, int ktoff, int vtoff, int decoff, int w, int g, int fr, f32x4 (&S)[8]) {
    bf16x8 vf[2];
#pragma unroll
    for (int k2 = 0; k2 < 2; ++k2) vf[k2] = ldsfrag(L + vtoff, 16 * w + fr, 144, 64 * k2 + 16 * g);
#pragma unroll
    for (int kt = 0; kt < 8; ++kt) { const f32x4 d4 = *(const LAS f32x4*)(L + decoff + (16 * kt + 4 * g) * 4); S[kt] = S[kt] * d4;
#pragma unroll
        for (int k2 = 0; k2 < 2; ++k2) S[kt] = __builtin_amdgcn_mfma_f32_16x16x32_bf16(ldsfrag(L + ktoff, 16 * kt + fr, 144, 64 * k2 + 16 * g), vf[k2], S[kt], 0, 0, 0); }
}
__device__ __forceinline__ size_t hg_slot(int dir, int b, int h, int sc) { return (size_t)(((dir * BATCH + b) * HH + h) * 8 + sc); }

struct HgIn { v4u z[2], q[2], v[2]; };
template <bool FULL>
__device__ __forceinline__ void hg_load(HgIn& r, const bf16* P, int b, int h, int w, int l, int cn, bool bwd) {
    const bf16* row = P + (size_t)(b * SEQ + cn * 64 + l) * NIN;
    const int colz = (bwd ? CFB : CFF) + h * 128 + 16 * w, colv = CIH + h * 128 + 16 * w, colq = CQH + h * 128 + 16 * w;
    r.z[0] = *(const GAS v4u*)(row + colz); r.z[1] = *(const GAS v4u*)(row + colz + 8); r.v[0] = *(const GAS v4u*)(row + colv); r.v[1] = *(const GAS v4u*)(row + colv + 8);
    if (FULL) { r.q[0] = *(const GAS v4u*)(row + colq); r.q[1] = *(const GAS v4u*)(row + colq + 8); } else { r.q[0] = r.z[0]; r.q[1] = r.z[1]; }
}
constexpr int P1_KTF = 0, P1_KTB = 18432, P1_VT = 36864, P1_DEC = 55296, P1_BUF = 55808, P1_LBF = 111616, P1_LBB = 112128, P1_END = 112640;
static_assert(P1_END <= RING_BYTES, "pass-1 LDS map");
__device__ __forceinline__ void hg_stage_p1(LAS unsigned char* L, int boff, int w, int l, const v4u (&zf)[2], const v4u (&zb)[2], float (&pb)[16], float (&dtf)[16]) {
#pragma unroll
    for (int hh = 0; hh < 2; ++hh) {
        float ff[8], fb[8], Ef[8], Eb[8];
        { const f32x4 a0 = *(const LAS f32x4*)(L + P1_LBF + (16 * w + 8 * hh) * 4), a1 = *(const LAS f32x4*)(L + P1_LBF + (16 * w + 8 * hh + 4) * 4);
          const f32x4 b0 = *(const LAS f32x4*)(L + P1_LBB + (16 * w + 8 * hh) * 4), b1 = *(const LAS f32x4*)(L + P1_LBB + (16 * w + 8 * hh + 4) * 4);
          const float lf[8] = {a0[0], a0[1], a0[2], a0[3], a1[0], a1[1], a1[2], a1[3]}, lbk[8] = {b0[0], b0[1], b0[2], b0[3], b1[0], b1[1], b1[2], b1[3]};
#pragma unroll
          for (int i = 0; i < 8; ++i) { const unsigned zw = zf[hh][i >> 1], yw = zb[hh][i >> 1]; const float z = (i & 1) ? bf_hi(zw) : bf_lo(zw), y = (i & 1) ? bf_hi(yw) : bf_lo(yw);
              ff[i] = lf[i] + (1.0f - lf[i]) * __builtin_amdgcn_rcpf(1.0f + __builtin_amdgcn_exp2f(-1.4426950408889634f * z));
              fb[i] = lbk[i] + (1.0f - lbk[i]) * __builtin_amdgcn_rcpf(1.0f + __builtin_amdgcn_exp2f(-1.4426950408889634f * y)); Ef[i] = ff[i]; Eb[i] = fb[i]; } }
        wave_scan_mul8(Ef); wave_scan_mul8(Eb);
        float ktf[8], ktb[8];
#pragma unroll
        for (int i = 0; i < 8; ++i) { const float lastf = __builtin_bit_cast(float, __builtin_amdgcn_readlane(__builtin_bit_cast(int, Ef[i]), 63)), lastb = __builtin_bit_cast(float, __builtin_amdgcn_readlane(__builtin_bit_cast(int, Eb[i]), 63));
            ktf[i] = (1.0f - ff[i]) * lastf * __builtin_amdgcn_rcpf(Ef[i]);
            ktb[i] = (1.0f - fb[i]) * Eb[i] * __builtin_amdgcn_rcpf(fb[i]) * pb[8 * hh + i];
            pb[8 * hh + i] *= lastb; dtf[8 * hh + i] = lastf; }
#pragma unroll
        for (int i = 0; i < 8; i += 2) { const unsigned pf = pk2(ktf[i], ktf[i + 1]), pq = pk2(ktb[i], ktb[i + 1]); const int ro = (16 * w + 8 * hh + i) * 144 + 2 * l;
            *(LAS unsigned short*)(L + boff + P1_KTF + ro) = (unsigned short)(pf & 0xffffu); *(LAS unsigned short*)(L + boff + P1_KTF + ro + 144) = (unsigned short)(pf >> 16);
            *(LAS unsigned short*)(L + boff + P1_KTB + ro) = (unsigned short)(pq & 0xffffu); *(LAS unsigned short*)(L + boff + P1_KTB + ro + 144) = (unsigned short)(pq >> 16); }
        if (l == 0) {
#pragma unroll
            for (int i = 0; i < 8; ++i) *(LAS float*)(L + boff + P1_DEC + (16 * w + 8 * hh + i) * 4) = dtf[8 * hh + i];
        }
    }
}
__device__ __forceinline__ void hgrn_pass1(Frame& F, const bf16* P, float* SL, float* DL) {
    LAS unsigned char* L = F.lds + RING_OFF;
    const int w = F.wave, l = F.lane, g = l >> 4, fr = l & 15;
    for (int item = F.vcu; item < 256; item += F.G) { const int b = item >> 6, h = (item >> 3) & 7, sc = item & 7;
        if (l < 16) { const int i0 = h * 128 + 16 * w + l;
            *(LAS float*)(L + P1_LBF + (16 * w + l) * 4) = 1.0f / (1.0f + __expf(F.lbf[HW + i0] - F.lbf[i0])); *(LAS float*)(L + P1_LBB + (16 * w + l) * 4) = 1.0f / (1.0f + __expf(F.lbb[HW + i0] - F.lbb[i0])); }
        const int colzf = CFF + h * 128 + 16 * w, colzb = CFB + h * 128 + 16 * w, colv = CIH + h * 128 + 16 * w;
        v4u zf[2], zb[2], vr[2];
        {   const bf16* row = P + (size_t)(b * SEQ + sc * 256 + l) * NIN;
            zf[0] = *(const GAS v4u*)(row + colzf); zf[1] = *(const GAS v4u*)(row + colzf + 8); zb[0] = *(const GAS v4u*)(row + colzb); zb[1] = *(const GAS v4u*)(row + colzb + 8);
            vr[0] = *(const GAS v4u*)(row + colv); vr[1] = *(const GAS v4u*)(row + colv + 8); }
        f32x4 Sf[8], Sb[8]; float pb[16], dtot[16];
#pragma unroll
        for (int kt = 0; kt < 8; ++kt) { Sf[kt] = (f32x4){0.f, 0.f, 0.f, 0.f}; Sb[kt] = (f32x4){0.f, 0.f, 0.f, 0.f}; }
#pragma unroll
        for (int i = 0; i < 16; ++i) { pb[i] = 1.0f; dtot[i] = 1.0f; }
        for (int n = 0; n < 4; ++n) { const int boff = (n & 1) * P1_BUF;
            float dtf[16];
            hg_stage_v(L, boff + P1_VT, w, l, vr);
            hg_stage_p1(L, boff, w, l, zf, zb, pb, dtf);
#pragma unroll
            for (int i = 0; i < 16; ++i) dtot[i] *= dtf[i];
            if (n + 1 < 4) { const bf16* row = P + (size_t)(b * SEQ + sc * 256 + (n + 1) * 64 + l) * NIN;
                zf[0] = *(const GAS v4u*)(row + colzf); zf[1] = *(const GAS v4u*)(row + colzf + 8); zb[0] = *(const GAS v4u*)(row + colzb); zb[1] = *(const GAS v4u*)(row + colzb + 8);
                vr[0] = *(const GAS v4u*)(row + colv); vr[1] = *(const GAS v4u*)(row + colv + 8); }
            __syncthreads();
            bf16x8 vf[2];
#pragma unroll
            for (int k2 = 0; k2 < 2; ++k2) vf[k2] = ldsfrag(L + boff + P1_VT, 16 * w + fr, 144, 64 * k2 + 16 * g);
#pragma unroll
            for (int kt = 0; kt < 8; ++kt) { const f32x4 d4 = *(const LAS f32x4*)(L + boff + P1_DEC + (16 * kt + 4 * g) * 4); Sf[kt] = Sf[kt] * d4;
#pragma unroll
                for (int k2 = 0; k2 < 2; ++k2) { Sf[kt] = __builtin_amdgcn_mfma_f32_16x16x32_bf16(ldsfrag(L + boff + P1_KTF, 16 * kt + fr, 144, 64 * k2 + 16 * g), vf[k2], Sf[kt], 0, 0, 0);
                                                 Sb[kt] = __builtin_amdgcn_mfma_f32_16x16x32_bf16(ldsfrag(L + boff + P1_KTB, 16 * kt + fr, 144, 64 * k2 + 16 * g), vf[k2], Sb[kt], 0, 0, 0); } }
        }
        const size_t slf = hg_slot(0, b, h, sc), slb = hg_slot(1, b, h, sc);
#pragma unroll
        for (int kt = 0; kt < 8; ++kt) { *(GAS f32x4*)(SL + slf * 16384 + (size_t)((kt * 8 + w) * 64 + l) * 4) = Sf[kt]; *(GAS f32x4*)(SL + slb * 16384 + (size_t)((kt * 8 + w) * 64 + l) * 4) = Sb[kt]; }
        if (l == 0) {
#pragma unroll
            for (int i = 0; i < 16; ++i) { DL[slf * 128 + 16 * w + i] = dtot[i]; DL[slb * 128 + 16 * w + i] = pb[i]; }
        }
        __syncthreads();
    }
}

__device__ __forceinline__ void hgrn_pass2_compute(LAS unsigned char* L, int w, int g, int fr, bool bwd, int vtoff, f32x4 (&S)[8], f32x4 (&o)[4]) {
    {   const int ct = w >> 1, sh = w & 1;
        bf16x8 qfr[4];
#pragma unroll
        for (int ks = 0; ks < 4; ++ks) qfr[ks] = ldsfrag(L + H2_QD, 16 * ct + fr, 272, 64 * ks + 16 * g);
#pragma unroll
        for (int t2 = 0; t2 < 2; ++t2) { const int st = 2 * sh + t2; f32x4 sc4 = (f32x4){0.f, 0.f, 0.f, 0.f};
#pragma unroll
            for (int ks = 0; ks < 4; ++ks) sc4 = __builtin_amdgcn_mfma_f32_16x16x32_bf16(ldsfrag(L + H2_KD, 16 * st + fr, 272, 64 * ks + 16 * g), qfr[ks], sc4, 0, 0, 0);
            const int c = 16 * ct + fr, s0 = 16 * st + 4 * g;
            float m[4];
#pragma unroll
            for (int r = 0; r < 4; ++r) { const bool keep = bwd ? (s0 + r >= c) : (s0 + r <= c); m[r] = keep ? sc4[r] : 0.f; }
            v2u pw; pw.x = pk2(m[0], m[1]); pw.y = pk2(m[2], m[3]);
            *(LAS v2u*)(L + H2_PS + c * 144 + 2 * s0) = pw; } }
    {   bf16x8 sa[4];
#pragma unroll
        for (int k2 = 0; k2 < 4; ++k2) { v4u t; t.x = pk2(S[2 * k2][0], S[2 * k2][1]); t.y = pk2(S[2 * k2][2], S[2 * k2][3]); t.z = pk2(S[2 * k2 + 1][0], S[2 * k2 + 1][1]); t.w = pk2(S[2 * k2 + 1][2], S[2 * k2 + 1][3]); sa[k2] = __builtin_bit_cast(bf16x8, t); }
#pragma unroll
        for (int ct = 0; ct < 4; ++ct) { const LAS unsigned char* qrow = L + H2_QD + (16 * ct + fr) * 272; o[ct] = (f32x4){0.f, 0.f, 0.f, 0.f};
#pragma unroll
            for (int k2 = 0; k2 < 4; ++k2) { const v2u b0 = *(const LAS v2u*)(qrow + 2 * (32 * k2 + 4 * g)), b1 = *(const LAS v2u*)(qrow + 2 * (32 * k2 + 16 + 4 * g));
                const v4u bv = (v4u){b0.x, b0.y, b1.x, b1.y};
                o[ct] = __builtin_amdgcn_mfma_f32_16x16x32_bf16(sa[k2], __builtin_bit_cast(bf16x8, bv), o[ct], 0, 0, 0); } } }
    hg_state_update(L, H2_KT0, vtoff, H2_DEC0, w, g, fr, S);
    __syncthreads();
    {   bf16x8 vf[2];
#pragma unroll
        for (int k2 = 0; k2 < 2; ++k2) vf[k2] = ldsfrag(L + vtoff, 16 * w + fr, 144, 64 * k2 + 16 * g);
#pragma unroll
        for (int ct = 0; ct < 4; ++ct)
#pragma unroll
            for (int k2 = 0; k2 < 2; ++k2) o[ct] = __builtin_amdgcn_mfma_f32_16x16x32_bf16(vf[k2], ldsfrag(L + H2_PS, 16 * ct + fr, 144, 64 * k2 + 16 * g), o[ct], 0, 0, 0); }
}
__device__ __forceinline__ void hgrn_pass2(Frame& F, const bf16* P, const float* SL, const float* DL, float* OFW, bf16* Y) {
    LAS unsigned char* L = F.lds + RING_OFF;
    const int w = F.wave, l = F.lane, g = l >> 4, fr = l & 15;
    LAS float* RED = (LAS float*)(L + H2_RED);
    for (int item = F.vcu; item < 256; item += F.G) { const int b = item >> 6, h = (item >> 3) & 7, sc = item & 7;
        HgIn in; hg_load<true>(in, P, b, h, w, l, sc * 4, false);
        const f32x4 gn = *(const GAS f32x4*)(F.ognorm + h * 128 + 16 * w + 4 * g);
        f32x4 S[8];
        for (int t = 0; t < 8; ++t) { const bool bwd = t >= 4; const int n = t & 3, j = bwd ? 3 - n : n, dir = bwd ? 1 : 0;
            if (n == 0) {
                if (bwd) { asm volatile("s_waitcnt vmcnt(0)" ::: "memory"); }
                hg_write_lb(L, F.lbf, F.lbb, bwd, h, w, l);
#pragma unroll
                for (int kt = 0; kt < 8; ++kt) S[kt] = (f32x4){0.f, 0.f, 0.f, 0.f};
                const int nf = bwd ? 7 - sc : sc;
                LAS float* DLS = (LAS float*)(L + H2_PS);
                for (int u = F.tid; u < nf * 128; u += NWAVES * 64) { const int tt = u >> 7; const int i = bwd ? 7 - tt : tt; DLS[u] = DL[hg_slot(dir, b, h, i) * 128 + (u & 127)]; }
                __syncthreads();
                int tt = 0;
                for (; tt + 1 < nf; tt += 2) {
                    const int i0 = bwd ? 7 - tt : tt, i1 = bwd ? 6 - tt : tt + 1;
                    const float* sl0 = SL + hg_slot(dir, b, h, i0) * 16384 + (size_t)(w * 64 + l) * 4; const float* sl1 = SL + hg_slot(dir, b, h, i1) * 16384 + (size_t)(w * 64 + l) * 4;
                    f32x4 s4a[8], s4b[8];
#pragma unroll
                    for (int kt = 0; kt < 8; ++kt) { s4a[kt] = *(const GAS f32x4*)(sl0 + (size_t)kt * 8 * 256); s4b[kt] = *(const GAS f32x4*)(sl1 + (size_t)kt * 8 * 256); }
                    asm volatile("" ::: "memory");
#pragma unroll
                    for (int kt = 0; kt < 8; ++kt) { const f32x4 d0 = *(const LAS f32x4*)(DLS + tt * 128 + 16 * kt + 4 * g), d1 = *(const LAS f32x4*)(DLS + (tt + 1) * 128 + 16 * kt + 4 * g);
                        S[kt] = (S[kt] * d0 + s4a[kt]) * d1 + s4b[kt]; } }
                if (tt < nf) { const int i = bwd ? 7 - tt : tt; const float* sl = SL + hg_slot(dir, b, h, i) * 16384 + (size_t)(w * 64 + l) * 4;
                    f32x4 s4[8];
#pragma unroll
                    for (int kt = 0; kt < 8; ++kt) s4[kt] = *(const GAS f32x4*)(sl + (size_t)kt * 8 * 256);
                    asm volatile("" ::: "memory");
#pragma unroll
                    for (int kt = 0; kt < 8; ++kt) { const f32x4 d4 = *(const LAS f32x4*)(DLS + tt * 128 + 16 * kt + 4 * g); S[kt] = S[kt] * d4 + s4[kt]; } }
            }
            const int vtoff = (t & 1) ? H2_VT1 : H2_VT0;
            {   float el[16];
                hg_stage_v(L, vtoff, w, l, in.v);
                hg_stage<true>(L, H2_KT0, H2_DEC0, w, l, bwd, in.z, in.q, el); }
            if (t + 1 < 8) { const bool nb = (t + 1) >= 4; const int nn = (t + 1) & 3; hg_load<true>(in, P, b, h, w, l, sc * 4 + (nb ? 3 - nn : nn), nb); }
            float* ofw = OFW + ((size_t)((item * 4 + j) * 4) * 8 + w) * 256 + (size_t)l * 4;
            f32x4 of[4]; v2u gr[4];
            if (bwd) {
#pragma unroll
                for (int ct = 0; ct < 4; ++ct) { of[ct] = *(const GAS f32x4*)(ofw + (size_t)ct * 8 * 256);
                    gr[ct] = *(const GAS v2u*)(P + (size_t)(b * SEQ + (sc * 4 + j) * 64 + ct * 16 + fr) * NIN + CGH + h * 128 + 16 * w + 4 * g); }
            }
            __syncthreads();
            f32x4 o[4];
            hgrn_pass2_compute(L, w, g, fr, bwd, vtoff, S, o);
            if (!bwd) {
#pragma unroll
                for (int ct = 0; ct < 4; ++ct) *(GAS f32x4*)(ofw + (size_t)ct * 8 * 256) = o[ct];
            } else {
                float ps[4];
#pragma unroll
                for (int ct = 0; ct < 4; ++ct) { o[ct] = o[ct] + of[ct]; const f32x4 v = o[ct];
                    float s2 = (v[0] * v[0] + v[1] * v[1]) + (v[2] * v[2] + v[3] * v[3]); s2 += __shfl_xor(s2, 16); s2 += __shfl_xor(s2, 32); ps[ct] = s2; }
                if (g == 0) {
#pragma unroll
                    for (int ct = 0; ct < 4; ++ct) RED[w * 64 + ct * 16 + fr] = ps[ct];
                }
                __syncthreads();
#pragma unroll
                for (int ct = 0; ct < 4; ++ct) { const int ti = ct * 16 + fr; float tot = 0.f;
#pragma unroll
                    for (int ww = 0; ww < 8; ++ww) tot += RED[ww * 64 + ti];
                    const float rs = 1.0f / sqrtf(tot * (1.f / 128.f) + EPS);
                    const size_t row = (size_t)(b * SEQ + (sc * 4 + j) * 64 + ti);
                    const f32x4 v = o[ct];
                    v2u o2; o2.x = pk2(v[0] * rs * gn[0] * pg8::silu_f(bf_lo(gr[ct].x)), v[1] * rs * gn[1] * pg8::silu_f(bf_hi(gr[ct].x)));
                    o2.y = pk2(v[2] * rs * gn[2] * pg8::silu_f(bf_lo(gr[ct].y)), v[3] * rs * gn[3] * pg8::silu_f(bf_hi(gr[ct].y)));
                    *(GAS v2u*)(Y + row * D + h * 128 + 16 * w + 4 * g) = o2; }
            }
        }
        __syncthreads();
    }
}

constexpr int AT_K = 0, AT_V = 34816, AT_TB = 69632, AT_END = 69632 + 2 * 264 * 4;
__device__ __forceinline__ int t5_bucket(int rel) {
    const int n = rel < 0 ? -rel : rel; int bkt;
    if (n < 8) bkt = n; else { int j = 0; while (j < 7 && 64 * (2 << j) <= n * n) ++j; bkt = 8 + j; }
    return bkt + (rel > 0 ? 16 : 0);
}
struct AtRegs { v4u k[4], v[4]; };
__device__ __forceinline__ void at_load(AtRegs& r, const bf16* P, int b, int kb, int kvh, int tid) {
    const bf16* kvbase = P + (size_t)(b * SEQ + kb * 128) * NIN;
#pragma unroll
    for (int i = 0; i < 4; ++i) { const int id = tid + 512 * i; r.k[i] = *(const GAS v4u*)(kvbase + (size_t)(id >> 4) * NIN + CKA + kvh * 128 + 8 * (id & 15)); }
#pragma unroll
    for (int i = 0; i < 4; ++i) { const int id = tid + 512 * i; r.v[i] = *(const GAS v4u*)(kvbase + (size_t)(id & 127) * NIN + CVA + kvh * 128 + 8 * (id >> 7)); }
}
__device__ __forceinline__ void at_stage(LAS unsigned char* L, const AtRegs& r, int tid) {
#pragma unroll
    for (int i = 0; i < 4; ++i) { const int id = tid + 512 * i; *(LAS v4u*)(L + AT_K + (id >> 4) * 272 + 16 * (id & 15)) = r.k[i]; }
#pragma unroll
    for (int i = 0; i < 4; ++i) { const int id = tid + 512 * i; const int key = id & 127, ch = id >> 7;
#pragma unroll
        for (int e = 0; e < 4; ++e) { *(LAS unsigned short*)(L + AT_V + (8 * ch + 2 * e) * 272 + 2 * key) = (unsigned short)(r.v[i][e] & 0xffffu); *(LAS unsigned short*)(L + AT_V + (8 * ch + 2 * e + 1) * 272 + 2 * key) = (unsigned short)(r.v[i][e] >> 16); } }
}
__device__ __forceinline__ void at_head(LAS unsigned char* L, const LAS float* TB, int relbase, int g, int fr, const bf16x8 (&bq)[4], float& mrun, float& lrun, f32x4 (&ot)[8]) {
    const float scale = 0.08838834764831845f;
    f32x4 st[8];
#pragma unroll
    for (int mt = 0; mt < 8; ++mt) { st[mt] = (f32x4){0.f, 0.f, 0.f, 0.f};
#pragma unroll
        for (int ks = 0; ks < 4; ++ks) st[mt] = __builtin_amdgcn_mfma_f32_16x16x32_bf16(ldsfrag(L + AT_K, 16 * mt + fr, 272, 64 * ks + 16 * g), bq[ks], st[mt], 0, 0, 0); }
    float mx = -3.0e38f;
#pragma unroll
    for (int mt = 0; mt < 8; ++mt)
#pragma unroll
        for (int r = 0; r < 4; ++r) { const int rel = relbase + 16 * mt + r; const bool ok = rel >= -128 && rel <= 128; const int ri = min(max(rel + 128, 0), 256);
            const float tb = TB[ri]; const float s = ok ? st[mt][r] * scale + tb : -1.0e30f; st[mt][r] = s; mx = fmaxf(mx, s); }
    mx = fmaxf(mx, __shfl_xor(mx, 16)); mx = fmaxf(mx, __shfl_xor(mx, 32));
    const float mnew = fmaxf(mrun, mx), alpha = __expf(mrun - mnew); mrun = mnew;
    float ls = 0.f;
#pragma unroll
    for (int mt = 0; mt < 8; ++mt)
#pragma unroll
        for (int r = 0; r < 4; ++r) { const float p = __expf(st[mt][r] - mnew); st[mt][r] = p; ls += p; }
    ls += __shfl_xor(ls, 16); ls += __shfl_xor(ls, 32);
    lrun = lrun * alpha + ls;
#pragma unroll
    for (int dt = 0; dt < 8; ++dt) ot[dt] = ot[dt] * alpha;
#pragma unroll
    for (int k2 = 0; k2 < 4; ++k2) {
        v4u pb; pb.x = pk2(st[2 * k2][0], st[2 * k2][1]); pb.y = pk2(st[2 * k2][2], st[2 * k2][3]); pb.z = pk2(st[2 * k2 + 1][0], st[2 * k2 + 1][1]); pb.w = pk2(st[2 * k2 + 1][2], st[2 * k2 + 1][3]);
        const bf16x8 pfrag = __builtin_bit_cast(bf16x8, pb);
#pragma unroll
        for (int dt = 0; dt < 8; ++dt) { const LAS unsigned char* vrow = L + AT_V + (16 * dt + fr) * 272;
            const v2u a0 = *(const LAS v2u*)(vrow + 2 * (32 * k2 + 4 * g)), a1 = *(const LAS v2u*)(vrow + 2 * (32 * k2 + 16 + 4 * g));
            const v4u av = (v4u){a0.x, a0.y, a1.x, a1.y};
            ot[dt] = __builtin_amdgcn_mfma_f32_16x16x32_bf16(__builtin_bit_cast(bf16x8, av), pfrag, ot[dt], 0, 0, 0); } }
}
__device__ __forceinline__ void attn_item(Frame& F, const bf16* P, bf16* Y, int item) {
    LAS unsigned char* L = F.lds + RING_OFF;
    const int w = F.wave, l = F.lane, g = l >> 4, fr = l & 15, tid = F.tid;
    {
        const int hq = item & 3, blk = (item >> 2) & 15, kvh = (item >> 6) & 1, b = item >> 7, h = kvh * 4 + hq;
        LAS float* TB = (LAS float*)(L + AT_TB);
        if (tid < 257) TB[tid] = F.relb[t5_bucket(tid - 128) * AH + h];
        const int jt0 = blk == 0 ? 1 : 0, jt1 = blk == 15 ? 1 : 2;
        AtRegs R; at_load(R, P, b, blk - 1 + jt0, kvh, tid);
        const int qrow = b * SEQ + blk * 128 + 16 * w + fr;
        bf16x8 bq[4];
#pragma unroll
        for (int ks = 0; ks < 4; ++ks) bq[ks] = *(const GAS bf16x8*)(P + (size_t)qrow * NIN + CQA + h * 128 + 32 * ks + 8 * g);
        float mrun = F.sink[h], lrun = 1.0f;
        f32x4 ot[8];
#pragma unroll
        for (int dt = 0; dt < 8; ++dt) ot[dt] = (f32x4){0.f, 0.f, 0.f, 0.f};
        for (int jt = jt0; jt <= jt1; ++jt) {
            at_stage(L, R, tid);
            __syncthreads();
            if (jt < jt1) at_load(R, P, b, blk + jt, kvh, tid);
            const int relbase = (jt - 1) * 128 + 4 * g - (16 * w + fr);
            at_head(L, TB, relbase, g, fr, bq, mrun, lrun, ot);
            __syncthreads();
        }
        const float inv = 1.0f / lrun;
#pragma unroll
        for (int dt = 0; dt < 8; ++dt) { v2u o2; o2.x = pk2(ot[dt][0] * inv, ot[dt][1] * inv); o2.y = pk2(ot[dt][2] * inv, ot[dt][3] * inv);
            *(GAS v2u*)(Y + (size_t)qrow * D + HW + h * 128 + 16 * dt + 4 * g) = o2; }
        __syncthreads();
    }
}
__device__ __forceinline__ void attn_phase(Frame& F, const bf16* P, bf16* Y) { for (int item = F.vcu; item < 512; item += F.G) attn_item(F, P, Y, item); }
__device__ __forceinline__ float at_softmax(const LAS float* TB, int relbase, f32x4 (&st)[8], float& mrun, float& lrun) {
    const float scale = 0.08838834764831845f;
    float mx = -3.0e38f;
#pragma unroll
    for (int mt = 0; mt < 8; ++mt)
#pragma unroll
        for (int r = 0; r < 4; ++r) { const int rel = relbase + 16 * mt + r; const bool ok = rel >= -128 && rel <= 128; const int ri = min(max(rel + 128, 0), 256);
            const float tb = TB[ri]; const float s = ok ? st[mt][r] * scale + tb : -1.0e30f; st[mt][r] = s; mx = fmaxf(mx, s); }
    mx = fmaxf(mx, __shfl_xor(mx, 16)); mx = fmaxf(mx, __shfl_xor(mx, 32));
    const float mnew = fmaxf(mrun, mx), alpha = __expf(mrun - mnew); mrun = mnew;
    float ls = 0.f;
#pragma unroll
    for (int mt = 0; mt < 8; ++mt)
#pragma unroll
        for (int r = 0; r < 4; ++r) { const float p = __expf(st[mt][r] - mnew); st[mt][r] = p; ls += p; }
    ls += __shfl_xor(ls, 16); ls += __shfl_xor(ls, 32);
    lrun = lrun * alpha + ls;
    return alpha;
}
__device__ __forceinline__ void attn_item2(Frame& F, const bf16* P, bf16* Y, int item2) {
    LAS unsigned char* L = F.lds + RING_OFF;
    const int w = F.wave, l = F.lane, g = l >> 4, fr = l & 15, tid = F.tid;
    const int hp = item2 & 1, blk = (item2 >> 1) & 15, kvh = (item2 >> 5) & 1, b = item2 >> 6, h0 = kvh * 4 + 2 * hp;
    LAS float* TB = (LAS float*)(L + AT_TB);
    for (int u = tid; u < 2 * 257; u += NWAVES * 64) { const int hh = u >= 257 ? 1 : 0, t = u - 257 * hh; TB[hh * 264 + t] = F.relb[t5_bucket(t - 128) * AH + h0 + hh]; }
    const int jt0 = blk == 0 ? 1 : 0, jt1 = blk == 15 ? 1 : 2;
    const int qrow = b * SEQ + blk * 128 + 16 * w + fr;
    bf16x8 bq0[4], bq1[4];
#pragma unroll
    for (int ks = 0; ks < 4; ++ks) { bq0[ks] = *(const GAS bf16x8*)(P + (size_t)qrow * NIN + CQA + h0 * 128 + 32 * ks + 8 * g); bq1[ks] = *(const GAS bf16x8*)(P + (size_t)qrow * NIN + CQA + (h0 + 1) * 128 + 32 * ks + 8 * g); }
    float m0 = F.sink[h0], m1 = F.sink[h0 + 1], l0 = 1.0f, l1 = 1.0f;
    f32x4 ot0[8], ot1[8];
#pragma unroll
    for (int dt = 0; dt < 8; ++dt) { ot0[dt] = (f32x4){0.f, 0.f, 0.f, 0.f}; ot1[dt] = (f32x4){0.f, 0.f, 0.f, 0.f}; }
    for (int jt = jt0; jt <= jt1; ++jt) {
        { AtRegs R; at_load(R, P, b, blk - 1 + jt, kvh, tid); at_stage(L, R, tid); }
        __syncthreads();
        const int relbase = (jt - 1) * 128 + 4 * g - (16 * w + fr);
        f32x4 st0[8], st1[8];
#pragma unroll
        for (int mt = 0; mt < 8; ++mt) { st0[mt] = (f32x4){0.f, 0.f, 0.f, 0.f}; st1[mt] = (f32x4){0.f, 0.f, 0.f, 0.f};
#pragma unroll
            for (int ks = 0; ks < 4; ++ks) { const bf16x8 kf = ldsfrag(L + AT_K, 16 * mt + fr, 272, 64 * ks + 16 * g);
                st0[mt] = __builtin_amdgcn_mfma_f32_16x16x32_bf16(kf, bq0[ks], st0[mt], 0, 0, 0); st1[mt] = __builtin_amdgcn_mfma_f32_16x16x32_bf16(kf, bq1[ks], st1[mt], 0, 0, 0); } }
        const float a0 = at_softmax(TB, relbase, st0, m0, l0);
        __builtin_amdgcn_sched_barrier(0);
        const float a1 = at_softmax(TB + 264, relbase, st1, m1, l1);
#pragma unroll
        for (int dt = 0; dt < 8; ++dt) { ot0[dt] = ot0[dt] * a0; ot1[dt] = ot1[dt] * a1; }
#pragma unroll
        for (int k2 = 0; k2 < 4; ++k2) {
            v4u pb; pb.x = pk2(st0[2 * k2][0], st0[2 * k2][1]); pb.y = pk2(st0[2 * k2][2], st0[2 * k2][3]); pb.z = pk2(st0[2 * k2 + 1][0], st0[2 * k2 + 1][1]); pb.w = pk2(st0[2 * k2 + 1][2], st0[2 * k2 + 1][3]);
            const bf16x8 pf0 = __builtin_bit_cast(bf16x8, pb);
            pb.x = pk2(st1[2 * k2][0], st1[2 * k2][1]); pb.y = pk2(st1[2 * k2][2], st1[2 * k2][3]); pb.z = pk2(st1[2 * k2 + 1][0], st1[2 * k2 + 1][1]); pb.w = pk2(st1[2 * k2 + 1][2], st1[2 * k2 + 1][3]);
            const bf16x8 pf1 = __builtin_bit_cast(bf16x8, pb);
#pragma unroll
            for (int dt = 0; dt < 8; ++dt) { const LAS unsigned char* vrow = L + AT_V + (16 * dt + fr) * 272;
                const v2u x0 = *(const LAS v2u*)(vrow + 2 * (32 * k2 + 4 * g)), x1 = *(const LAS v2u*)(vrow + 2 * (32 * k2 + 16 + 4 * g));
                const bf16x8 av = __builtin_bit_cast(bf16x8, (v4u){x0.x, x0.y, x1.x, x1.y});
                ot0[dt] = __builtin_amdgcn_mfma_f32_16x16x32_bf16(av, pf0, ot0[dt], 0, 0, 0); ot1[dt] = __builtin_amdgcn_mfma_f32_16x16x32_bf16(av, pf1, ot1[dt], 0, 0, 0); } }
        __syncthreads();
    }
    const float inv0 = 1.0f / l0, inv1 = 1.0f / l1;
#pragma unroll
    for (int dt = 0; dt < 8; ++dt) { v2u o2; o2.x = pk2(ot0[dt][0] * inv0, ot0[dt][1] * inv0); o2.y = pk2(ot0[dt][2] * inv0, ot0[dt][3] * inv0);
        *(GAS v2u*)(Y + (size_t)qrow * D + HW + h0 * 128 + 16 * dt + 4 * g) = o2;
        o2.x = pk2(ot1[dt][0] * inv1, ot1[dt][1] * inv1); o2.y = pk2(ot1[dt][2] * inv1, ot1[dt][3] * inv1);
        *(GAS v2u*)(Y + (size_t)qrow * D + HW + (h0 + 1) * 128 + 16 * dt + 4 * g) = o2; }
    __syncthreads();
}

constexpr int CW_GRP = 1024;
__device__ __forceinline__ void hg_group_publish(Frame& F, int grp) {
    asm volatile("s_waitcnt vmcnt(0)" ::: "memory");
    __syncthreads();
    if (F.tid == 0) { __builtin_amdgcn_fence(__ATOMIC_RELEASE, "agent"); asm volatile("s_waitcnt vmcnt(0)" ::: "memory");
        __hip_atomic_fetch_add((unsigned*)(F.ctl + CW_GRP + 64 * grp), 1u, __ATOMIC_RELAXED, __HIP_MEMORY_SCOPE_AGENT); }
}
__device__ __forceinline__ void hg_group_wait(Frame& F, int grp) {
    if (F.tid == 0) { unsigned sp = 0;
        while (__hip_atomic_load((unsigned*)(F.ctl + CW_GRP + 64 * grp), __ATOMIC_RELAXED, __HIP_MEMORY_SCOPE_AGENT) < 8u) { __builtin_amdgcn_s_sleep(2); if (++sp > (1u << 20)) break; }
        __builtin_amdgcn_fence(__ATOMIC_ACQUIRE, "agent"); asm volatile("s_waitcnt vmcnt(0)" ::: "memory"); }
    __syncthreads();
}

struct Args { const float* in[18]; float* out; unsigned char* ws; int ph_lo, ph_hi, li, pad; };
__global__ void __launch_bounds__(NWAVES * 64, 2) hymba_fwd(Args args) {
    extern __shared__ __attribute__((aligned(16))) unsigned char lds[];
    Frame F;
    F.lds = (LAS unsigned char*)lds;
    F.MISC = (volatile LAS unsigned*)(F.lds + MISC_OFF);
    F.tid = threadIdx.x; F.lane = F.tid & 63; F.wave = __builtin_amdgcn_readfirstlane(F.tid >> 6);
    F.G = gridDim.x; { const int bx = blockIdx.x; F.vcu = (F.G % 8 == 0) ? (bx % 8) * (F.G / 8) + bx / 8 : bx; }
    unsigned char* ws = args.ws;
    F.ctl = (gu32*)(ws + WS_CTL);
    F.x = args.in[0]; F.pre1 = args.in[1]; F.post1 = args.in[2]; F.w1gu = args.in[3]; F.w1d = args.in[4]; F.prem = args.in[5]; F.postm = args.in[6]; F.win = args.in[7];
    F.lbf = args.in[8]; F.lbb = args.in[9]; F.ognorm = args.in[10]; F.sink = args.in[11]; F.wout = args.in[12]; F.pre2 = args.in[13]; F.post2 = args.in[14];
    F.w2gu = args.in[15]; F.w2d = args.in[16]; F.relb = args.in[17]; F.out = args.out;
    F.W1GU = (bf16*)(ws + WS_W1GU); F.W1D = (bf16*)(ws + WS_W1D); F.WIN = (bf16*)(ws + WS_WIN); F.WOUT = (bf16*)(ws + WS_WOUT); F.W2GU = (bf16*)(ws + WS_W2GU); F.W2D = (bf16*)(ws + WS_W2D);
    F.H = (bf16*)(ws + WS_H); F.ACT = (bf16*)(ws + WS_ACT); F.FFB = (bf16*)(ws + WS_FF); F.SLB = (float*)(ws + WS_FF); F.XR = (bf16*)(ws + WS_FF + 32 * MiB); F.ssq = (float*)(ws + WS_SSQ);
    for (int u = F.tid; u < (LDS_BYTES - LDSCTL_OFF) / 4; u += NWAVES * 64) ((LAS unsigned*)(F.lds + LDSCTL_OFF))[u] = 0u;
    __syncthreads();
    XcdBarrier bar; bar.bar = (unsigned*)(F.ctl + CW_BAR); bar.x = 0; bar.st = nullptr;
    if (N_LAUNCHES != PER_PHASE) bar = xcd_barrier_post((unsigned*)(F.ctl + CW_BAR), F.MISC + 8);
#define GRID_BAR() do { if (N_LAUNCHES != PER_PHASE) xcd_barrier(bar); } while (0)
    const int lo = args.ph_lo, hi = args.ph_hi;
    unsigned long long pr_t0 = 0, pr_dt = 0;
#ifdef PROBE_PHASE
#define TS(k) do { if ((k) == PROBE_PHASE) pr_t0 = __builtin_amdgcn_s_memrealtime(); } while (0)
#define TE(k) do { if ((k) == PROBE_PHASE) pr_dt = __builtin_amdgcn_s_memrealtime() - pr_t0; } while (0)
#else
#define TS(k) do {} while (0)
#define TE(k) do {} while (0)
#endif
#define IN(k) (lo <= (k) && (k) < hi)
#define BOTH(k) (IN(k) && IN((k) + 1))
    typedef pg8::StaticOrder SO;
    TS(0); if (IN(0)) for (int r_ = 0; r_ < REP_P0; ++r_) { p0_prologue(F); if (BOTH(0)) GRID_BAR(); }
    TE(0);
    TS(1); if (IN(1)) for (int r_ = 0; r_ < REP_P1; ++r_) { pg8::Gemm gm{F.H, F.W1GU, M, NGU, D}; SO S; S.init(M, NGU, F.G, (int)blockIdx.x); pg8::EpiSwiglu E{F.ACT, FF};
        pg8::gemm_phase<pg8::EpiSwiglu, SO, PG8_ALIGN, PG8_SP2>(F.lds + RING_OFF, gm, S, E);
        { const int nfull = (M / 256) * (NGU / 256) % F.G;
          if (nfull != 0 && (int)blockIdx.x >= nfull && r_ == 0) convert_list<1>(F, ((int)blockIdx.x - nfull) * NWAVES + F.wave, (F.G - nfull) * NWAVES);
          else if (nfull == 0 && r_ == 0) convert_list<1>(F, F.vcu * NWAVES + F.wave, F.G * NWAVES); }
        if (BOTH(1)) GRID_BAR(); }
    TE(1);
    TS(2); if (IN(2)) for (int r_ = 0; r_ < REP_P2; ++r_) { pg8::Gemm gm{F.ACT, F.W1D, M, D, FF}; SO S; S.init(M, D, F.G, (int)blockIdx.x); pg8::EpiBf16Ssq E{F.FFB, D, F.ssq};
        pg8::gemm_phase<pg8::EpiBf16Ssq, SO, PG8_ALIGN, PG8_SP2>(F.lds + RING_OFF, gm, S, E); if (BOTH(2)) GRID_BAR(); }
    TE(2);
    TS(3); if (IN(3)) for (int r_ = 0; r_ < REP_P3; ++r_) { ew_phase<true, false>(F, F.x, F.FFB, F.ssq, F.post1, 0.5f, F.XR, F.prem, F.H); TS(67); if (BOTH(3)) GRID_BAR(); TE(67); }
    TE(3);
    TS(4); if (IN(4)) for (int r_ = 0; r_ < REP_P4; ++r_) { pg8::Gemm gm{F.H, F.WIN, M, NIN, D}; SO S; S.init(M, NIN, F.G, (int)blockIdx.x); pg8::EpiBf16 E{F.ACT, NIN};
        pg8::gemm_phase<pg8::EpiBf16, SO, PG8_ALIGN, PG8_SP2>(F.lds + RING_OFF, gm, S, E);
        { const int nfull = (M / 256) * (NIN / 256) % F.G;
          if (nfull != 0 && (int)blockIdx.x >= nfull && r_ == 0) convert_list<2>(F, ((int)blockIdx.x - nfull) * NWAVES + F.wave, (F.G - nfull) * NWAVES);
          else if (nfull == 0 && r_ == 0) convert_list<2>(F, F.vcu * NWAVES + F.wave, F.G * NWAVES); }
        TS(66); if (BOTH(4)) GRID_BAR(); TE(66); }
    TE(4);
    TS(5); if (IN(5)) {
        if (F.G == 256 && REP_HG == 1 && REP_AT == 1) {
            const int grp = F.vcu >> 3;
            TS(64); TS(50);
#if defined(PROBE_PHASE) && (PROBE_PHASE == 72 || PROBE_PHASE == 73)
            pr_t0 = __builtin_amdgcn_s_memrealtime();
#endif
            hgrn_pass1(F, F.ACT, F.SLB, F.ssq); TE(50); TS(53); hg_group_publish(F, grp); TE(53);
            TS(51); attn_item2(F, F.ACT, F.H, F.vcu); TE(51);
            hg_group_wait(F, grp); TS(52); hgrn_pass2(F, F.ACT, F.SLB, F.ssq, F.out, F.H); TE(52); TE(64); TS(68); asm volatile("s_waitcnt vmcnt(0)" ::: "memory"); TE(68);
#if defined(PROBE_PHASE) && (PROBE_PHASE == 72 || PROBE_PHASE == 73)
            { const unsigned long long tnow = __builtin_amdgcn_s_memrealtime(); if (F.tid == 0) __hip_atomic_store((unsigned*)(F.ctl + 8192 + blockIdx.x), (unsigned)(tnow - pr_t0), __ATOMIC_RELAXED, __HIP_MEMORY_SCOPE_AGENT); }
#endif
#if defined(PROBE_PHASE) && PROBE_PHASE == 69
            TS(69); if (F.tid == 0) { __builtin_amdgcn_fence(__ATOMIC_RELEASE, "agent"); asm volatile("s_waitcnt vmcnt(0)" ::: "memory"); } TE(69);
#endif
        } else {
            for (int r_ = 0; r_ < REP_HG; ++r_) hgrn_pass1(F, F.ACT, F.SLB, F.ssq); for (int r_ = 0; r_ < REP_AT; ++r_) attn_phase(F, F.ACT, F.H); GRID_BAR();
            hgrn_pass2(F, F.ACT, F.SLB, F.ssq, F.out, F.H);
        }
        TS(65); if (BOTH(5)) GRID_BAR(); TE(65);
#if defined(PROBE_PHASE) && (PROBE_PHASE == 72 || PROBE_PHASE == 73)
        { unsigned mx = 0, am = 0; for (int i = 0; i < 256; ++i) { const unsigned v = __hip_atomic_load((unsigned*)(F.ctl + 8192 + i), __ATOMIC_RELAXED, __HIP_MEMORY_SCOPE_AGENT); if (v > mx) { mx = v; am = i; } }
          pr_dt = PROBE_PHASE == 72 ? mx : am * 100u; }
#endif
        }
    TE(5);
    TS(6);
    TE(6);
    TS(7); if (IN(7)) for (int r_ = 0; r_ < REP_P7; ++r_) { pg8::Gemm gm{F.H, F.WOUT, M, D, D}; SO S; S.init(M, D, F.G, (int)blockIdx.x); pg8::EpiBf16Ssq E{F.FFB, D, F.ssq};
        pg8::gemm_phase<pg8::EpiBf16Ssq, SO, PG8_ALIGN, PG8_SP2>(F.lds + RING_OFF, gm, S, E); if (BOTH(7)) GRID_BAR(); }
    TE(7);
    TS(8); if (IN(8)) { ew_phase<false, false>(F, F.XR, F.FFB, F.ssq, F.postm, 1.0f, F.XR, F.pre2, F.H); if (BOTH(8)) GRID_BAR(); }
    TE(8);
    TS(9); if (IN(9)) { pg8::Gemm gm{F.H, F.W2GU, M, NGU, D}; SO S; S.init(M, NGU, F.G, (int)blockIdx.x); pg8::EpiSwiglu E{F.ACT, FF};
        pg8::gemm_phase<pg8::EpiSwiglu, SO, PG8_ALIGN, PG8_SP2>(F.lds + RING_OFF, gm, S, E);
        { const int nfull = (M / 256) * (NGU / 256) % F.G;
          if (nfull != 0 && (int)blockIdx.x >= nfull) convert_list<3>(F, ((int)blockIdx.x - nfull) * NWAVES + F.wave, (F.G - nfull) * NWAVES);
          else if (nfull == 0) convert_list<3>(F, F.vcu * NWAVES + F.wave, F.G * NWAVES); }
        if (BOTH(9)) GRID_BAR(); }
    TE(9);
    TS(10); if (IN(10)) { pg8::Gemm gm{F.ACT, F.W2D, M, D, FF}; SO S; S.init(M, D, F.G, (int)blockIdx.x); pg8::EpiBf16Ssq E{F.FFB, D, F.ssq};
        pg8::gemm_phase<pg8::EpiBf16Ssq, SO, PG8_ALIGN, PG8_SP2>(F.lds + RING_OFF, gm, S, E); if (BOTH(10)) GRID_BAR(); }
    TE(10);
    TS(11); if (IN(11)) { ew_phase<false, true>(F, F.XR, F.FFB, F.ssq, F.post2, 0.5f, F.out, nullptr, nullptr); }
    TE(11);
#undef IN
#undef BOTH
#ifdef PROBE_PHASE
    if (blockIdx.x == 0 && F.tid == 0) { const unsigned long long te = __builtin_amdgcn_s_memrealtime(); while (__builtin_amdgcn_s_memrealtime() - te < (unsigned long long)PROBE_MULT * pr_dt) __builtin_amdgcn_s_sleep(8); }
#endif
}

extern "C" void kernel_launch(void* const* d_in, const int* in_sizes, int n_in, void* d_out, int out_size, void* d_ws, size_t ws_size, hipStream_t stream) {
    static int grid = 0;
    if (grid == 0) {
        if (n_in != 18 || in_sizes[0] != M * D || out_size != M * D || ws_size < WS_END) { fprintf(stderr, "kernel_launch: unexpected shapes/workspace (n_in %d, ws %zu)\n", n_in, ws_size); grid = -1; return; }
        int dev = 0, cus = 0;
        if (hipGetDevice(&dev) != hipSuccess || hipDeviceGetAttribute(&cus, hipDeviceAttributeMultiprocessorCount, dev) != hipSuccess) { grid = -1; return; }
        if (hipFuncSetAttribute((const void*)hymba_fwd, hipFuncAttributeMaxDynamicSharedMemorySize, LDS_BYTES) != hipSuccess) { fprintf(stderr, "kernel_launch: hipFuncSetAttribute failed\n"); grid = -1; return; }
        (void)hipGetLastError();
        grid = cus;
    }
    if (grid < 0) return;
    if (hipMemsetAsync((char*)d_ws + WS_CTL, 0, CTL_ZERO_BYTES, stream) != hipSuccess) return;
    Args a{};
    for (int i = 0; i < 18; ++i) a.in[i] = (const float*)d_in[i];
    a.out = (float*)d_out; a.ws = (unsigned char*)d_ws;
    if (N_LAUNCHES == 1) { a.ph_lo = 0; a.ph_hi = PER_PHASE; a.li = 0; hipLaunchKernelGGL(hymba_fwd, dim3(grid), dim3(NWAVES * 64), LDS_BYTES, stream, a); }
    else { for (int li = 0; li < PER_PHASE; ++li) { a.ph_lo = li; a.ph_hi = li + 1; a.li = li; hipLaunchKernelGGL(hymba_fwd, dim3(grid), dim3(NWAVES * 64), LDS_BYTES, stream, a); } }
}
```

```cpp
#include <hip/hip_runtime.h>
#include <cstdio>
#include <cstdint>

#ifndef MK_N_LAUNCHES
#define MK_N_LAUNCHES 1
#endif

namespace pg8 {
#define PG8_LAS __attribute__((address_space(3)))
typedef unsigned short bf16_t;
typedef short bf16x8 __attribute__((ext_vector_type(8)));
typedef float f32x4 __attribute__((ext_vector_type(4)));
typedef unsigned u32x4 __attribute__((ext_vector_type(4)));
#ifndef PG8_WGM
#define PG8_WGM 8
#endif
constexpr int BM = 256, BK = 64, HALF = 128, HTB = HALF * BK * 2  , STAGE_BYTES = 8 * HTB, NXCD = 8, WGM = PG8_WGM;

__host__ __device__ __forceinline__ int lds_byte(int r, int c) { const int st = (r >> 4) * 2 + (c >> 5), rr = r & 15, cc = c & 31, ob = rr * 64 + cc * 2; return st * 1024 + (ob ^ (((ob >> 9) & 1) << 5)); }
__host__ __device__ __forceinline__ void stage_rc(int b, int& R, int& C) { const int st = b / 1024, sb = b % 1024, swz = sb ^ (((sb >> 9) & 1) << 5); R = (st >> 1) * 16 + swz / 64; C = (st & 1) * 32 + (swz % 64) / 2; }
__host__ __device__ __forceinline__ int perm32(int rho) { const int n = rho >> 4, i = rho & 15; return 8 * (i >> 2) + 4 * n + (i & 3); }

struct Unit { int pm, pn; };
struct Gemm { const bf16_t* A; const bf16_t* Bt; int M, N, K; };

struct StaticOrder {
    int nM, nN, nwg, G, c;
    __host__ __device__ void init(int M, int N, int G_, int c_) { nM = M / BM; nN = N / BM; nwg = nM * nN; G = G_; c = c_; }
    __host__ __device__ bool next(int i, Unit& u) const {
        const long L = (long)i * G + c; if (L >= nwg) return false;
        int wgid = (int)L; { const int q = nwg / NXCD, r = nwg % NXCD, xcd = wgid % NXCD, off = wgid / NXCD; wgid = (xcd < r ? xcd * (q + 1) : r * (q + 1) + (xcd - r) * q) + off; }
        const int nig = WGM * nN, gid = wgid / nig, fm = gid * WGM, gsz = (nM - fm) < WGM ? (nM - fm) : WGM;
        u.pm = fm + ((wgid % nig) % gsz); u.pn = (wgid % nig) / gsz; return true;
    }
    __device__ __forceinline__ void a_ready(const Unit&) const {}
    __device__ __forceinline__ void done(const Unit&) const {}
};

typedef __bf16 bf16v2_t __attribute__((ext_vector_type(2)));
typedef float f32v2_t __attribute__((ext_vector_type(2)));
__device__ __forceinline__ unsigned cvt_pk_bf16(float lo, float hi) { const f32v2_t v = {lo, hi}; const bf16v2_t b = __builtin_convertvector(v, bf16v2_t); return __builtin_bit_cast(unsigned, b); }

struct EpiBf16 {
    static constexpr bool PERM = true, AFTER_DRAIN = false;
    bf16_t* O; int ldc;
    __device__ __forceinline__ void operator()(const f32x4 (&acc)[2][2][4][2], const Unit& u, int wr, int wc, int fr, int fq) const {
        const int row0 = u.pm * BM + wr * 64 + fr; const int col0 = u.pn * BM + wc * 32 + 8 * fq;
#pragma unroll
        for (int ai = 0; ai < 2; ++ai)
#pragma unroll
            for (int m = 0; m < 4; ++m) { bf16_t* rowp = O + (size_t)(row0 + ai * HALF + m * 16) * ldc + col0;
#pragma unroll
                for (int bj = 0; bj < 2; ++bj) { const f32x4 v0 = acc[ai][bj][m][0], v1 = acc[ai][bj][m][1];
                    u32x4 w; w.x = cvt_pk_bf16(v0[0], v0[1]); w.y = cvt_pk_bf16(v0[2], v0[3]); w.z = cvt_pk_bf16(v1[0], v1[1]); w.w = cvt_pk_bf16(v1[2], v1[3]);
                    *(u32x4*)(rowp + bj * HALF) = w; } }
    }
};
__device__ __forceinline__ float silu_f(float x) { return x * __builtin_amdgcn_rcpf(1.0f + __builtin_amdgcn_exp2f(-1.4426950408889634f * x)); }
struct EpiSwiglu {
    static constexpr bool PERM = true, AFTER_DRAIN = false;
    bf16_t* O; int ldc;
    __device__ __forceinline__ void operator()(const f32x4 (&acc)[2][2][4][2], const Unit& u, int wr, int wc, int fr, int fq) const {
        const int row0 = u.pm * BM + wr * 64 + fr; const int col0 = u.pn * HALF + wc * 32 + 8 * fq;
#pragma unroll
        for (int ai = 0; ai < 2; ++ai)
#pragma unroll
            for (int m = 0; m < 4; ++m) { bf16_t* rowp = O + (size_t)(row0 + ai * HALF + m * 16) * ldc + col0;
                const f32x4 g0 = acc[ai][0][m][0], g1 = acc[ai][0][m][1], u0 = acc[ai][1][m][0], u1 = acc[ai][1][m][1];
                float r[8];
#pragma unroll
                for (int e = 0; e < 4; ++e) { r[e] = silu_f(g0[e]) * u0[e]; r[4 + e] = silu_f(g1[e]) * u1[e]; }
                u32x4 w; w.x = cvt_pk_bf16(r[0], r[1]); w.y = cvt_pk_bf16(r[2], r[3]); w.z = cvt_pk_bf16(r[4], r[5]); w.w = cvt_pk_bf16(r[6], r[7]);
                *(u32x4*)rowp = w; }
    }
};
struct EpiBf16Ssq {
    static constexpr bool PERM = true, AFTER_DRAIN = false;
    bf16_t* C; int ldc; float* ssq;
    __device__ __forceinline__ void operator()(const f32x4 (&acc)[2][2][4][2], const Unit& u, int wr, int wc, int fr, int fq) const {
        const int row0 = u.pm * BM + wr * 64 + fr, col0 = u.pn * BM + wc * 32 + 8 * fq;
#pragma unroll
        for (int ai = 0; ai < 2; ++ai)
#pragma unroll
            for (int m = 0; m < 4; ++m) { const int row = row0 + ai * HALF + m * 16; bf16_t* rowp = C + (size_t)row * ldc + col0; float s = 0.f;
#pragma unroll
                for (int bj = 0; bj < 2; ++bj) { const f32x4 v0 = acc[ai][bj][m][0], v1 = acc[ai][bj][m][1];
                    s += ((v0[0] * v0[0] + v0[1] * v0[1]) + (v0[2] * v0[2] + v0[3] * v0[3])) + ((v1[0] * v1[0] + v1[1] * v1[1]) + (v1[2] * v1[2] + v1[3] * v1[3]));
                    u32x4 w; w.x = cvt_pk_bf16(v0[0], v0[1]); w.y = cvt_pk_bf16(v0[2], v0[3]); w.z = cvt_pk_bf16(v1[0], v1[1]); w.w = cvt_pk_bf16(v1[2], v1[3]);
                    *(u32x4*)(rowp + bj * HALF) = w; }
                s += __shfl_xor(s, 16); s += __shfl_xor(s, 32);
                if (fq == 0) ssq[row * 32 + u.pn * 4 + wc] = s; }
    }
};

template <class Epi, class Sched, bool ALIGN_EPI = false, bool SP2 = false>
__device__ __forceinline__ void gemm_phase(PG8_LAS unsigned char* lds, const Gemm g, const Sched& S, const Epi& E) {
    const int tid = threadIdx.x, wid = __builtin_amdgcn_readfirstlane(tid >> 6), lane = tid & 63, wr = wid >> 2, wc = wid & 3, fr = lane & 15, fq = lane >> 4;
    const int K = g.K, nt = K / BK;
    unsigned voffA[2], voffB[2];
#pragma unroll
    for (int i = 0; i < 2; ++i) { int R, C; stage_rc(tid * 16 + i * 8192, R, C); const int Rb = Epi::PERM ? ((R & ~31) + perm32(R & 31)) : R;
        voffA[i] = (unsigned)(R * K + C) * 2u; voffB[i] = (unsigned)(Rb * K + C) * 2u; }
    const size_t kstep = (size_t)(BK * 2);
    const size_t hstep = (size_t)HALF * K * 2;
    const size_t tstep = 2 * hstep;
    const unsigned ldsw = (unsigned)wid * 1024u;
    const int aoff = lds_byte(wr * 64 + fr, fq * 8), boff = lds_byte(wc * 32 + fr, fq * 8);
#define PG8_SA(b, h) (((b) * 2 + (h)) * HTB)
#define PG8_SB(b, h) ((4 + (b) * 2 + (h)) * HTB)
#define PG8_STAGE(bufoff, gbase, voff) do { _Pragma("unroll") for (int _i = 0; _i < 2; ++_i) \
        __builtin_amdgcn_global_load_lds((const unsigned*)((const char*)(gbase) + (voff)[_i]), (PG8_LAS unsigned*)(lds + (bufoff) + ldsw + _i * 8192), 16, 0, 0); } while (0)
#define PG8_LDA(dst, b, h) do { _Pragma("unroll") for (int m = 0; m < 4; ++m) _Pragma("unroll") for (int k = 0; k < 2; ++k) dst[m][k] = *(const PG8_LAS bf16x8*)(lds + PG8_SA(b, h) + aoff + m * 2048 + k * 1024); } while (0)
#define PG8_LDB(dst, b, h) do { _Pragma("unroll") for (int n = 0; n < 2; ++n) _Pragma("unroll") for (int k = 0; k < 2; ++k) dst[n][k] = *(const PG8_LAS bf16x8*)(lds + PG8_SB(b, h) + boff + n * 2048 + k * 1024); } while (0)
#define PG8_MMA(ai, bj, At, Bt) do { __builtin_amdgcn_s_setprio(1); _Pragma("unroll") for (int m = 0; m < 4; ++m) _Pragma("unroll") for (int n = 0; n < 2; ++n) _Pragma("unroll") for (int k = 0; k < 2; ++k) \
        acc[ai][bj][m][n] = __builtin_amdgcn_mfma_f32_16x16x32_bf16(Bt[n][k], At[m][k], acc[ai][bj][m][n], 0, 0, 0); __builtin_amdgcn_s_setprio(0); } while (0)
#define PG8_WAIT_V(n) asm volatile("s_waitcnt vmcnt(" #n ")" ::: "memory")
#define PG8_WAIT_L(n) asm volatile("s_waitcnt lgkmcnt(" #n ")" ::: "memory")
#define PG8_BAR __builtin_amdgcn_s_barrier()
#define PG8_SCHED __builtin_amdgcn_sched_barrier(0)
    Unit cur, nxt; int ui = 0;
    if (!S.next(0, cur)) return;
    f32x4 acc[2][2][4][2];
#pragma unroll
    for (int a = 0; a < 2; ++a)
#pragma unroll
        for (int b = 0; b < 2; ++b)
#pragma unroll
            for (int m = 0; m < 4; ++m)
#pragma unroll
                for (int n = 0; n < 2; ++n) acc[a][b][m][n] = (f32x4){0.f, 0.f, 0.f, 0.f};
    bf16x8 At[4][2], B0[2][2], B1[2][2];
    const char* cA = (const char*)g.A + (size_t)cur.pm * tstep; const char* cB = (const char*)g.Bt + (size_t)cur.pn * tstep;
    S.a_ready(cur);
    if constexpr (SP2) {
        PG8_STAGE(PG8_SB(0, 0), cB, voffB); PG8_STAGE(PG8_SB(0, 1), cB + hstep, voffB); PG8_STAGE(PG8_SA(0, 0), cA, voffA); PG8_STAGE(PG8_SA(0, 1), cA + hstep, voffA);
        if (wr == 1) PG8_BAR;
        PG8_WAIT_V(2); PG8_BAR;
        PG8_STAGE(PG8_SB(1, 0), cB + kstep, voffB); PG8_STAGE(PG8_SA(1, 0), cA + kstep, voffA); PG8_STAGE(PG8_SB(1, 1), cB + hstep + kstep, voffB);
        PG8_WAIT_V(6); PG8_BAR;
    } else {
        PG8_STAGE(PG8_SB(0, 0), cB, voffB); PG8_STAGE(PG8_SA(0, 0), cA, voffA); PG8_STAGE(PG8_SB(0, 1), cB + hstep, voffB); PG8_STAGE(PG8_SA(0, 1), cA + hstep, voffA);
        if (wr == 1) PG8_BAR;
        PG8_WAIT_V(4); PG8_BAR;
        PG8_STAGE(PG8_SB(1, 0), cB + kstep, voffB); PG8_STAGE(PG8_SA(1, 0), cA + kstep, voffA); PG8_STAGE(PG8_SB(1, 1), cB + hstep + kstep, voffB);
        PG8_WAIT_V(6); PG8_BAR;
    }
    for (;;) {
        const bool has_next = S.next(ui + 1, nxt);
        const char* nA = has_next ? (const char*)g.A + (size_t)nxt.pm * tstep : cA; const char* nB = has_next ? (const char*)g.Bt + (size_t)nxt.pn * tstep : cB;
        for (int t = 0; t < nt; t += 2) {
            const bool last = (t == nt - 2);
            const char* a1 = cA + (size_t)(t + 1) * kstep;
            const char* a2 = last ? nA : cA + (size_t)(t + 2) * kstep; const char* b2 = last ? nB : cB + (size_t)(t + 2) * kstep;
            const char* a3 = a2 + kstep; const char* b3 = b2 + kstep;
            if (last && has_next) S.a_ready(nxt);
            if constexpr (SP2) {
            PG8_LDB(B0, 0, 0); PG8_LDB(B1, 0, 1); PG8_SCHED; PG8_LDA(At, 0, 0); PG8_STAGE(PG8_SA(1, 1), a1 + hstep, voffA);
            PG8_WAIT_V(8); PG8_WAIT_L(0); PG8_BAR; PG8_MMA(0, 0, At, B0); PG8_MMA(0, 1, At, B1); PG8_BAR; PG8_SCHED;
            PG8_LDA(At, 0, 1); PG8_STAGE(PG8_SB(0, 0), b2, voffB); PG8_STAGE(PG8_SB(0, 1), b2 + hstep, voffB); PG8_STAGE(PG8_SA(0, 0), a2, voffA);
            PG8_WAIT_V(8); PG8_WAIT_L(0); PG8_BAR; PG8_MMA(1, 0, At, B0); PG8_MMA(1, 1, At, B1); PG8_BAR; PG8_SCHED;
            PG8_LDB(B0, 1, 0); PG8_LDB(B1, 1, 1); PG8_SCHED; PG8_LDA(At, 1, 0); PG8_STAGE(PG8_SA(0, 1), a2 + hstep, voffA);
            PG8_WAIT_V(8); PG8_WAIT_L(0); PG8_BAR; PG8_MMA(0, 0, At, B0); PG8_MMA(0, 1, At, B1); PG8_BAR; PG8_SCHED;
            PG8_LDA(At, 1, 1); PG8_STAGE(PG8_SB(1, 0), b3, voffB); PG8_STAGE(PG8_SB(1, 1), b3 + hstep, voffB); PG8_STAGE(PG8_SA(1, 0), a3, voffA);
            PG8_WAIT_V(8); PG8_WAIT_L(0); PG8_BAR; PG8_MMA(1, 0, At, B0); PG8_MMA(1, 1, At, B1); PG8_BAR; PG8_SCHED;
            } else {
            PG8_LDB(B0, 0, 0); PG8_SCHED; PG8_LDA(At, 0, 0); PG8_STAGE(PG8_SA(1, 1), a1 + hstep, voffA);
            PG8_WAIT_L(8); PG8_BAR; PG8_WAIT_L(0); PG8_MMA(0, 0, At, B0); PG8_BAR; PG8_SCHED;
            PG8_LDB(B1, 0, 1); PG8_STAGE(PG8_SB(0, 0), b2, voffB);
            PG8_BAR; PG8_WAIT_L(0); PG8_MMA(0, 1, At, B1); PG8_BAR;
            PG8_LDA(At, 0, 1); PG8_STAGE(PG8_SA(0, 0), a2, voffA);
            PG8_BAR; PG8_WAIT_L(0); PG8_MMA(1, 0, At, B0); PG8_BAR; PG8_SCHED;
            PG8_STAGE(PG8_SB(0, 1), b2 + hstep, voffB);
            PG8_WAIT_V(6); PG8_BAR; PG8_MMA(1, 1, At, B1); PG8_BAR;
            PG8_LDB(B0, 1, 0); PG8_SCHED; PG8_LDA(At, 1, 0); PG8_STAGE(PG8_SA(0, 1), a2 + hstep, voffA);
            PG8_WAIT_L(8); PG8_BAR; PG8_WAIT_L(0); PG8_MMA(0, 0, At, B0); PG8_BAR; PG8_SCHED;
            PG8_LDB(B1, 1, 1); PG8_STAGE(PG8_SB(1, 0), b3, voffB);
            PG8_BAR; PG8_WAIT_L(0); PG8_MMA(0, 1, At, B1); PG8_BAR;
            PG8_LDA(At, 1, 1); PG8_STAGE(PG8_SA(1, 0), a3, voffA);
            PG8_BAR; PG8_WAIT_L(0); PG8_MMA(1, 0, At, B0); PG8_BAR; PG8_SCHED;
            PG8_STAGE(PG8_SB(1, 1), b3 + hstep, voffB);
            PG8_WAIT_V(6); PG8_BAR; PG8_MMA(1, 1, At, B1); PG8_BAR;
            }
        }
        if constexpr (ALIGN_EPI) { if (wr == 0) PG8_BAR; }
        if constexpr (!Epi::AFTER_DRAIN) { E(acc, cur, wr, wc, fr, fq); S.done(cur); }
        if (!has_next) break;
#pragma unroll
        for (int a = 0; a < 2; ++a)
#pragma unroll
            for (int b = 0; b < 2; ++b)
#pragma unroll
                for (int m = 0; m < 4; ++m)
#pragma unroll
                    for (int n = 0; n < 2; ++n) acc[a][b][m][n] = (f32x4){0.f, 0.f, 0.f, 0.f};
        cur = nxt; cA = nA; cB = nB; ++ui;
        if constexpr (ALIGN_EPI) { if (wr == 1) PG8_BAR; }
    }
    PG8_WAIT_V(0);
    if constexpr (!ALIGN_EPI) { if (wr == 0) PG8_BAR; }
    PG8_BAR;
#undef PG8_SA
#undef PG8_SB
#undef PG8_STAGE
#undef PG8_LDA
#undef PG8_LDB
#undef PG8_MMA
#undef PG8_WAIT_V
#undef PG8_WAIT_L
#undef PG8_BAR
#undef PG8_SCHED
}
}

#ifndef REP_P0
#define REP_P0 1
#endif
#ifndef REP_P1
#define REP_P1 1
#endif
#ifndef REP_P2
#define REP_P2 1
#endif
#ifndef REP_P3
#define REP_P3 1
#endif
#ifndef REP_P4
#define REP_P4 1
#endif
#ifndef REP_HG
#define REP_HG 1
#endif
#ifndef REP_AT
#define REP_AT 1
#endif
#ifndef REP_P6
#define REP_P6 1
#endif
#ifndef REP_P7
#define REP_P7 1
#endif
#ifndef PROBE_MULT
#define PROBE_MULT 8
#endif
#ifndef PG8_SP2
#define PG8_SP2 true
#endif
#ifndef PG8_ALIGN
#define PG8_ALIGN true
#endif

constexpr int NWAVES = 8;
constexpr int N_LAUNCHES = MK_N_LAUNCHES;
constexpr int PER_PHASE = 12;

constexpr int BATCH = 4, SEQ = 2048, D = 2048, FF = 5632, NGU = 2 * FF, NIN = 6656;
constexpr int M = BATCH * SEQ;
constexpr int HW = 1024, HH = 8, HD = 128;
constexpr int AH = 8, AKV = 2;
constexpr int CQH = 0, CIH = 1024, CFF = 2048, CFB = 3072, CGH = 4096, CQA = 5120, CKA = 6144, CVA = 6400;
constexpr float EPS = 1e-6f;

constexpr size_t MiB = 1u << 20;
constexpr size_t WS_CTL = 0, CTL_ZERO_BYTES = 32768;
constexpr size_t WS_W1GU = 2 * MiB, WS_W1D = 46 * MiB, WS_WIN = 68 * MiB, WS_WOUT = 94 * MiB, WS_W2GU = 102 * MiB, WS_W2D = 146 * MiB;
constexpr size_t WS_H = 168 * MiB;
constexpr size_t WS_ACT = 200 * MiB;
constexpr size_t WS_FF = 304 * MiB;
constexpr size_t WS_END = 368 * MiB;
constexpr int CW_BAR = 4096;
constexpr size_t WS_SSQ = 1 * MiB;

constexpr int RING_OFF = 0, RING_BYTES = 131072;
constexpr int LDSCTL_OFF = RING_BYTES, MISC_OFF = LDSCTL_OFF + 320;
constexpr int LDS_BYTES = 147456;

#define GAS __attribute__((address_space(1)))
#define LAS __attribute__((address_space(3)))
typedef unsigned short bf16;
typedef unsigned v4u __attribute__((ext_vector_type(4)));
typedef unsigned v2u __attribute__((ext_vector_type(2)));
typedef float f32x4 __attribute__((ext_vector_type(4)));
typedef short bf16x8 __attribute__((ext_vector_type(8)));
typedef short bf16x4 __attribute__((ext_vector_type(4)));
typedef GAS unsigned gu32;
#define RLX_AGENT __ATOMIC_RELAXED, __HIP_MEMORY_SCOPE_AGENT
#define LDS_WAIT() asm volatile("s_waitcnt lgkmcnt(0)" ::: "memory")
#define VM_WAIT() asm volatile("s_waitcnt vmcnt(0)" ::: "memory")
__device__ __forceinline__ unsigned f2bf(float f) { unsigned u = __builtin_bit_cast(unsigned, f); return (u + 0x7fffu + ((u >> 16) & 1u)) >> 16; }
__device__ __forceinline__ unsigned pk2(float lo, float hi) { return pg8::cvt_pk_bf16(lo, hi); }
__device__ __forceinline__ float bf_lo(unsigned u) { return __builtin_bit_cast(float, u << 16); }
__device__ __forceinline__ float bf_hi(unsigned u) { return __builtin_bit_cast(float, u & 0xffff0000u); }

#define XB_TMO      128
#define XB_XCNT(j)  (256  + 64 * (j))
#define XB_XSUB(j)  (1280 + 64 * (j))
#define XB_XGEN(j)  (2304 + 64 * (j))
#define XB_TOP      3328
#define XB_TOPGEN   3392
#define XCD_BAR_WORDS 3456
#define XB_SPIN_CAP (1u << 20)

__device__ __forceinline__ unsigned xb_ld(unsigned* p)              { return __hip_atomic_load(p, __ATOMIC_RELAXED, __HIP_MEMORY_SCOPE_AGENT); }
__device__ __forceinline__ unsigned xb_add(unsigned* p, unsigned v) { return __hip_atomic_fetch_add(p, v, __ATOMIC_RELAXED, __HIP_MEMORY_SCOPE_AGENT); }
__device__ __forceinline__ unsigned xb_xcc_id() { return (unsigned)__builtin_amdgcn_s_getreg((3 << 11) | 20) & 0xFu; }
#define XB_SPIN(cond, bar) do { unsigned _sp = 0; while (cond) { __builtin_amdgcn_s_sleep(1); \
    if ((++_sp & 255u) == 0u) { if (xb_ld(&(bar)[XB_TMO])) break; if (_sp > XB_SPIN_CAP) { atomicAdd(&(bar)[XB_TMO], 1u); break; } } } } while (0)

struct XcdBarrier { unsigned* bar; unsigned x; volatile LAS unsigned* st; };

__device__ __forceinline__ XcdBarrier xcd_barrier_post(unsigned* bar, volatile LAS unsigned* st) {
    XcdBarrier b; b.bar = bar; b.x = xb_xcc_id(); b.st = st;
    if (threadIdx.x == 0) (void)xb_add(&bar[XB_XCNT(b.x)], 1u);
    return b;
}
__device__ __forceinline__ void xcd_barrier_complete(unsigned* bar, unsigned x, unsigned& nloc, unsigned& nx) {
    const unsigned G = gridDim.x * gridDim.y * gridDim.z;
    unsigned sum, cnt, mine, sp = 0u;
    for (;;) {
        sum = 0u; cnt = 0u; mine = 0u;
#pragma unroll
        for (unsigned j = 0; j < 16; ++j) { const unsigned c = xb_ld(&bar[XB_XCNT(j)]); sum += c; cnt += (c > 0u) ? 1u : 0u; mine = (j == x) ? c : mine; }
        if (sum == G) break;
        __builtin_amdgcn_s_sleep(1);
        if ((++sp & 255u) == 0u) { if (xb_ld(&bar[XB_TMO])) break; if (sp > XB_SPIN_CAP) { atomicAdd(&bar[XB_TMO], 1u); break; } }
    }
    nloc = mine > 0u ? mine : 1u; nx = cnt > 0u ? cnt : 1u;
}
__device__ __forceinline__ void xcd_barrier(const XcdBarrier& b) {
    asm volatile("s_waitcnt vmcnt(0)" ::: "memory");
    __syncthreads();
    if (threadIdx.x == 0) {
        unsigned* bar = b.bar;
        __builtin_amdgcn_s_waitcnt(0);
        unsigned nloc = b.st[0], nx = b.st[1];
        if (nloc == 0u) { xcd_barrier_complete(bar, b.x, nloc, nx); b.st[0] = nloc; b.st[1] = nx; }
        const unsigned old = xb_add(&bar[XB_XSUB(b.x)], 1u);
        const unsigned gen = old / nloc;
        if (old + 1u == (gen + 1u) * nloc) {
            __builtin_amdgcn_fence(__ATOMIC_RELEASE, "agent");
            asm volatile("s_waitcnt vmcnt(0)" ::: "memory");
            const unsigned og = xb_add(&bar[XB_TOP], 1u);
            const unsigned tg = og / nx;
            if (og + 1u == (tg + 1u) * nx) xb_add(&bar[XB_TOPGEN], 1u);
            else XB_SPIN(xb_ld(&bar[XB_TOPGEN]) == tg, bar);
            __builtin_amdgcn_fence(__ATOMIC_ACQUIRE, "agent");
            xb_add(&bar[XB_XGEN(b.x)], 1u);
            asm volatile("s_waitcnt vmcnt(0)" ::: "memory");
        } else {
            XB_SPIN(xb_ld(&bar[XB_XGEN(b.x)]) == gen, bar);
            __builtin_amdgcn_fence(__ATOMIC_ACQUIRE, "agent");
            asm volatile("s_waitcnt vmcnt(0)" ::: "memory");
        }
    }
    __syncthreads();
}

struct Frame {
    LAS unsigned char* lds;
    volatile LAS unsigned* MISC;
    gu32* ctl;
    int tid, lane, wave;
    int vcu, G;
    const float* x; float* out;
    const float *pre1, *post1, *w1gu, *w1d, *prem, *postm, *win, *lbf, *lbb, *ognorm, *sink, *wout, *pre2, *post2, *w2gu, *w2d, *relb;
    bf16 *W1GU, *W1D, *WIN, *WOUT, *W2GU, *W2D;
    bf16 *H, *ACT, *FFB, *XR; float* SLB; float* ssq;
};

__device__ __forceinline__ float wave_sum(float v) {
#pragma unroll
    for (int o = 1; o < 64; o <<= 1) v += __shfl_xor(v, o);
    return v;
}
struct CvItem { const float* src; bf16* dst; int K, N; };
__device__ __forceinline__ CvItem cv_item(const float* W, int K, int N, bf16* WT, bool gu, int item) {
    const int nblk = N / 32, kb = item / nblk, nb = item % nblk, k0 = 64 * kb, n0 = 32 * nb;
    int r0 = n0;
    if (gu) { const int half = N / 2; const int nn = n0 < half ? n0 : n0 - half; r0 = 256 * (nn / 128) + (nn % 128) + (n0 < half ? 0 : 128); }
    CvItem c; c.src = W + (size_t)k0 * N + n0; c.dst = WT + (size_t)r0 * K + k0; c.K = K; c.N = N; return c;
}
constexpr int I_GU = (D / 64) * (NGU / 32), I_DN = (FF / 64) * (D / 32), I_IN = (D / 64) * (NIN / 32), I_OUT = (D / 64) * (D / 32);
template <int LIST>
__device__ __forceinline__ CvItem cv_list_item(Frame& F, int r) {
    if (LIST == 0) return cv_item(F.w1gu, D, NGU, F.W1GU, true, r);
    if (LIST == 1) { if (r < I_DN) return cv_item(F.w1d, FF, D, F.W1D, false, r); r -= I_DN; if (r < I_IN) return cv_item(F.win, D, NIN, F.WIN, false, r); r -= I_IN; return cv_item(F.wout, D, D, F.WOUT, false, r); }
    if (LIST == 2) return cv_item(F.w2gu, D, NGU, F.W2GU, true, r);
    return cv_item(F.w2d, FF, D, F.W2D, false, r);
}
template <int LIST>
__device__ __forceinline__ void convert_list(Frame& F, int worker, int nworkers) {
    LAS float* scr = (LAS float*)(F.lds + RING_OFF + F.wave * 16384);
    constexpr int NITEMS = LIST == 0 ? I_GU : (LIST == 1 ? I_DN + I_IN + I_OUT : (LIST == 2 ? I_GU : I_DN));
    const int lane = F.lane;
    int it = worker; if (it >= NITEMS) return;
    CvItem cur = cv_list_item<LIST>(F, it);
    float r[32];
#pragma unroll
    for (int i = 0; i < 32; ++i) r[i] = __builtin_nontemporal_load(cur.src + (size_t)(2 * i + (lane >> 5)) * cur.N + (lane & 31));
    for (;;) {
#pragma unroll
        for (int i = 0; i < 32; ++i) scr[(2 * i + (lane >> 5)) * 33 + (lane & 31)] = r[i];
        const int nxt = it + nworkers; const bool has = nxt < NITEMS; CvItem nd = cur;
        if (has) { nd = cv_list_item<LIST>(F, nxt);
#pragma unroll
            for (int i = 0; i < 32; ++i) r[i] = __builtin_nontemporal_load(nd.src + (size_t)(2 * i + (lane >> 5)) * nd.N + (lane & 31)); }
        LDS_WAIT(); asm volatile("" ::: "memory");
        const int c = lane & 7;
#pragma unroll
        for (int j = 0; j < 4; ++j) { const int n = (lane >> 3) + 8 * j; const LAS float* sp = scr + (8 * c) * 33 + n;
            v4u o; o.x = pk2(sp[0 * 33], sp[1 * 33]); o.y = pk2(sp[2 * 33], sp[3 * 33]); o.z = pk2(sp[4 * 33], sp[5 * 33]); o.w = pk2(sp[6 * 33], sp[7 * 33]);
            *(GAS v4u*)(cur.dst + (size_t)n * cur.K + 8 * c) = o; }
        LDS_WAIT(); asm volatile("" ::: "memory");
        if (!has) break;
        cur = nd; it = nxt;
    }
}
__device__ __forceinline__ void rms_rows_to_bf16(int lane, const float* x, const float* gain, bf16* out, int first, int stride) {
    if (first >= M) return;
    f32x4 v[8];
#pragma unroll
    for (int j = 0; j < 8; ++j) v[j] = __builtin_nontemporal_load((const GAS f32x4*)(x + (size_t)first * D + 8 * (lane + 64 * (j >> 1)) + 4 * (j & 1)));
    for (int m = first; m < M; m += stride) {
        f32x4 c[8]; float s = 0.f;
#pragma unroll
        for (int j = 0; j < 8; ++j) { c[j] = v[j]; s += (c[j].x * c[j].x + c[j].y * c[j].y) + (c[j].z * c[j].z + c[j].w * c[j].w); }
        if (m + stride < M) {
#pragma unroll
            for (int j = 0; j < 8; ++j) v[j] = __builtin_nontemporal_load((const GAS f32x4*)(x + (size_t)(m + stride) * D + 8 * (lane + 64 * (j >> 1)) + 4 * (j & 1))); }
        const float rs = 1.0f / sqrtf(wave_sum(s) * (1.f / D) + EPS);
#pragma unroll
        for (int j = 0; j < 4; ++j) { const f32x4 g0 = *(const GAS f32x4*)(gain + 8 * (lane + 64 * j)), g1 = *(const GAS f32x4*)(gain + 8 * (lane + 64 * j) + 4); const f32x4 c0 = c[2 * j], c1 = c[2 * j + 1];
            v4u o; o.x = pk2(c0.x * rs * g0.x, c0.y * rs * g0.y); o.y = pk2(c0.z * rs * g0.z, c0.w * rs * g0.w); o.z = pk2(c1.x * rs * g1.x, c1.y * rs * g1.y); o.w = pk2(c1.z * rs * g1.z, c1.w * rs * g1.w);
            *(GAS v4u*)(out + (size_t)m * D + 8 * (lane + 64 * j)) = o; }
    }
}
__device__ __forceinline__ void p0_prologue(Frame& F) {
    const int gw = F.vcu * NWAVES + F.wave, NGW = F.G * NWAVES;
    convert_list<0>(F, gw, NGW);
    rms_rows_to_bf16(F.lane, F.x, F.pre1, F.H, gw, NGW);
}
__device__ __forceinline__ void unpack8(const v4u t, float (&o)[8]) { o[0] = bf_lo(t.x); o[1] = bf_hi(t.x); o[2] = bf_lo(t.y); o[3] = bf_hi(t.y); o[4] = bf_lo(t.z); o[5] = bf_hi(t.z); o[6] = bf_lo(t.w); o[7] = bf_hi(t.w); }
template <bool XIN_F32, bool XOUT_F32>
__device__ __forceinline__ void ew_phase(Frame& F, const void* xi, const bf16* ff, const float* ssq, const float* post, float coef, void* xo, const float* pre, bf16* h) {
    const int gw = F.vcu * NWAVES + F.wave, NGW = F.G * NWAVES, lane = F.lane;
    for (int m = gw; m < M; m += NGW) {
        const float part = (lane < 32) ? ssq[m * 32 + lane] : 0.f;
        const float rs = coef / sqrtf(wave_sum(part) * (1.f / D) + EPS);
        float v[4][8]; float s = 0.f;
#pragma unroll
        for (int j = 0; j < 4; ++j) { const size_t e0 = (size_t)m * D + 8 * (lane + 64 * j); float a[8], b[8];
            if (XIN_F32) { const f32x4 a0 = __builtin_nontemporal_load((const GAS f32x4*)((const float*)xi + e0)), a1 = __builtin_nontemporal_load((const GAS f32x4*)((const float*)xi + e0 + 4));
                a[0] = a0.x; a[1] = a0.y; a[2] = a0.z; a[3] = a0.w; a[4] = a1.x; a[5] = a1.y; a[6] = a1.z; a[7] = a1.w; }
            else unpack8(__builtin_nontemporal_load((const GAS v4u*)((const bf16*)xi + e0)), a);
            unpack8(__builtin_nontemporal_load((const GAS v4u*)(ff + e0)), b);
            const f32x4 g0 = *(const GAS f32x4*)(post + 8 * (lane + 64 * j)), g1 = *(const GAS f32x4*)(post + 8 * (lane + 64 * j) + 4);
            const float gg[8] = {g0.x, g0.y, g0.z, g0.w, g1.x, g1.y, g1.z, g1.w};
#pragma unroll
            for (int e = 0; e < 8; ++e) v[j][e] = a[e] + b[e] * gg[e] * rs;
            if (XOUT_F32) { __builtin_nontemporal_store((f32x4){v[j][0], v[j][1], v[j][2], v[j][3]}, (GAS f32x4*)((float*)xo + e0)); __builtin_nontemporal_store((f32x4){v[j][4], v[j][5], v[j][6], v[j][7]}, (GAS f32x4*)((float*)xo + e0 + 4)); }
            else { v4u o; o.x = pk2(v[j][0], v[j][1]); o.y = pk2(v[j][2], v[j][3]); o.z = pk2(v[j][4], v[j][5]); o.w = pk2(v[j][6], v[j][7]);
                   __builtin_nontemporal_store(o, (GAS v4u*)((bf16*)xo + e0)); unpack8(o, v[j]); }
#pragma unroll
            for (int e = 0; e < 8; ++e) s += v[j][e] * v[j][e]; }
        if (h) {
            const float r2 = 1.0f / sqrtf(wave_sum(s) * (1.f / D) + EPS);
#pragma unroll
            for (int j = 0; j < 4; ++j) { const f32x4 g0 = *(const GAS f32x4*)(pre + 8 * (lane + 64 * j)), g1 = *(const GAS f32x4*)(pre + 8 * (lane + 64 * j) + 4);
                v4u o; o.x = pk2(v[j][0] * r2 * g0.x, v[j][1] * r2 * g0.y); o.y = pk2(v[j][2] * r2 * g0.z, v[j][3] * r2 * g0.w); o.z = pk2(v[j][4] * r2 * g1.x, v[j][5] * r2 * g1.y); o.w = pk2(v[j][6] * r2 * g1.z, v[j][7] * r2 * g1.w);
                *(GAS v4u*)(h + (size_t)m * D + 8 * (lane + 64 * j)) = o; }
        }
    }
}

__device__ __forceinline__ bf16x8 ldsfrag(LAS unsigned char* base, int row, int stride, int kbyte) { return *(const LAS bf16x8*)(base + row * stride + kbyte); }
constexpr int H2_QD = 0, H2_KD = 17408, H2_KT0 = 34816, H2_KT1 = 53248, H2_VT0 = 71680, H2_VT1 = 90112, H2_PS = 108544, H2_DEC0 = 117760, H2_DEC1 = 118272, H2_RED = 118784, H2_LB = 126976, H2_END = 127488;
static_assert(H2_END <= RING_BYTES, "HGRN LDS map");
static_assert((CW_BAR + 3456) * 4 <= (int)CTL_ZERO_BYTES, "barrier words inside the memset region");
__device__ __forceinline__ void wave_scan_mul8(float (&v)[8]) {
#define SCAN_ROUND(ctrl) \
    "v_mul_f32_dpp %0, %0, %0 " ctrl "\n\tv_mul_f32_dpp %1, %1, %1 " ctrl "\n\tv_mul_f32_dpp %2, %2, %2 " ctrl "\n\tv_mul_f32_dpp %3, %3, %3 " ctrl "\n\t" \
    "v_mul_f32_dpp %4, %4, %4 " ctrl "\n\tv_mul_f32_dpp %5, %5, %5 " ctrl "\n\tv_mul_f32_dpp %6, %6, %6 " ctrl "\n\tv_mul_f32_dpp %7, %7, %7 " ctrl "\n\t"
    asm volatile("s_nop 1\n\t"
        SCAN_ROUND("row_shr:1 row_mask:0xf bank_mask:0xf") SCAN_ROUND("row_shr:2 row_mask:0xf bank_mask:0xf") SCAN_ROUND("row_shr:4 row_mask:0xf bank_mask:0xf")
        SCAN_ROUND("row_shr:8 row_mask:0xf bank_mask:0xf") SCAN_ROUND("row_bcast:15 row_mask:0xa bank_mask:0xf") SCAN_ROUND("row_bcast:31 row_mask:0xc bank_mask:0xf")
        "s_nop 1"
        : "+v"(v[0]), "+v"(v[1]), "+v"(v[2]), "+v"(v[3]), "+v"(v[4]), "+v"(v[5]), "+v"(v[6]), "+v"(v[7]));
#undef SCAN_ROUND
}
template <bool FULL>
__device__ __forceinline__ void hg_stage(LAS unsigned char* L, int ktoff, int decoff, int w, int l, bool bwd, const v4u (&zr)[2], const v4u (&qr)[2], float (&el)[16]) {
#pragma unroll
    for (int hh = 0; hh < 2; ++hh) {
        float f[8], kk[8], E[8], lbv[8];
        { const f32x4 l0 = *(const LAS f32x4*)(L + H2_LB + (16 * w + 8 * hh) * 4), l1 = *(const LAS f32x4*)(L + H2_LB + (16 * w + 8 * hh + 4) * 4);
          lbv[0] = l0[0]; lbv[1] = l0[1]; lbv[2] = l0[2]; lbv[3] = l0[3]; lbv[4] = l1[0]; lbv[5] = l1[1]; lbv[6] = l1[2]; lbv[7] = l1[3]; }
#pragma unroll
        for (int i = 0; i < 8; ++i) { const unsigned zw = zr[hh][i >> 1]; const float z = (i & 1) ? bf_hi(zw) : bf_lo(zw);
            const float sig = __builtin_amdgcn_rcpf(1.0f + __builtin_amdgcn_exp2f(-1.4426950408889634f * z)); f[i] = lbv[i] + (1.0f - lbv[i]) * sig; kk[i] = 1.0f - f[i]; }
#pragma unroll
        for (int i = 0; i < 8; ++i) E[i] = f[i];
        wave_scan_mul8(E);
        float qd[8], kd[8], kt[8];
#pragma unroll
        for (int i = 0; i < 8; ++i) { const float last = __builtin_bit_cast(float, __builtin_amdgcn_readlane(__builtin_bit_cast(int, E[i]), 63)); el[8 * hh + i] = last;
            const float rE = __builtin_amdgcn_rcpf(E[i]); const float C = bwd ? last * f[i] * rE : E[i]; const float Cinv = bwd ? __builtin_amdgcn_rcpf(C) : rE;
            kd[i] = kk[i] * Cinv; kt[i] = kd[i] * last;
            if (FULL) { const unsigned qw = qr[hh][i >> 1]; const float q = (i & 1) ? bf_hi(qw) : bf_lo(qw); qd[i] = q * C; } }
        if (FULL) { v4u a;
            a.x = pk2(qd[0], qd[1]); a.y = pk2(qd[2], qd[3]); a.z = pk2(qd[4], qd[5]); a.w = pk2(qd[6], qd[7]);
            *(LAS v4u*)(L + H2_QD + l * 272 + 32 * w + 16 * hh) = a;
            a.x = pk2(kd[0], kd[1]); a.y = pk2(kd[2], kd[3]); a.z = pk2(kd[4], kd[5]); a.w = pk2(kd[6], kd[7]);
            *(LAS v4u*)(L + H2_KD + l * 272 + 32 * w + 16 * hh) = a; }
#pragma unroll
        for (int i = 0; i < 8; i += 2) { const unsigned pw = pk2(kt[i], kt[i + 1]);
            *(LAS unsigned short*)(L + ktoff + (16 * w + 8 * hh + i) * 144 + 2 * l) = (unsigned short)(pw & 0xffffu); *(LAS unsigned short*)(L + ktoff + (16 * w + 8 * hh + i + 1) * 144 + 2 * l) = (unsigned short)(pw >> 16); }
        if (l == 0) {
#pragma unroll
            for (int i = 0; i < 8; ++i) *(LAS float*)(L + decoff + (16 * w + 8 * hh + i) * 4) = el[8 * hh + i];
        }
    }
}
__device__ __forceinline__ void hg_write_lb(LAS unsigned char* L, const float* lbf, const float* lbb, bool bwd, int h, int w, int l) {
    if (l < 16) { const int i0 = h * 128 + 16 * w + l; const float f0 = lbf[i0], f1 = lbf[HW + i0], b0 = lbb[i0], b1 = lbb[HW + i0];
        const float a0 = bwd ? b0 : f0, a1 = bwd ? b1 : f1; *(LAS float*)(L + H2_LB + (16 * w + l) * 4) = 1.0f / (1.0f + __expf(a1 - a0)); }
}
__device__ __forceinline__ void hg_stage_v(LAS unsigned char* L, int vtoff, int w, int l, const v4u (&vr)[2]) {
#pragma unroll
    for (int i = 0; i < 8; ++i) { const unsigned vw = vr[i >> 2][i & 3];
        *(LAS unsigned short*)(L + vtoff + (16 * w + 2 * i) * 144 + 2 * l) = (unsigned short)(vw & 0xffffu); *(LAS unsigned short*)(L + vtoff + (16 * w + 2 * i + 1) * 144 + 2 * l) = (unsigned short)(vw >> 16); }
}
__device__ __forceinline__ void hg_state_update(LAS unsigned char* L, int ktoff, int vtoff, int decoff, int w, int g, int fr, f32x4 (&S)[8]) {
    bf16x8 vf[2];
#pragma unroll
    for (int k2 = 0; k2 < 2; ++k2) vf[k2] = ldsfrag(L + vtoff, 16 * w + fr, 144, 64 * k2 + 16 * g);
#pragma unroll
    for (int kt = 0; kt < 8; ++kt) { const f32x4 d4 = *(const LAS f32x4*)(L + decoff + (16 * kt + 4 * g) * 4); S[kt] = S[kt] * d4;
#pragma unroll
        for (int k2 = 0; k2 < 2; ++k2) S[kt] = __builtin_amdgcn_mfma_f32_16x16x32_bf16(ldsfrag(L + ktoff, 16 * kt + fr, 144, 64 * k2 + 16 * g), vf[k2], S[kt], 0, 0, 0); }
}
__device__ __forceinline__ size_t hg_slot(int dir, int b, int h, int sc) { return (size_t)(((dir * BATCH + b) * HH + h) * 8 + sc); }

struct HgIn { v4u z[2], q[2], v[2]; };
template <bool FULL>
__device__ __forceinline__ void hg_load(HgIn& r, const bf16* P, int b, int h, int w, int l, int cn, bool bwd) {
    const bf16* row = P + (size_t)(b * SEQ + cn * 64 + l) * NIN;
    const int colz = (bwd ? CFB : CFF) + h * 128 + 16 * w, colv = CIH + h * 128 + 16 * w, colq = CQH + h * 128 + 16 * w;
    r.z[0] = *(const GAS v4u*)(row + colz); r.z[1] = *(const GAS v4u*)(row + colz + 8); r.v[0] = *(const GAS v4u*)(row + colv); r.v[1] = *(const GAS v4u*)(row + colv + 8);
    if (FULL) { r.q[0] = *(const GAS v4u*)(row + colq); r.q[1] = *(const GAS v4u*)(row + colq + 8); } else { r.q[0] = r.z[0]; r.q[1] = r.z[1]; }
}
constexpr int P1_KTF = 0, P1_KTB = 18432, P1_VT = 36864, P1_DEC = 55296, P1_BUF = 55808, P1_LBF = 111616, P1_LBB = 112128, P1_END = 112640;
static_assert(P1_END <= RING_BYTES, "pass-1 LDS map");
__device__ __forceinline__ void hg_stage_p1(LAS unsigned char* L, int boff, int w, int l, const v4u (&zf)[2], const v4u (&zb)[2], float (&pb)[16], float (&dtf)[16]) {
#pragma unroll
    for (int hh = 0; hh < 2; ++hh) {
        float ff[8], fb[8], Ef[8], Eb[8];
        { const f32x4 a0 = *(const LAS f32x4*)(L + P1_LBF + (16 * w + 8 * hh) * 4), a1 = *(const LAS f32x4*)(L + P1_LBF + (16 * w + 8 * hh + 4) * 4);
          const f32x4 b0 = *(const LAS f32x4*)(L + P1_LBB + (16 * w + 8 * hh) * 4), b1 = *(const LAS f32x4*)(L + P1_LBB + (16 * w + 8 * hh + 4) * 4);
          const float lf[8] = {a0[0], a0[1], a0[2], a0[3], a1[0], a1[1], a1[2], a1[3]}, lbk[8] = {b0[0], b0[1], b0[2], b0[3], b1[0], b1[1], b1[2], b1[3]};
#pragma unroll
          for (int i = 0; i < 8; ++i) { const unsigned zw = zf[hh][i >> 1], yw = zb[hh][i >> 1]; const float z = (i & 1) ? bf_hi(zw) : bf_lo(zw), y = (i & 1) ? bf_hi(yw) : bf_lo(yw);
              ff[i] = lf[i] + (1.0f - lf[i]) * __builtin_amdgcn_rcpf(1.0f + __builtin_amdgcn_exp2f(-1.4426950408889634f * z));
              fb[i] = lbk[i] + (1.0f - lbk[i]) * __builtin_amdgcn_rcpf(1.0f + __builtin_amdgcn_exp2f(-1.4426950408889634f * y)); Ef[i] = ff[i]; Eb[i] = fb[i]; } }
        wave_scan_mul8(Ef); wave_scan_mul8(Eb);
        float ktf[8], ktb[8];
#pragma unroll
        for (int i = 0; i < 8; ++i) { const float lastf = __builtin_bit_cast(float, __builtin_amdgcn_readlane(__builtin_bit_cast(int, Ef[i]), 63)), lastb = __builtin_bit_cast(float, __builtin_amdgcn_readlane(__builtin_bit_cast(int, Eb[i]), 63));
            ktf[i] = (1.0f - ff[i]) * lastf * __builtin_amdgcn_rcpf(Ef[i]);
            ktb[i] = (1.0f - fb[i]) * Eb[i] * __builtin_amdgcn_rcpf(fb[i]) * pb[8 * hh + i];
            pb[8 * hh + i] *= lastb; dtf[8 * hh + i] = lastf; }
#pragma unroll
        for (int i = 0; i < 8; i += 2) { const unsigned pf = pk2(ktf[i], ktf[i + 1]), pq = pk2(ktb[i], ktb[i + 1]); const int ro = (16 * w + 8 * hh + i) * 144 + 2 * l;
            *(LAS unsigned short*)(L + boff + P1_KTF + ro) = (unsigned short)(pf & 0xffffu); *(LAS unsigned short*)(L + boff + P1_KTF + ro + 144) = (unsigned short)(pf >> 16);
            *(LAS unsigned short*)(L + boff + P1_KTB + ro) = (unsigned short)(pq & 0xffffu); *(LAS unsigned short*)(L + boff + P1_KTB + ro + 144) = (unsigned short)(pq >> 16); }
        if (l == 0) {
#pragma unroll
            for (int i = 0; i < 8; ++i) *(LAS float*)(L + boff + P1_DEC + (16 * w + 8 * hh + i) * 4) = dtf[8 * hh + i];
        }
    }
}
__device__ __forceinline__ void hgrn_pass1(Frame& F, const bf16* P, float* SL, float* DL) {
    LAS unsigned char* L = F.lds + RING_OFF;
    const int w = F.wave, l = F.lane, g = l >> 4, fr = l & 15;
    for (int item = F.vcu; item < 256; item += F.G) { const int b = item >> 6, h = (item >> 3) & 7, sc = item & 7;
        if (l < 16) { const int i0 = h * 128 + 16 * w + l;
            *(LAS float*)(L + P1_LBF + (16 * w + l) * 4) = 1.0f / (1.0f + __expf(F.lbf[HW + i0] - F.lbf[i0])); *(LAS float*)(L + P1_LBB + (16 * w + l) * 4) = 1.0f / (1.0f + __expf(F.lbb[HW + i0] - F.lbb[i0])); }
        const int colzf = CFF + h * 128 + 16 * w, colzb = CFB + h * 128 + 16 * w, colv = CIH + h * 128 + 16 * w;
        v4u zf[2], zb[2], vr[2];
        {   const bf16* row = P + (size_t)(b * SEQ + sc * 256 + l) * NIN;
            zf[0] = *(const GAS v4u*)(row + colzf); zf[1] = *(const GAS v4u*)(row + colzf + 8); zb[0] = *(const GAS v4u*)(row + colzb); zb[1] = *(const GAS v4u*)(row + colzb + 8);
            vr[0] = *(const GAS v4u*)(row + colv); vr[1] = *(const GAS v4u*)(row + colv + 8); }
        f32x4 Sf[8], Sb[8]; float pb[16], dtot[16];
#pragma unroll
        for (int kt = 0; kt < 8; ++kt) { Sf[kt] = (f32x4){0.f, 0.f, 0.f, 0.f}; Sb[kt] = (f32x4){0.f, 0.f, 0.f, 0.f}; }
#pragma unroll
        for (int i = 0; i < 16; ++i) { pb[i] = 1.0f; dtot[i] = 1.0f; }
        for (int n = 0; n < 4; ++n) { const int boff = (n & 1) * P1_BUF;
            float dtf[16];
            hg_stage_v(L, boff + P1_VT, w, l, vr);
            hg_stage_p1(L, boff, w, l, zf, zb, pb, dtf);
#pragma unroll
            for (int i = 0; i < 16; ++i) dtot[i] *= dtf[i];
            if (n + 1 < 4) { const bf16* row = P + (size_t)(b * SEQ + sc * 256 + (n + 1) * 64 + l) * NIN;
                zf[0] = *(const GAS v4u*)(row + colzf); zf[1] = *(const GAS v4u*)(row + colzf + 8); zb[0] = *(const GAS v4u*)(row + colzb); zb[1] = *(const GAS v4u*)(row + colzb + 8);
                vr[0] = *(const GAS v4u*)(row + colv); vr[1] = *(const GAS v4u*)(row + colv + 8); }
            __syncthreads();
            bf16x8 vf[2];
#pragma unroll
            for (int k2 = 0; k2 < 2; ++k2) vf[k2] = ldsfrag(L + boff + P1_VT, 16 * w + fr, 144, 64 * k2 + 16 * g);
#pragma unroll
            for (int kt = 0; kt < 8; ++kt) { const f32x4 d4 = *(const LAS f32x4*)(L + boff + P1_DEC + (16 * kt + 4 * g) * 4); Sf[kt] = Sf[kt] * d4;
#pragma unroll
                for (int k2 = 0; k2 < 2; ++k2) { Sf[kt] = __builtin_amdgcn_mfma_f32_16x16x32_bf16(ldsfrag(L + boff + P1_KTF, 16 * kt + fr, 144, 64 * k2 + 16 * g), vf[k2], Sf[kt], 0, 0, 0);
                                                 Sb[kt] = __builtin_amdgcn_mfma_f32_16x16x32_bf16(ldsfrag(L + boff + P1_KTB, 16 * kt + fr, 144, 64 * k2 + 16 * g), vf[k2], Sb[kt], 0, 0, 0); } }
        }
        const size_t slf = hg_slot(0, b, h, sc), slb = hg_slot(1, b, h, sc);
#pragma unroll
        for (int kt = 0; kt < 8; ++kt) { *(GAS f32x4*)(SL + slf * 16384 + (size_t)((kt * 8 + w) * 64 + l) * 4) = Sf[kt]; *(GAS f32x4*)(SL + slb * 16384 + (size_t)((kt * 8 + w) * 64 + l) * 4) = Sb[kt]; }
        if (l == 0) {
#pragma unroll
            for (int i = 0; i < 16; ++i) { DL[slf * 128 + 16 * w + i] = dtot[i]; DL[slb * 128 + 16 * w + i] = pb[i]; }
        }
        __syncthreads();
    }
}

__device__ __forceinline__ void hgrn_pass2_compute(LAS unsigned char* L, int w, int g, int fr, bool bwd, int vtoff, f32x4 (&S)[8], f32x4 (&o)[4]) {
    {   const int ct = w >> 1, sh = w & 1;
        bf16x8 qfr[4];
#pragma unroll
        for (int ks = 0; ks < 4; ++ks) qfr[ks] = ldsfrag(L + H2_QD, 16 * ct + fr, 272, 64 * ks + 16 * g);
#pragma unroll
        for (int t2 = 0; t2 < 2; ++t2) { const int st = 2 * sh + t2; f32x4 sc4 = (f32x4){0.f, 0.f, 0.f, 0.f};
#pragma unroll
            for (int ks = 0; ks < 4; ++ks) sc4 = __builtin_amdgcn_mfma_f32_16x16x32_bf16(ldsfrag(L + H2_KD, 16 * st + fr, 272, 64 * ks + 16 * g), qfr[ks], sc4, 0, 0, 0);
            const int c = 16 * ct + fr, s0 = 16 * st + 4 * g;
            float m[4];
#pragma unroll
            for (int r = 0; r < 4; ++r) { const bool keep = bwd ? (s0 + r >= c) : (s0 + r <= c); m[r] = keep ? sc4[r] : 0.f; }
            v2u pw; pw.x = pk2(m[0], m[1]); pw.y = pk2(m[2], m[3]);
            *(LAS v2u*)(L + H2_PS + c * 144 + 2 * s0) = pw; } }
    {   bf16x8 sa[4];
#pragma unroll
        for (int k2 = 0; k2 < 4; ++k2) { v4u t; t.x = pk2(S[2 * k2][0], S[2 * k2][1]); t.y = pk2(S[2 * k2][2], S[2 * k2][3]); t.z = pk2(S[2 * k2 + 1][0], S[2 * k2 + 1][1]); t.w = pk2(S[2 * k2 + 1][2], S[2 * k2 + 1][3]); sa[k2] = __builtin_bit_cast(bf16x8, t); }
#pragma unroll
        for (int ct = 0; ct < 4; ++ct) { const LAS unsigned char* qrow = L + H2_QD + (16 * ct + fr) * 272; o[ct] = (f32x4){0.f, 0.f, 0.f, 0.f};
#pragma unroll
            for (int k2 = 0; k2 < 4; ++k2) { const v2u b0 = *(const LAS v2u*)(qrow + 2 * (32 * k2 + 4 * g)), b1 = *(const LAS v2u*)(qrow + 2 * (32 * k2 + 16 + 4 * g));
                const v4u bv = (v4u){b0.x, b0.y, b1.x, b1.y};
                o[ct] = __builtin_amdgcn_mfma_f32_16x16x32_bf16(sa[k2], __builtin_bit_cast(bf16x8, bv), o[ct], 0, 0, 0); } } }
    hg_state_update(L, H2_KT0, vtoff, H2_DEC0, w, g, fr, S);
    __syncthreads();
    {   bf16x8 vf[2];
#pragma unroll
        for (int k2 = 0; k2 < 2; ++k2) vf[k2] = ldsfrag(L + vtoff, 16 * w + fr, 144, 64 * k2 + 16 * g);
#pragma unroll
        for (int ct = 0; ct < 4; ++ct)
#pragma unroll
            for (int k2 = 0; k2 < 2; ++k2) o[ct] = __builtin_amdgcn_mfma_f32_16x16x32_bf16(vf[k2], ldsfrag(L + H2_PS, 16 * ct + fr, 144, 64 * k2 + 16 * g), o[ct], 0, 0, 0); }
}
__device__ __forceinline__ void hgrn_pass2(Frame& F, const bf16* P, const float* SL, const float* DL, float* OFW, bf16* Y) {
    LAS unsigned char* L = F.lds + RING_OFF;
    const int w = F.wave, l = F.lane, g = l >> 4, fr = l & 15;
    LAS float* RED = (LAS float*)(L + H2_RED);
    for (int item = F.vcu; item < 256; item += F.G) { const int b = item >> 6, h = (item >> 3) & 7, sc = item & 7;
        HgIn in; hg_load<true>(in, P, b, h, w, l, sc * 4, false);
        const f32x4 gn = *(const GAS f32x4*)(F.ognorm + h * 128 + 16 * w + 4 * g);
        f32x4 S[8];
        for (int t = 0; t < 8; ++t) { const bool bwd = t >= 4; const int n = t & 3, j = bwd ? 3 - n : n, dir = bwd ? 1 : 0;
            if (n == 0) {
                if (bwd) { asm volatile("s_waitcnt vmcnt(0)" ::: "memory"); }
                hg_write_lb(L, F.lbf, F.lbb, bwd, h, w, l);
#pragma unroll
                for (int kt = 0; kt < 8; ++kt) S[kt] = (f32x4){0.f, 0.f, 0.f, 0.f};
                const int nf = bwd ? 7 - sc : sc;
                LAS float* DLS = (LAS float*)(L + H2_PS);
                for (int u = F.tid; u < nf * 128; u += NWAVES * 64) { const int tt = u >> 7; const int i = bwd ? 7 - tt : tt; DLS[u] = DL[hg_slot(dir, b, h, i) * 128 + (u & 127)]; }
                __syncthreads();
                int tt = 0;
                for (; tt + 1 < nf; tt += 2) {
                    const int i0 = bwd ? 7 - tt : tt, i1 = bwd ? 6 - tt : tt + 1;
                    const float* sl0 = SL + hg_slot(dir, b, h, i0) * 16384 + (size_t)(w * 64 + l) * 4; const float* sl1 = SL + hg_slot(dir, b, h, i1) * 16384 + (size_t)(w * 64 + l) * 4;
                    f32x4 s4a[8], s4b[8];
#pragma unroll
                    for (int kt = 0; kt < 8; ++kt) { s4a[kt] = *(const GAS f32x4*)(sl0 + (size_t)kt * 8 * 256); s4b[kt] = *(const GAS f32x4*)(sl1 + (size_t)kt * 8 * 256); }
                    asm volatile("" ::: "memory");
#pragma unroll
                    for (int kt = 0; kt < 8; ++kt) { const f32x4 d0 = *(const LAS f32x4*)(DLS + tt * 128 + 16 * kt + 4 * g), d1 = *(const LAS f32x4*)(DLS + (tt + 1) * 128 + 16 * kt + 4 * g);
                        S[kt] = (S[kt] * d0 + s4a[kt]) * d1 + s4b[kt]; } }
                if (tt < nf) { const int i = bwd ? 7 - tt : tt; const float* sl = SL + hg_slot(dir, b, h, i) * 16384 + (size_t)(w * 64 + l) * 4;
                    f32x4 s4[8];
#pragma unroll
                    for (int kt = 0; kt < 8; ++kt) s4[kt] = *(const GAS f32x4*)(sl + (size_t)kt * 8 * 256);
                    asm volatile("" ::: "memory");
#pragma unroll
                    for (int kt = 0; kt < 8; ++kt) { const f32x4 d4 = *(const LAS f32x4*)(DLS + tt * 128 + 16 * kt + 4 * g); S[kt] = S[kt] * d4 + s4[kt]; } }
            }
            const int vtoff = (t & 1) ? H2_VT1 : H2_VT0;
            {   float el[16];
                hg_stage_v(L, vtoff, w, l, in.v);
                hg_stage<true>(L, H2_KT0, H2_DEC0, w, l, bwd, in.z, in.q, el); }
            if (t + 1 < 8) { const bool nb = (t + 1) >= 4; const int nn = (t + 1) & 3; hg_load<true>(in, P, b, h, w, l, sc * 4 + (nb ? 3 - nn : nn), nb); }
            float* ofw = OFW + ((size_t)((item * 4 + j) * 4) * 8 + w) * 256 + (size_t)l * 4;
            f32x4 of[4]; v2u gr[4];
            if (bwd) {
#pragma unroll
                for (int ct = 0; ct < 4; ++ct) { of[ct] = *(const GAS f32x4*)(ofw + (size_t)ct * 8 * 256);
                    gr[ct] = *(const GAS v2u*)(P + (size_t)(b * SEQ + (sc * 4 + j) * 64 + ct * 16 + fr) * NIN + CGH + h * 128 + 16 * w + 4 * g); }
            }
            __syncthreads();
            f32x4 o[4];
            hgrn_pass2_compute(L, w, g, fr, bwd, vtoff, S, o);
            if (!bwd) {
#pragma unroll
                for (int ct = 0; ct < 4; ++ct) *(GAS f32x4*)(ofw + (size_t)ct * 8 * 256) = o[ct];
            } else {
                float ps[4];
#pragma unroll
                for (int ct = 0; ct < 4; ++ct) { o[ct] = o[ct] + of[ct]; const f32x4 v = o[ct];
                    float s2 = (v[0] * v[0] + v[1] * v[1]) + (v[2] * v[2] + v[3] * v[3]); s2 += __shfl_xor(s2, 16); s2 += __shfl_xor(s2, 32); ps[ct] = s2; }
                if (g == 0) {
#pragma unroll
                    for (int ct = 0; ct < 4; ++ct) RED[w * 64 + ct * 16 + fr] = ps[ct];
                }
                __syncthreads();
#pragma unroll
                for (int ct = 0; ct < 4; ++ct) { const int ti = ct * 16 + fr; float tot = 0.f;
#pragma unroll
                    for (int ww = 0; ww < 8; ++ww) tot += RED[ww * 64 + ti];
                    const float rs = 1.0f / sqrtf(tot * (1.f / 128.f) + EPS);
                    const size_t row = (size_t)(b * SEQ + (sc * 4 + j) * 64 + ti);
                    const f32x4 v = o[ct];
                    v2u o2; o2.x = pk2(v[0] * rs * gn[0] * pg8::silu_f(bf_lo(gr[ct].x)), v[1] * rs * gn[1] * pg8::silu_f(bf_hi(gr[ct].x)));
                    o2.y = pk2(v[2] * rs * gn[2] * pg8::silu_f(bf_lo(gr[ct].y)), v[3] * rs * gn[3] * pg8::silu_f(bf_hi(gr[ct].y)));
                    *(GAS v2u*)(Y + row * D + h * 128 + 16 * w + 4 * g) = o2; }
            }
        }
        __syncthreads();
    }
}

constexpr int AT_K = 0, AT_V = 34816, AT_TB = 69632, AT_END = 69632 + 2 * 264 * 4;
__device__ __forceinline__ int t5_bucket(int rel) {
    const int n = rel < 0 ? -rel : rel; int bkt;
    if (n < 8) bkt = n; else { int j = 0; while (j < 7 && 64 * (2 << j) <= n * n) ++j; bkt = 8 + j; }
    return bkt + (rel > 0 ? 16 : 0);
}
struct AtRegs { v4u k[4], v[4]; };
__device__ __forceinline__ void at_load(AtRegs& r, const bf16* P, int b, int kb, int kvh, int tid) {
    const bf16* kvbase = P + (size_t)(b * SEQ + kb * 128) * NIN;
#pragma unroll
    for (int i = 0; i < 4; ++i) { const int id = tid + 512 * i; r.k[i] = *(const GAS v4u*)(kvbase + (size_t)(id >> 4) * NIN + CKA + kvh * 128 + 8 * (id & 15)); }
#pragma unroll
    for (int i = 0; i < 4; ++i) { const int id = tid + 512 * i; r.v[i] = *(const GAS v4u*)(kvbase + (size_t)(id & 127) * NIN + CVA + kvh * 128 + 8 * (id >> 7)); }
}
__device__ __forceinline__ void at_stage(LAS unsigned char* L, const AtRegs& r, int tid) {
#pragma unroll
    for (int i = 0; i < 4; ++i) { const int id = tid + 512 * i; *(LAS v4u*)(L + AT_K + (id >> 4) * 272 + 16 * (id & 15)) = r.k[i]; }
#pragma unroll
    for (int i = 0; i < 4; ++i) { const int id = tid + 512 * i; const int key = id & 127, ch = id >> 7;
#pragma unroll
        for (int e = 0; e < 4; ++e) { *(LAS unsigned short*)(L + AT_V + (8 * ch + 2 * e) * 272 + 2 * key) = (unsigned short)(r.v[i][e] & 0xffffu); *(LAS unsigned short*)(L + AT_V + (8 * ch + 2 * e + 1) * 272 + 2 * key) = (unsigned short)(r.v[i][e] >> 16); } }
}
__device__ __forceinline__ void at_head(LAS unsigned char* L, const LAS float* TB, int relbase, int g, int fr, const bf16x8 (&bq)[4], float& mrun, float& lrun, f32x4 (&ot)[8]) {
    const float scale = 0.08838834764831845f;
    f32x4 st[8];
#pragma unroll
    for (int mt = 0; mt < 8; ++mt) { st[mt] = (f32x4){0.f, 0.f, 0.f, 0.f};
#pragma unroll
        for (int ks = 0; ks < 4; ++ks) st[mt] = __builtin_amdgcn_mfma_f32_16x16x32_bf16(ldsfrag(L + AT_K, 16 * mt + fr, 272, 64 * ks + 16 * g), bq[ks], st[mt], 0, 0, 0); }
    float mx = -3.0e38f;
#pragma unroll
    for (int mt = 0; mt < 8; ++mt)
#pragma unroll
        for (int r = 0; r < 4; ++r) { const int rel = relbase + 16 * mt + r; const bool ok = rel >= -128 && rel <= 128; const int ri = min(max(rel + 128, 0), 256);
            const float tb = TB[ri]; const float s = ok ? st[mt][r] * scale + tb : -1.0e30f; st[mt][r] = s; mx = fmaxf(mx, s); }
    mx = fmaxf(mx, __shfl_xor(mx, 16)); mx = fmaxf(mx, __shfl_xor(mx, 32));
    const float mnew = fmaxf(mrun, mx), alpha = __expf(mrun - mnew); mrun = mnew;
    float ls = 0.f;
#pragma unroll
    for (int mt = 0; mt < 8; ++mt)
#pragma unroll
        for (int r = 0; r < 4; ++r) { const float p = __expf(st[mt][r] - mnew); st[mt][r] = p; ls += p; }
    ls += __shfl_xor(ls, 16); ls += __shfl_xor(ls, 32);
    lrun = lrun * alpha + ls;
#pragma unroll
    for (int dt = 0; dt < 8; ++dt) ot[dt] = ot[dt] * alpha;
#pragma unroll
    for (int k2 = 0; k2 < 4; ++k2) {
        v4u pb; pb.x = pk2(st[2 * k2][0], st[2 * k2][1]); pb.y = pk2(st[2 * k2][2], st[2 * k2][3]); pb.z = pk2(st[2 * k2 + 1][0], st[2 * k2 + 1][1]); pb.w = pk2(st[2 * k2 + 1][2], st[2 * k2 + 1][3]);
        const bf16x8 pfrag = __builtin_bit_cast(bf16x8, pb);
#pragma unroll
        for (int dt = 0; dt < 8; ++dt) { const LAS unsigned char* vrow = L + AT_V + (16 * dt + fr) * 272;
            const v2u a0 = *(const LAS v2u*)(vrow + 2 * (32 * k2 + 4 * g)), a1 = *(const LAS v2u*)(vrow + 2 * (32 * k2 + 16 + 4 * g));
            const v4u av = (v4u){a0.x, a0.y, a1.x, a1.y};
            ot[dt] = __builtin_amdgcn_mfma_f32_16x16x32_bf16(__builtin_bit_cast(bf16x8, av), pfrag, ot[dt], 0, 0, 0); } }
}
__device__ __forceinline__ void attn_item(Frame& F, const bf16* P, bf16* Y, int item) {
    LAS unsigned char* L = F.lds + RING_OFF;
    const int w = F.wave, l = F.lane, g = l >> 4, fr = l & 15, tid = F.tid;
    {
        const int hq = item & 3, blk = (item >> 2) & 15, kvh = (item >> 6) & 1, b = item >> 7, h = kvh * 4 + hq;
        LAS float* TB = (LAS float*)(L + AT_TB);
        if (tid < 257) TB[tid] = F.relb[t5_bucket(tid - 128) * AH + h];
        const int jt0 = blk == 0 ? 1 : 0, jt1 = blk == 15 ? 1 : 2;
        AtRegs R; at_load(R, P, b, blk - 1 + jt0, kvh, tid);
        const int qrow = b * SEQ + blk * 128 + 16 * w + fr;
        bf16x8 bq[4];
#pragma unroll
        for (int ks = 0; ks < 4; ++ks) bq[ks] = *(const GAS bf16x8*)(P + (size_t)qrow * NIN + CQA + h * 128 + 32 * ks + 8 * g);
        float mrun = F.sink[h], lrun = 1.0f;
        f32x4 ot[8];
#pragma unroll
        for (int dt = 0; dt < 8; ++dt) ot[dt] = (f32x4){0.f, 0.f, 0.f, 0.f};
        for (int jt = jt0; jt <= jt1; ++jt) {
            at_stage(L, R, tid);
            __syncthreads();
            if (jt < jt1) at_load(R, P, b, blk + jt, kvh, tid);
            const int relbase = (jt - 1) * 128 + 4 * g - (16 * w + fr);
            at_head(L, TB, relbase, g, fr, bq, mrun, lrun, ot);
            __syncthreads();
        }
        const float inv = 1.0f / lrun;
#pragma unroll
        for (int dt = 0; dt < 8; ++dt) { v2u o2; o2.x = pk2(ot[dt][0] * inv, ot[dt][1] * inv); o2.y = pk2(ot[dt][2] * inv, ot[dt][3] * inv);
            *(GAS v2u*)(Y + (size_t)qrow * D + HW + h * 128 + 16 * dt + 4 * g) = o2; }
        __syncthreads();
    }
}
__device__ __forceinline__ void attn_phase(Frame& F, const bf16* P, bf16* Y) { for (int item = F.vcu; item < 512; item += F.G) attn_item(F, P, Y, item); }
__device__ __forceinline__ float at_softmax(const LAS float* TB, int relbase, f32x4 (&st)[8], float& mrun, float& lrun) {
    const float scale = 0.08838834764831845f;
    float mx = -3.0e38f;
#pragma unroll
    for (int mt = 0; mt < 8; ++mt)
#pragma unroll
        for (int r = 0; r < 4; ++r) { const int rel = relbase + 16 * mt + r; const bool ok = rel >= -128 && rel <= 128; const int ri = min(max(rel + 128, 0), 256);
            const float tb = TB[ri]; const float s = ok ? st[mt][r] * scale + tb : -1.0e30f; st[mt][r] = s; mx = fmaxf(mx, s); }
    mx = fmaxf(mx, __shfl_xor(mx, 16)); mx = fmaxf(mx, __shfl_xor(mx, 32));
    const float mnew = fmaxf(mrun, mx), alpha = __expf(mrun - mnew); mrun = mnew;
    float ls = 0.f;
#pragma unroll
    for (int mt = 0; mt < 8; ++mt)
#pragma unroll
        for (int r = 0; r < 4; ++r) { const float p = __expf(st[mt][r] - mnew); st[mt][r] = p; ls += p; }
    ls += __shfl_xor(ls, 16); ls += __shfl_xor(ls, 32);
    lrun = lrun * alpha + ls;
    return alpha;
}
__device__ __forceinline__ void attn_item2(Frame& F, const bf16* P, bf16* Y, int item2) {
    LAS unsigned char* L = F.lds + RING_OFF;
    const int w = F.wave, l = F.lane, g = l >> 4, fr = l & 15, tid = F.tid;
    const int hp = item2 & 1, blk = (item2 >> 1) & 15, kvh = (item2 >> 5) & 1, b = item2 >> 6, h0 = kvh * 4 + 2 * hp;
    LAS float* TB = (LAS float*)(L + AT_TB);
    for (int u = tid; u < 2 * 257; u += NWAVES * 64) { const int hh = u >= 257 ? 1 : 0, t = u - 257 * hh; TB[hh * 264 + t] = F.relb[t5_bucket(t - 128) * AH + h0 + hh]; }
    const int jt0 = blk == 0 ? 1 : 0, jt1 = blk == 15 ? 1 : 2;
    const int qrow = b * SEQ + blk * 128 + 16 * w + fr;
    bf16x8 bq0[4], bq1[4];
#pragma unroll
    for (int ks = 0; ks < 4; ++ks) { bq0[ks] = *(const GAS bf16x8*)(P + (size_t)qrow * NIN + CQA + h0 * 128 + 32 * ks + 8 * g); bq1[ks] = *(const GAS bf16x8*)(P + (size_t)qrow * NIN + CQA + (h0 + 1) * 128 + 32 * ks + 8 * g); }
    float m0 = F.sink[h0], m1 = F.sink[h0 + 1], l0 = 1.0f, l1 = 1.0f;
    f32x4 ot0[8], ot1[8];
#pragma unroll
    for (int dt = 0; dt < 8; ++dt) { ot0[dt] = (f32x4){0.f, 0.f, 0.f, 0.f}; ot1[dt] = (f32x4){0.f, 0.f, 0.f, 0.f}; }
    for (int jt = jt0; jt <= jt1; ++jt) {
        { AtRegs R; at_load(R, P, b, blk - 1 + jt, kvh, tid); at_stage(L, R, tid); }
        __syncthreads();
        const int relbase = (jt - 1) * 128 + 4 * g - (16 * w + fr);
        f32x4 st0[8], st1[8];
#pragma unroll
        for (int mt = 0; mt < 8; ++mt) { st0[mt] = (f32x4){0.f, 0.f, 0.f, 0.f}; st1[mt] = (f32x4){0.f, 0.f, 0.f, 0.f};
#pragma unroll
            for (int ks = 0; ks < 4; ++ks) { const bf16x8 kf = ldsfrag(L + AT_K, 16 * mt + fr, 272, 64 * ks + 16 * g);
                st0[mt] = __builtin_amdgcn_mfma_f32_16x16x32_bf16(kf, bq0[ks], st0[mt], 0, 0, 0); st1[mt] = __builtin_amdgcn_mfma_f32_16x16x32_bf16(kf, bq1[ks], st1[mt], 0, 0, 0); } }
        const float a0 = at_softmax(TB, relbase, st0, m0, l0);
        __builtin_amdgcn_sched_barrier(0);
        const float a1 = at_softmax(TB + 264, relbase, st1, m1, l1);
#pragma unroll
        for (int dt = 0; dt < 8; ++dt) { ot0[dt] = ot0[dt] * a0; ot1[dt] = ot1[dt] * a1; }
#pragma unroll
        for (int k2 = 0; k2 < 4; ++k2) {
            v4u pb; pb.x = pk2(st0[2 * k2][0], st0[2 * k2][1]); pb.y = pk2(st0[2 * k2][2], st0[2 * k2][3]); pb.z = pk2(st0[2 * k2 + 1][0], st0[2 * k2 + 1][1]); pb.w = pk2(st0[2 * k2 + 1][2], st0[2 * k2 + 1][3]);
            const bf16x8 pf0 = __builtin_bit_cast(bf16x8, pb);
            pb.x = pk2(st1[2 * k2][0], st1[2 * k2][1]); pb.y = pk2(st1[2 * k2][2], st1[2 * k2][3]); pb.z = pk2(st1[2 * k2 + 1][0], st1[2 * k2 + 1][1]); pb.w = pk2(st1[2 * k2 + 1][2], st1[2 * k2 + 1][3]);
            const bf16x8 pf1 = __builtin_bit_cast(bf16x8, pb);
#pragma unroll
            for (int dt = 0; dt < 8; ++dt) { const LAS unsigned char* vrow = L + AT_V + (16 * dt + fr) * 272;
                const v2u x0 = *(const LAS v2u*)(vrow + 2 * (32 * k2 + 4 * g)), x1 = *(const LAS v2u*)(vrow + 2 * (32 * k2 + 16 + 4 * g));
                const bf16x8 av = __builtin_bit_cast(bf16x8, (v4u){x0.x, x0.y, x1.x, x1.y});
                ot0[dt] = __builtin_amdgcn_mfma_f32_16x16x32_bf16(av, pf0, ot0[dt], 0, 0, 0); ot1[dt] = __builtin_amdgcn_mfma_f32_16x16x32_bf16(av, pf1, ot1[dt], 0, 0, 0); } }
        __syncthreads();
    }
    const float inv0 = 1.0f / l0, inv1 = 1.0f / l1;
#pragma unroll
    for (int dt = 0; dt < 8; ++dt) { v2u o2; o2.x = pk2(ot0[dt][0] * inv0, ot0[dt][1] * inv0); o2.y = pk2(ot0[dt][2] * inv0, ot0[dt][3] * inv0);
        *(GAS v2u*)(Y + (size_t)qrow * D + HW + h0 * 128 + 16 * dt + 4 * g) = o2;
        o2.x = pk2(ot1[dt][0] * inv1, ot1[dt][1] * inv1); o2.y = pk2(ot1[dt][2] * inv1, ot1[dt][3] * inv1);
        *(GAS v2u*)(Y + (size_t)qrow * D + HW + (h0 + 1) * 128 + 16 * dt + 4 * g) = o2; }
    __syncthreads();
}

constexpr int CW_GRP = 1024;
__device__ __forceinline__ void hg_group_publish(Frame& F, int grp) {
    asm volatile("s_waitcnt vmcnt(0)" ::: "memory");
    __syncthreads();
    if (F.tid == 0) { __builtin_amdgcn_fence(__ATOMIC_RELEASE, "agent"); asm volatile("s_waitcnt vmcnt(0)" ::: "memory");
        __hip_atomic_fetch_add((unsigned*)(F.ctl + CW_GRP + 64 * grp), 1u, __ATOMIC_RELAXED, __HIP_MEMORY_SCOPE_AGENT); }
}
__device__ __forceinline__ void hg_group_wait(Frame& F, int grp) {
    if (F.tid == 0) { unsigned sp = 0;
        while (__hip_atomic_load((unsigned*)(F.ctl + CW_GRP + 64 * grp), __ATOMIC_RELAXED, __HIP_MEMORY_SCOPE_AGENT) < 8u) { __builtin_amdgcn_s_sleep(2); if (++sp > (1u << 20)) break; }
        __builtin_amdgcn_fence(__ATOMIC_ACQUIRE, "agent"); asm volatile("s_waitcnt vmcnt(0)" ::: "memory"); }
    __syncthreads();
}

struct Args { const float* in[18]; float* out; unsigned char* ws; int ph_lo, ph_hi, li, pad; };
__global__ void __launch_bounds__(NWAVES * 64, 2) hymba_fwd(Args args) {
    extern __shared__ __attribute__((aligned(16))) unsigned char lds[];
    Frame F;
    F.lds = (LAS unsigned char*)lds;
    F.MISC = (volatile LAS unsigned*)(F.lds + MISC_OFF);
    F.tid = threadIdx.x; F.lane = F.tid & 63; F.wave = __builtin_amdgcn_readfirstlane(F.tid >> 6);
    F.G = gridDim.x; { const int bx = blockIdx.x; F.vcu = (F.G % 8 == 0) ? (bx % 8) * (F.G / 8) + bx / 8 : bx; }
    unsigned char* ws = args.ws;
    F.ctl = (gu32*)(ws + WS_CTL);
    F.x = args.in[0]; F.pre1 = args.in[1]; F.post1 = args.in[2]; F.w1gu = args.in[3]; F.w1d = args.in[4]; F.prem = args.in[5]; F.postm = args.in[6]; F.win = args.in[7];
    F.lbf = args.in[8]; F.lbb = args.in[9]; F.ognorm = args.in[10]; F.sink = args.in[11]; F.wout = args.in[12]; F.pre2 = args.in[13]; F.post2 = args.in[14];
    F.w2gu = args.in[15]; F.w2d = args.in[16]; F.relb = args.in[17]; F.out = args.out;
    F.W1GU = (bf16*)(ws + WS_W1GU); F.W1D = (bf16*)(ws + WS_W1D); F.WIN = (bf16*)(ws + WS_WIN); F.WOUT = (bf16*)(ws + WS_WOUT); F.W2GU = (bf16*)(ws + WS_W2GU); F.W2D = (bf16*)(ws + WS_W2D);
    F.H = (bf16*)(ws + WS_H); F.ACT = (bf16*)(ws + WS_ACT); F.FFB = (bf16*)(ws + WS_FF); F.SLB = (float*)(ws + WS_FF); F.XR = (bf16*)(ws + WS_FF + 32 * MiB); F.ssq = (float*)(ws + WS_SSQ);
    for (int u = F.tid; u < (LDS_BYTES - LDSCTL_OFF) / 4; u += NWAVES * 64) ((LAS unsigned*)(F.lds + LDSCTL_OFF))[u] = 0u;
    __syncthreads();
    XcdBarrier bar; bar.bar = (unsigned*)(F.ctl + CW_BAR); bar.x = 0; bar.st = nullptr;
    if (N_LAUNCHES != PER_PHASE) bar = xcd_barrier_post((unsigned*)(F.ctl + CW_BAR), F.MISC + 8);
#define GRID_BAR() do { if (N_LAUNCHES != PER_PHASE) xcd_barrier(bar); } while (0)
    const int lo = args.ph_lo, hi = args.ph_hi;
    unsigned long long pr_t0 = 0, pr_dt = 0;
#ifdef PROBE_PHASE
#define TS(k) do { if ((k) == PROBE_PHASE) pr_t0 = __builtin_amdgcn_s_memrealtime(); } while (0)
#define TE(k) do { if ((k) == PROBE_PHASE) pr_dt = __builtin_amdgcn_s_memrealtime() - pr_t0; } while (0)
#else
#define TS(k) do {} while (0)
#define TE(k) do {} while (0)
#endif
#define IN(k) (lo <= (k) && (k) < hi)
#define BOTH(k) (IN(k) && IN((k) + 1))
    typedef pg8::StaticOrder SO;
    TS(0); if (IN(0)) for (int r_ = 0; r_ < REP_P0; ++r_) { p0_prologue(F); if (BOTH(0)) GRID_BAR(); }
    TE(0);
    TS(1); if (IN(1)) for (int r_ = 0; r_ < REP_P1; ++r_) { pg8::Gemm gm{F.H, F.W1GU, M, NGU, D}; SO S; S.init(M, NGU, F.G, (int)blockIdx.x); pg8::EpiSwiglu E{F.ACT, FF};
        pg8::gemm_phase<pg8::EpiSwiglu, SO, PG8_ALIGN, PG8_SP2>(F.lds + RING_OFF, gm, S, E);
        { const int nfull = (M / 256) * (NGU / 256) % F.G;
          if (nfull != 0 && (int)blockIdx.x >= nfull && r_ == 0) convert_list<1>(F, ((int)blockIdx.x - nfull) * NWAVES + F.wave, (F.G - nfull) * NWAVES);
          else if (nfull == 0 && r_ == 0) convert_list<1>(F, F.vcu * NWAVES + F.wave, F.G * NWAVES); }
        if (BOTH(1)) GRID_BAR(); }
    TE(1);
    TS(2); if (IN(2)) for (int r_ = 0; r_ < REP_P2; ++r_) { pg8::Gemm gm{F.ACT, F.W1D, M, D, FF}; SO S; S.init(M, D, F.G, (int)blockIdx.x); pg8::EpiBf16Ssq E{F.FFB, D, F.ssq};
        pg8::gemm_phase<pg8::EpiBf16Ssq, SO, PG8_ALIGN, PG8_SP2>(F.lds + RING_OFF, gm, S, E); if (BOTH(2)) GRID_BAR(); }
    TE(2);
    TS(3); if (IN(3)) for (int r_ = 0; r_ < REP_P3; ++r_) { ew_phase<true, false>(F, F.x, F.FFB, F.ssq, F.post1, 0.5f, F.XR, F.prem, F.H); TS(67); if (BOTH(3)) GRID_BAR(); TE(67); }
    TE(3);
    TS(4); if (IN(4)) for (int r_ = 0; r_ < REP_P4; ++r_) { pg8::Gemm gm{F.H, F.WIN, M, NIN, D}; SO S; S.init(M, NIN, F.G, (int)blockIdx.x); pg8::EpiBf16 E{F.ACT, NIN};
        pg8::gemm_phase<pg8::EpiBf16, SO, PG8_ALIGN, PG8_SP2>(F.lds + RING_OFF, gm, S, E);
        { const int nfull = (M / 256) * (NIN / 256) % F.G;
          if (nfull != 0 && (int)blockIdx.x >= nfull && r_ == 0) convert_list<2>(F, ((int)blockIdx.x - nfull) * NWAVES + F.wave, (F.G - nfull) * NWAVES);
          else if (nfull == 0 && r_ == 0) convert_list<2>(F, F.vcu * NWAVES + F.wave, F.G * NWAVES); }
        TS(66); if (BOTH(4)) GRID_BAR(); TE(66); }
    TE(4);
    TS(5); if (IN(5)) {
        if (F.G == 256 && REP_HG == 1 && REP_AT == 1) {
            const int grp = F.vcu >> 3;
            TS(64); TS(50);
            hgrn_pass1(F, F.ACT, F.SLB, F.ssq); TE(50); TS(53); hg_group_publish(F, grp); TE(53);
            TS(51); attn_item2(F, F.ACT, F.H, F.vcu); TE(51);
            hg_group_wait(F, grp); TS(52); hgrn_pass2(F, F.ACT, F.SLB, F.ssq, F.out, F.H); TE(52); TE(64);
        } else {
            for (int r_ = 0; r_ < REP_HG; ++r_) hgrn_pass1(F, F.ACT, F.SLB, F.ssq); for (int r_ = 0; r_ < REP_AT; ++r_) attn_phase(F, F.ACT, F.H); GRID_BAR();
            hgrn_pass2(F, F.ACT, F.SLB, F.ssq, F.out, F.H);
        }
        TS(65); if (BOTH(5)) GRID_BAR(); TE(65);
        }
    TE(5);
    TS(6);
    TE(6);
    TS(7); if (IN(7)) for (int r_ = 0; r_ < REP_P7; ++r_) { pg8::Gemm gm{F.H, F.WOUT, M, D, D}; SO S; S.init(M, D, F.G, (int)blockIdx.x); pg8::EpiBf16Ssq E{F.FFB, D, F.ssq};
        pg8::gemm_phase<pg8::EpiBf16Ssq, SO, PG8_ALIGN, PG8_SP2>(F.lds + RING_OFF, gm, S, E); if (BOTH(7)) GRID_BAR(); }
    TE(7);
    TS(8); if (IN(8)) { ew_phase<false, false>(F, F.XR, F.FFB, F.ssq, F.postm, 1.0f, F.XR, F.pre2, F.H); if (BOTH(8)) GRID_BAR(); }
    TE(8);
    TS(9); if (IN(9)) { pg8::Gemm gm{F.H, F.W2GU, M, NGU, D}; SO S; S.init(M, NGU, F.G, (int)blockIdx.x); pg8::EpiSwiglu E{F.ACT, FF};
        pg8::gemm_phase<pg8::EpiSwiglu, SO, PG8_ALIGN, PG8_SP2>(F.lds + RING_OFF, gm, S, E);
        { const int nfull = (M / 256) * (NGU / 256) % F.G;
          if (nfull != 0 && (int)blockIdx.x >= nfull) convert_list<3>(F, ((int)blockIdx.x - nfull) * NWAVES + F.wave, (F.G - nfull) * NWAVES);
          else if (nfull == 0) convert_list<3>(F, F.vcu * NWAVES + F.wave, F.G * NWAVES); }
        if (BOTH(9)) GRID_BAR(); }
    TE(9);
    TS(10); if (IN(10)) { pg8::Gemm gm{F.ACT, F.W2D, M, D, FF}; SO S; S.init(M, D, F.G, (int)blockIdx.x); pg8::EpiBf16Ssq E{F.FFB, D, F.ssq};
        pg8::gemm_phase<pg8::EpiBf16Ssq, SO, PG8_ALIGN, PG8_SP2>(F.lds + RING_OFF, gm, S, E); if (BOTH(10)) GRID_BAR(); }
    TE(10);
    TS(11); if (IN(11)) { ew_phase<false, true>(F, F.XR, F.FFB, F.ssq, F.post2, 0.5f, F.out, nullptr, nullptr); }
    TE(11);
#undef IN
#undef BOTH
#ifdef PROBE_PHASE
    if (blockIdx.x == 0 && F.tid == 0) { const unsigned long long te = __builtin_amdgcn_s_memrealtime(); while (__builtin_amdgcn_s_memrealtime() - te < (unsigned long long)PROBE_MULT * pr_dt) __builtin_amdgcn_s_sleep(8); }
#endif
}

extern "C" void kernel_launch(void* const* d_in, const int* in_sizes, int n_in, void* d_out, int out_size, void* d_ws, size_t ws_size, hipStream_t stream) {
    static int grid = 0;
    if (grid == 0) {
        if (n_in != 18 || in_sizes[0] != M * D || out_size != M * D || ws_size < WS_END) { fprintf(stderr, "kernel_launch: unexpected shapes/workspace (n_in %d, ws %zu)\n", n_in, ws_size); grid = -1; return; }
        int dev = 0, cus = 0;
        if (hipGetDevice(&dev) != hipSuccess || hipDeviceGetAttribute(&cus, hipDeviceAttributeMultiprocessorCount, dev) != hipSuccess) { grid = -1; return; }
        if (hipFuncSetAttribute((const void*)hymba_fwd, hipFuncAttributeMaxDynamicSharedMemorySize, LDS_BYTES) != hipSuccess) { fprintf(stderr, "kernel_launch: hipFuncSetAttribute failed\n"); grid = -1; return; }
        (void)hipGetLastError();
        grid = cus;
    }
    if (grid < 0) return;
    if (hipMemsetAsync((char*)d_ws + WS_CTL, 0, CTL_ZERO_BYTES, stream) != hipSuccess) return;
    Args a{};
    for (int i = 0; i < 18; ++i) a.in[i] = (const float*)d_in[i];
    a.out = (float*)d_out; a.ws = (unsigned char*)d_ws;
    if (N_LAUNCHES == 1) { a.ph_lo = 0; a.ph_hi = PER_PHASE; a.li = 0; hipLaunchKernelGGL(hymba_fwd, dim3(grid), dim3(NWAVES * 64), LDS_BYTES, stream, a); }
    else { for (int li = 0; li < PER_PHASE; ++li) { a.ph_lo = li; a.ph_hi = li + 1; a.li = li; hipLaunchKernelGGL(hymba_fwd, dim3(grid), dim3(NWAVES * 64), LDS_BYTES, stream, a); } }
}
```
